# Optimizing an MI355X kernel written in HIP

```python
import jax
import jax.numpy as jnp
from jax import lax
import numpy as np

D_MODEL = 1024
BATCH = 2
SEQ = 16384
DEPTH = 1

GRID_W = 64
CTX_LEN = 256
NA_HEADS = 8
NA_HEAD_DIM = 64
NA_WIDTH = NA_HEADS * NA_HEAD_DIM
NA_WIN_ROWS = 8
NA_WIN_COLS = 16
RW_HEADS = 8
RW_HEAD_DIM = 64
RW_WIDTH = RW_HEADS * RW_HEAD_DIM
MIX_WIDTH = NA_WIDTH + RW_WIDTH
DECAY_LORA = 64
AAA_LORA = 64
GATE_LORA = 128
RW_PROJ = 3 * RW_WIDTH + 2 * DECAY_LORA + AAA_LORA + GATE_LORA
IN_PROJ = 3 * NA_WIDTH + RW_PROJ
D_FF = -(-8 * D_MODEL // (3 * 256)) * 256
NORM_EPS = 1e-6
RW_GN_EPS = 64e-5

kernel_name = 'hybrid_na_rwkv7_prefix_dit_layer'


def rms_norm(x, g, eps=NORM_EPS):
    xf = x.astype(jnp.float32)
    y = xf * lax.rsqrt(jnp.mean(xf * xf, axis=-1, keepdims=True) + eps)
    return (y * g.astype(jnp.float32)).astype(x.dtype)


def modulate(h, shift, scale):
    return h * (1.0 + scale[..., None, :]) + shift[..., None, :]


def split_heads(t, n_heads):
    return t.reshape(t.shape[:-1] + (n_heads, t.shape[-1] // n_heads))


def swiglu(u, w_in, w_out):
    gate, up = jnp.split(u @ w_in, 2, axis=-1)
    return (jax.nn.silu(gate) * up) @ w_out


def na_qkv(p, q_g, k_g):
    q, k, v = jnp.split(p, 3, axis=-1)
    q = rms_norm(split_heads(q, NA_HEADS), q_g) * (NA_HEAD_DIM ** -0.5)
    k = rms_norm(split_heads(k, NA_HEADS), k_g)
    return q, k, split_heads(v, NA_HEADS)


def neighborhood_attention(q, k, v, k_ctx, v_ctx, rpb):
    B, T, H, dh = q.shape
    rows = T // GRID_W
    wr = min(NA_WIN_ROWS, rows)
    wc = NA_WIN_COLS
    qg = q.reshape(B, rows, GRID_W, H, dh).transpose(1, 0, 3, 2, 4)
    kg = k.reshape(B, rows, GRID_W, H, dh).transpose(0, 3, 1, 2, 4)
    vg = v.reshape(B, rows, GRID_W, H, dh).transpose(0, 3, 1, 2, 4)
    kc = k_ctx.transpose(0, 2, 1, 3)
    vc = v_ctx.transpose(0, 2, 1, 3)
    col = jnp.arange(GRID_W)
    col_start = jnp.clip(col - wc // 2, 0, GRID_W - wc)
    col_idx = col_start[:, None] + jnp.arange(wc)[None, :]
    dj = col_idx - col[:, None] + (NA_WIN_COLS - 1)
    n_win = wr * wc

    def row_block(args):
        i, q_row = args
        rs = jnp.clip(i - wr // 2, 0, rows - wr)
        k_rows = lax.dynamic_slice_in_dim(kg, rs, wr, axis=2)
        v_rows = lax.dynamic_slice_in_dim(vg, rs, wr, axis=2)
        k_win = k_rows[:, :, :, col_idx]
        v_win = v_rows[:, :, :, col_idx]
        di = rs + jnp.arange(wr) - i + (NA_WIN_ROWS - 1)
        bias = rpb[:, di[:, None, None], dj[None]]
        s_win = jnp.einsum('bhqd,bhrqcd->bhqrc', q_row, k_win) + bias.transpose(0, 2, 1, 3)[None]
        s_ctx = jnp.einsum('bhqd,bhld->bhql', q_row, kc)
        s = jnp.concatenate([s_win.reshape(B, H, GRID_W, n_win), s_ctx], axis=-1)
        pr = jax.nn.softmax(s.astype(jnp.float32), axis=-1).astype(v.dtype)
        p_win = pr[..., :n_win].reshape(B, H, GRID_W, wr, wc)
        return (jnp.einsum('bhqrc,bhrqcd->bhqd', p_win, v_win)
                + jnp.einsum('bhql,bhld->bhqd', pr[..., n_win:], vc))

    out = lax.map(row_block, (jnp.arange(rows), qg))
    return out.transpose(1, 0, 3, 2, 4).reshape(B, T, H * dh)


def context_attention(q, k, v):
    s = jnp.einsum('bqhd,bkhd->bhqk', q, k).astype(jnp.float32)
    pr = jax.nn.softmax(s, axis=-1).astype(v.dtype)
    o = jnp.einsum('bhqk,bkhd->bqhd', pr, v)
    return o.reshape(o.shape[:2] + (NA_WIDTH,))


def token_shift(p, mu_prev, mu_next):
    prev = jnp.pad(p[:, :-1], ((0, 0), (1, 0), (0, 0)))
    nxt = jnp.pad(p[:, 1:], ((0, 0), (0, 1), (0, 0)))
    return p + mu_prev * (prev - p) + mu_next * (nxt - p)


def rwkv_prep(p, mu_prev, mu_next, w0, w_up, a0, a_up, g_up, k_k, k_a):
    p = token_shift(p, mu_prev, mu_next).astype(jnp.float32)
    offs = np.cumsum([RW_WIDTH, RW_WIDTH, RW_WIDTH, 2 * DECAY_LORA, AAA_LORA]).tolist()
    r, k, v, wd, ad, gd = jnp.split(p, offs, axis=-1)
    wd = wd.reshape(wd.shape[:-1] + (2, DECAY_LORA))
    logw = -jax.nn.softplus(-(w0 + jnp.einsum('btdr,drc->btdc', jnp.tanh(wd), w_up))) - 0.5
    decay = jnp.exp(-jnp.exp(logw))
    a = jax.nn.sigmoid(a0 + jnp.einsum('btr,drc->btdc', ad, a_up))
    g = jax.nn.sigmoid(gd) @ g_up
    kk = split_heads(k * k_k, RW_HEADS)
    kk = kk / jnp.maximum(jnp.sqrt(jnp.sum(kk * kk, axis=-1, keepdims=True)), 1e-12)
    k_dir = k[:, :, None, :] * (1.0 + (a - 1.0) * k_a)
    return r, v, kk, decay, a, k_dir, g


def dir_inputs(feat, d):
    r, v, kk, decay, a, k_dir, _ = feat
    hs = lambda t: split_heads(t, RW_HEADS)
    return hs(r), hs(decay[:, :, d]), hs(k_dir[:, :, d]), hs(v), -kk, kk * hs(a[:, :, d])


def wkv_scan(s0, r, w, k, v, a, b, reverse):
    def step(s, inp):
        r_t, w_t, k_t, v_t, a_t, b_t = inp
        sa = jnp.einsum('bhvk,bhk->bhv', s, a_t)
        s = s * w_t[:, :, None, :] + sa[..., None] * b_t[:, :, None, :] + v_t[..., None] * k_t[:, :, None, :]
        return s, jnp.einsum('bhvk,bhk->bhv', s, r_t)
    xs = tuple(jnp.moveaxis(t, 1, 0) for t in (r, w, k, v, a, b))
    s, ys = lax.scan(step, s0, xs, reverse=reverse)
    return s, jnp.moveaxis(ys, 0, 1)


def rwkv_bonus(inp, r_k):
    r, _, k, v, _, _ = inp
    return jnp.sum(r * k * r_k, axis=-1, keepdims=True) * v


def rwkv_finish(wkv, bonus, g, ln_g, ln_b):
    mu = jnp.mean(wkv, axis=-1, keepdims=True)
    var = jnp.mean(jnp.square(wkv - mu), axis=-1, keepdims=True)
    y = (wkv - mu) * lax.rsqrt(var + RW_GN_EPS) * ln_g.reshape(RW_HEADS, RW_HEAD_DIM) + ln_b.reshape(RW_HEADS, RW_HEAD_DIM)
    y = y + bonus
    return y.reshape(y.shape[:2] + (RW_WIDTH,)) * g


def rwkv_bidir(feat, featc, r_k, ln_g, ln_b, want_ctx):
    B = feat[0].shape[0]
    s0 = jnp.zeros((B, RW_HEADS, RW_HEAD_DIM, RW_HEAD_DIM), jnp.float32)
    wkv, bonus, wkv_c, bonus_c = 0.0, 0.0, 0.0, 0.0
    for d, rev in enumerate((False, True)):
        ix = dir_inputs(feat, d)
        ic = dir_inputs(featc, d)
        s_ctx, y_c = wkv_scan(s0, *ic, reverse=rev)
        _, y_x = wkv_scan(s_ctx, *ix, reverse=rev)
        wkv = wkv + y_x
        bonus = bonus + rwkv_bonus(ix, r_k)
        if want_ctx:
            wkv_c = wkv_c + y_c
            bonus_c = bonus_c + rwkv_bonus(ic, r_k)
    o_x = rwkv_finish(wkv, bonus, feat[6], ln_g, ln_b)
    o_c = rwkv_finish(wkv_c, bonus_c, featc[6], ln_g, ln_b) if want_ctx else None
    return o_x, o_c


def setup_inputs(seed: int = 0) -> dict:
    key = jax.random.key(seed)
    ks = jax.random.split(key, 28)
    nrm = lambda k, shape, s: jax.random.normal(k, shape, jnp.float32) * s
    L = DEPTH
    return {
        'x': nrm(ks[0], (BATCH, SEQ, D_MODEL), 1.0),
        'c': nrm(ks[1], (BATCH, D_MODEL), 1.0),
        'ctx': nrm(ks[2], (BATCH, CTX_LEN, D_MODEL), 1.0),
        'c_ctx': nrm(ks[3], (D_MODEL,), 1.0),
        'norm1_g': 1.0 + nrm(ks[4], (L, D_MODEL), 0.02),
        'norm2_g': 1.0 + nrm(ks[5], (L, D_MODEL), 0.02),
        'w_ada': nrm(ks[6], (L, D_MODEL, 6 * D_MODEL), D_MODEL ** -0.5),
        'b_ada': nrm(ks[7], (L, 6 * D_MODEL), 0.01),
        'w_in': nrm(ks[8], (L, D_MODEL, IN_PROJ), D_MODEL ** -0.5),
        'na_q_g': 1.0 + nrm(ks[9], (L, NA_HEAD_DIM), 0.02),
        'na_k_g': 1.0 + nrm(ks[10], (L, NA_HEAD_DIM), 0.02),
        'na_rpb': nrm(ks[11], (L, NA_HEADS, 2 * NA_WIN_ROWS - 1, 2 * NA_WIN_COLS - 1), 0.2),
        'rw_mu_prev': jax.random.uniform(ks[12], (L, RW_PROJ), jnp.float32, 0.0, 0.5),
        'rw_mu_next': jax.random.uniform(ks[13], (L, RW_PROJ), jnp.float32, 0.0, 0.5),
        'rw_w0': jax.random.uniform(ks[14], (L, 2, RW_WIDTH), jnp.float32, -5.0, 0.0),
        'rw_w_up': nrm(ks[15], (L, 2, DECAY_LORA, RW_WIDTH), 0.5 * DECAY_LORA ** -0.5),
        'rw_a0': nrm(ks[16], (L, 2, RW_WIDTH), 0.5),
        'rw_a_up': nrm(ks[17], (L, 2, AAA_LORA, RW_WIDTH), AAA_LORA ** -0.5),
        'rw_g_up': nrm(ks[18], (L, GATE_LORA, RW_WIDTH), GATE_LORA ** -0.5),
        'rw_k_k': 0.85 + nrm(ks[19], (L, RW_WIDTH), 0.05),
        'rw_k_a': 1.0 + nrm(ks[20], (L, RW_WIDTH), 0.05),
        'rw_r_k': nrm(ks[21], (L, RW_HEADS, RW_HEAD_DIM), 0.1),
        'rw_ln_g': 1.0 + nrm(ks[22], (L, RW_WIDTH), 0.02),
        'rw_ln_b': nrm(ks[23], (L, RW_WIDTH), 0.01),
        'w_out': nrm(ks[24], (L, MIX_WIDTH, D_MODEL), MIX_WIDTH ** -0.5),
        'ffn_w_in': nrm(ks[25], (L, D_MODEL, 2 * D_FF), D_MODEL ** -0.5),
        'ffn_w_out': nrm(ks[26], (L, D_FF, D_MODEL), D_FF ** -0.5),
    }


def reference(x, c, ctx, c_ctx, norm1_g, norm2_g, w_ada, b_ada, w_in, na_q_g, na_k_g, na_rpb,
              rw_mu_prev, rw_mu_next, rw_w0, rw_w_up, rw_a0, rw_a_up, rw_g_up, rw_k_k, rw_k_a,
              rw_r_k, rw_ln_g, rw_ln_b, w_out, ffn_w_in, ffn_w_out):
    silu_c = jax.nn.silu(c)
    silu_cc = jax.nn.silu(c_ctx)
    h, hc = x, ctx
    for l in range(DEPTH):
        last = l == DEPTH - 1
        mod = jnp.split(silu_c @ w_ada[l] + b_ada[l], 6, axis=-1)
        modc = jnp.split(silu_cc @ w_ada[l] + b_ada[l], 6, axis=-1)
        u = modulate(rms_norm(h, norm1_g[l]), mod[0], mod[1])
        uc = modulate(rms_norm(hc, norm1_g[l]), modc[0], modc[1])
        p = u @ w_in[l]
        pc = uc @ w_in[l]
        q, k, v = na_qkv(p[..., :3 * NA_WIDTH], na_q_g[l], na_k_g[l])
        qc, kc, vc = na_qkv(pc[..., :3 * NA_WIDTH], na_q_g[l], na_k_g[l])
        o_na = neighborhood_attention(q, k, v, kc, vc, na_rpb[l])
        rw_args = (rw_mu_prev[l], rw_mu_next[l], rw_w0[l], rw_w_up[l], rw_a0[l], rw_a_up[l],
                   rw_g_up[l], rw_k_k[l], rw_k_a[l])
        feat = rwkv_prep(p[..., 3 * NA_WIDTH:], *rw_args)
        featc = rwkv_prep(pc[..., 3 * NA_WIDTH:], *rw_args)
        o_rw, o_rwc = rwkv_bidir(feat, featc, rw_r_k[l], rw_ln_g[l], rw_ln_b[l], not last)
        mix = jnp.concatenate([o_na, o_rw.astype(h.dtype)], axis=-1) @ w_out[l]
        h = h + mod[2][:, None, :] * mix
        h = h + mod[5][:, None, :] * swiglu(modulate(rms_norm(h, norm2_g[l]), mod[3], mod[4]),
                                            ffn_w_in[l], ffn_w_out[l])
        if not last:
            mixc = jnp.concatenate([context_attention(qc, kc, vc), o_rwc.astype(hc.dtype)], axis=-1) @ w_out[l]
            hc = hc + modc[2] * mixc
            hc = hc + modc[5] * swiglu(modulate(rms_norm(hc, norm2_g[l]), modc[3], modc[4]),
                                       ffn_w_in[l], ffn_w_out[l])
    return h
```

```cpp
#include <hip/hip_runtime.h>
#include <hip/hip_cooperative_groups.h>
#include <cstdio>
namespace cg = cooperative_groups;
namespace pg8 {
#define PG8_LAS __attribute__((address_space(3)))
typedef unsigned short bf16_t;
typedef short bf16x8 __attribute__((ext_vector_type(8)));
typedef float f32x4 __attribute__((ext_vector_type(4)));
typedef unsigned u32x4 __attribute__((ext_vector_type(4)));
constexpr int BM = 256, BK = 64, HALF = 128, HTB = HALF * BK * 2  , STAGE_BYTES = 8 * HTB, NXCD = 8, WGM = 8;

__host__ __device__ __forceinline__ int lds_byte(int r, int c) { const int st = (r >> 4) * 2 + (c >> 5), rr = r & 15, cc = c & 31, ob = rr * 64 + cc * 2; return st * 1024 + (ob ^ (((ob >> 9) & 1) << 5)); }
__host__ __device__ __forceinline__ void stage_rc(int b, int& R, int& C) { const int st = b / 1024, sb = b % 1024, swz = sb ^ (((sb >> 9) & 1) << 5); R = (st >> 1) * 16 + swz / 64; C = (st & 1) * 32 + (swz % 64) / 2; }
__host__ __device__ __forceinline__ int perm32(int rho) { const int n = rho >> 4, i = rho & 15; return 8 * (i >> 2) + 4 * n + (i & 3); }

struct Unit { int pm, pn; };
struct Gemm { const bf16_t* A; const bf16_t* Bt; int M, N, K; };

struct StaticOrder {
    int nM, nN, nwg, G, c;
    __host__ __device__ void init(int M, int N, int G_, int c_) { nM = M / BM; nN = N / BM; nwg = nM * nN; G = G_; c = c_; }
    __host__ __device__ bool next(int i, Unit& u) const {
        const long L = (long)i * G + c; if (L >= nwg) return false;
        int wgid = (int)L; { const int q = nwg / NXCD, r = nwg % NXCD, xcd = wgid % NXCD, off = wgid / NXCD; wgid = (xcd < r ? xcd * (q + 1) : r * (q + 1) + (xcd - r) * q) + off; }
        const int nig = WGM * nN, gid = wgid / nig, fm = gid * WGM, gsz = (nM - fm) < WGM ? (nM - fm) : WGM;
        u.pm = fm + ((wgid % nig) % gsz); u.pn = (wgid % nig) / gsz; return true;
    }
    __device__ __forceinline__ void a_ready(const Unit&) const {}
    __device__ __forceinline__ void done(const Unit&) const {}
};
__device__ __forceinline__ unsigned cvt_pk_bf16(float lo, float hi) { unsigned r; asm volatile("v_cvt_pk_bf16_f32 %0, %1, %2" : "=v"(r) : "v"(lo), "v"(hi)); return r; }
typedef float f32x2 __attribute__((ext_vector_type(2)));
template <class Epi, class Sched, bool STAMP = false>
__device__ __forceinline__ void gemm_phase(PG8_LAS unsigned char* lds, const Gemm g, const Sched& S, const Epi& E, unsigned long long* stamps) {
    const int tid = threadIdx.x, wid = __builtin_amdgcn_readfirstlane(tid >> 6), lane = tid & 63, wr = wid >> 2, wc = wid & 3, fr = lane & 15, fq = lane >> 4;
    const int K = g.K, nt = K / BK;
    int ts_lo = 0, ts_hi = 0, nts = 0; const unsigned long long rt_entry = STAMP ? (unsigned long long)wall_clock64() : 0ull;
#define PG8_STAMP() do { if (STAMP && wid == 0 && nts < 64) { const unsigned long long _c = (unsigned long long)clock64(); \
        ts_lo = (lane == nts) ? (int)(unsigned)_c : ts_lo; ts_hi = (lane == nts) ? (int)(unsigned)(_c >> 32) : ts_hi; ++nts; } } while (0)
    PG8_STAMP();
    unsigned voffA[2], voffB[2];
#pragma unroll
    for (int i = 0; i < 2; ++i) { int R, C; stage_rc(tid * 16 + i * 8192, R, C); const int Rb = Epi::PERM ? ((R & ~31) + perm32(R & 31)) : R;
        voffA[i] = (unsigned)(R * K + C) * 2u; voffB[i] = (unsigned)(Rb * K + C) * 2u; }
    const size_t kstep = (size_t)(BK * 2);
    const size_t hstep = (size_t)HALF * K * 2;
    const size_t tstep = 2 * hstep;
    const unsigned ldsw = (unsigned)wid * 1024u;
    const int aoff = lds_byte(wr * 64 + fr, fq * 8), boff = lds_byte(wc * 32 + fr, fq * 8);
#define PG8_SA(b, h) (((b) * 2 + (h)) * HTB)
#define PG8_SB(b, h) ((4 + (b) * 2 + (h)) * HTB)
#define PG8_STAGE(bufoff, gbase, voff) do { _Pragma("unroll") for (int _i = 0; _i < 2; ++_i) \
        __builtin_amdgcn_global_load_lds((const unsigned*)((const char*)(gbase) + (voff)[_i]), (PG8_LAS unsigned*)(lds + (bufoff) + ldsw + _i * 8192), 16, 0, 0); } while (0)
#define PG8_LDA(dst, b, h) do { _Pragma("unroll") for (int m = 0; m < 4; ++m) _Pragma("unroll") for (int k = 0; k < 2; ++k) dst[m][k] = *(const PG8_LAS bf16x8*)(lds + PG8_SA(b, h) + aoff + m * 2048 + k * 1024); } while (0)
#define PG8_LDB(dst, b, h) do { _Pragma("unroll") for (int n = 0; n < 2; ++n) _Pragma("unroll") for (int k = 0; k < 2; ++k) dst[n][k] = *(const PG8_LAS bf16x8*)(lds + PG8_SB(b, h) + boff + n * 2048 + k * 1024); } while (0)
#define PG8_MMA(ai, bj, At, Bt) do { __builtin_amdgcn_s_setprio(1); _Pragma("unroll") for (int m = 0; m < 4; ++m) _Pragma("unroll") for (int n = 0; n < 2; ++n) _Pragma("unroll") for (int k = 0; k < 2; ++k) \
        acc[ai][bj][m][n] = __builtin_amdgcn_mfma_f32_16x16x32_bf16(Bt[n][k], At[m][k], acc[ai][bj][m][n], 0, 0, 0); __builtin_amdgcn_s_setprio(0); } while (0)
#define PG8_WAIT_V(n) asm volatile("s_waitcnt vmcnt(" #n ")" ::: "memory")
#define PG8_WAIT_L(n) asm volatile("s_waitcnt lgkmcnt(" #n ")" ::: "memory")
#define PG8_BAR __builtin_amdgcn_s_barrier()
#define PG8_SCHED __builtin_amdgcn_sched_barrier(0)
    Unit cur, nxt; int ui = 0;
    if (!S.next(0, cur)) return;
    f32x4 acc[2][2][4][2];
#pragma unroll
    for (int a = 0; a < 2; ++a)
#pragma unroll
        for (int b = 0; b < 2; ++b)
#pragma unroll
            for (int m = 0; m < 4; ++m)
#pragma unroll
                for (int n = 0; n < 2; ++n) acc[a][b][m][n] = (f32x4){0.f, 0.f, 0.f, 0.f};
    bf16x8 At[4][2], B0[2][2], B1[2][2];
    const char* cA = (const char*)g.A + (size_t)cur.pm * tstep; const char* cB = (const char*)g.Bt + (size_t)cur.pn * tstep;
    S.a_ready(cur);
    PG8_STAGE(PG8_SB(0, 0), cB, voffB); PG8_STAGE(PG8_SA(0, 0), cA, voffA); PG8_STAGE(PG8_SB(0, 1), cB + hstep, voffB); PG8_STAGE(PG8_SA(0, 1), cA + hstep, voffA);
    if (wr == 1) PG8_BAR;
    PG8_WAIT_V(4); PG8_BAR;
    PG8_STAGE(PG8_SB(1, 0), cB + kstep, voffB); PG8_STAGE(PG8_SA(1, 0), cA + kstep, voffA); PG8_STAGE(PG8_SB(1, 1), cB + hstep + kstep, voffB);
    PG8_WAIT_V(6); PG8_BAR;
    PG8_STAMP();
    for (;;) {
        const bool has_next = S.next(ui + 1, nxt);
        const char* nA = has_next ? (const char*)g.A + (size_t)nxt.pm * tstep : cA; const char* nB = has_next ? (const char*)g.Bt + (size_t)nxt.pn * tstep : cB;
        for (int t = 0; t < nt; t += 2) {
            const bool last = (t == nt - 2);
            const char* a1 = cA + (size_t)(t + 1) * kstep;
            const char* a2 = last ? nA : cA + (size_t)(t + 2) * kstep; const char* b2 = last ? nB : cB + (size_t)(t + 2) * kstep;
            const char* a3 = a2 + kstep; const char* b3 = b2 + kstep;
            if (last && has_next) S.a_ready(nxt);
            PG8_LDB(B0, 0, 0); PG8_SCHED; PG8_LDA(At, 0, 0); PG8_STAGE(PG8_SA(1, 1), a1 + hstep, voffA);
            PG8_WAIT_L(8); PG8_BAR; PG8_WAIT_L(0); PG8_MMA(0, 0, At, B0); PG8_BAR; PG8_SCHED;
            PG8_LDB(B1, 0, 1); PG8_STAGE(PG8_SB(0, 0), b2, voffB);
            PG8_BAR; PG8_WAIT_L(0); PG8_MMA(0, 1, At, B1); PG8_BAR;
            PG8_LDA(At, 0, 1); PG8_STAGE(PG8_SA(0, 0), a2, voffA);
            PG8_BAR; PG8_WAIT_L(0); PG8_MMA(1, 0, At, B0); PG8_BAR; PG8_SCHED;
            PG8_STAGE(PG8_SB(0, 1), b2 + hstep, voffB);
            PG8_WAIT_V(6); PG8_BAR; PG8_MMA(1, 1, At, B1); PG8_BAR;
            PG8_LDB(B0, 1, 0); PG8_SCHED; PG8_LDA(At, 1, 0); PG8_STAGE(PG8_SA(0, 1), a2 + hstep, voffA);
            PG8_WAIT_L(8); PG8_BAR; PG8_WAIT_L(0); PG8_MMA(0, 0, At, B0); PG8_BAR; PG8_SCHED;
            PG8_LDB(B1, 1, 1); PG8_STAGE(PG8_SB(1, 0), b3, voffB);
            PG8_BAR; PG8_WAIT_L(0); PG8_MMA(0, 1, At, B1); PG8_BAR;
            PG8_LDA(At, 1, 1); PG8_STAGE(PG8_SA(1, 0), a3, voffA);
            PG8_BAR; PG8_WAIT_L(0); PG8_MMA(1, 0, At, B0); PG8_BAR; PG8_SCHED;
            PG8_STAGE(PG8_SB(1, 1), b3 + hstep, voffB);
            PG8_WAIT_V(6); PG8_BAR; PG8_MMA(1, 1, At, B1); PG8_BAR;
        }
        PG8_STAMP();
        if constexpr (!Epi::AFTER_DRAIN) { E(acc, cur, wr, wc, fr, fq); S.done(cur); }
        PG8_STAMP();
        if (!has_next) break;
#pragma unroll
        for (int a = 0; a < 2; ++a)
#pragma unroll
            for (int b = 0; b < 2; ++b)
#pragma unroll
                for (int m = 0; m < 4; ++m)
#pragma unroll
                    for (int n = 0; n < 2; ++n) acc[a][b][m][n] = (f32x4){0.f, 0.f, 0.f, 0.f};
        cur = nxt; cA = nA; cB = nB; ++ui;
    }
    PG8_WAIT_V(0);
    if (wr == 0) PG8_BAR;
    PG8_BAR;
    if constexpr (Epi::AFTER_DRAIN) { E.fused(acc, cur, wr, wc, fr, fq, lds, wid, lane); S.done(cur); }
    PG8_STAMP();
    if (STAMP && wid == 0) { stamps[lane] = lane < nts ? (((unsigned long long)(unsigned)ts_hi << 32) | (unsigned)ts_lo) : 0ull;
        if (lane == 62) stamps[62] = rt_entry; if (lane == 63) stamps[63] = (unsigned long long)wall_clock64(); }
#undef PG8_STAMP
#undef PG8_SA
#undef PG8_SB
#undef PG8_STAGE
#undef PG8_LDA
#undef PG8_LDB
#undef PG8_MMA
#undef PG8_WAIT_V
#undef PG8_WAIT_L
#undef PG8_BAR
#undef PG8_SCHED
}
}
using pg8::bf16_t; using pg8::bf16x8; using pg8::f32x4; using pg8::u32x4; using pg8::Unit;
typedef unsigned u32x2 __attribute__((ext_vector_type(2)));
typedef short s16x4 __attribute__((ext_vector_type(4)));
#define LAS __attribute__((address_space(3)))

constexpr int D = 1024, NB = 2, T = 16384, LC = 256, MT = NB * T, MC = NB * LC, MA = MT + MC;
constexpr int RWP = 1856, INP = 3392, INPP = 3584, DFF = 2816;
constexpr int LDS_BYTES = 131072;
constexpr int NCHAIN = 32;

constexpr size_t OFF_MOD = 0;
constexpr size_t OFF_WIN = 131072;
constexpr size_t OFF_WOUT = OFF_WIN + (size_t)INPP * 1024 * 2;
constexpr size_t OFF_WF1 = OFF_WOUT + (size_t)1024 * 1024 * 2;
constexpr size_t OFF_WF2 = OFF_WF1 + (size_t)5632 * 1024 * 2;
constexpr size_t OFF_MIX = OFF_WF2 + (size_t)1024 * 2816 * 2;
constexpr size_t OFF_U = OFF_MIX + (size_t)MT * 1024 * 2;
constexpr size_t OFF_Q = OFF_U + (size_t)MA * 1024 * 2;
constexpr size_t OFF_K = OFF_Q + (size_t)MA * 512 * 2;
constexpr size_t OFF_VT = OFF_K + (size_t)MA * 512 * 2;
constexpr size_t OFF_VTC = OFF_VT + (size_t)NB * 8 * 64 * T * 2;
constexpr size_t OFF_PR = OFF_VTC + (size_t)NB * 8 * 64 * LC * 2;
constexpr size_t OFF_Y0 = OFF_PR + (size_t)MA * RWP * 2;
constexpr size_t OFF_Y1 = OFF_Y0 + (size_t)MT * 512 * 4;
constexpr size_t OFF_BON = OFF_Y1 + (size_t)MT * 512 * 4;
constexpr size_t OFF_END = OFF_BON + (size_t)NCHAIN * T * 4;
constexpr size_t OFF_ACT = OFF_Q;
static_assert(OFF_ACT + (size_t)MT * DFF * 2 <= OFF_Y0, "ACT alias overflow");

struct Params {
    const float* in[27];
    float* out; unsigned char* ws;
    int ph_lo, ph_hi;
};

__device__ __forceinline__ float bf2f(bf16_t v) { return __uint_as_float(((unsigned)v) << 16); }
__device__ __forceinline__ bf16_t f2bf(float f) { unsigned u = __float_as_uint(f); u += 0x7FFFu + ((u >> 16) & 1u); return (bf16_t)(u >> 16); }
__device__ __forceinline__ unsigned pk2(float lo, float hi) { return (unsigned)f2bf(lo) | ((unsigned)f2bf(hi) << 16); }
__device__ __forceinline__ float wave_sum(float v) {
#pragma unroll
    for (int o = 1; o < 64; o <<= 1) v += __shfl_xor(v, o);
    return v;
}
__device__ __forceinline__ float silu_f(float x) { return x / (1.0f + __expf(-x)); }
__device__ __forceinline__ float sigmoid_f(float x) { return 1.0f / (1.0f + __expf(-x)); }

struct EpiIn {
    static constexpr bool PERM = false, AFTER_DRAIN = false;
    bf16_t *Q, *K, *VT, *VTC, *PR; const float *qg, *kg;
    __device__ __forceinline__ void operator()(const f32x4 (&acc)[2][2][4][2], const Unit& u, int wr, int wc, int fr, int fq) const {
        const int c0 = u.pn * 256 + wc * 64;
        const int row0 = u.pm * 256 + wr * 64 + fr;
        if (c0 < 1024) {
            const bool isq = c0 < 512; const float* g = isq ? qg : kg; bf16_t* dst = isq ? Q : K; const int cc = c0 & 511; const float sc = isq ? 0.125f : 1.0f;
            f32x4 gv[2][2];
#pragma unroll
            for (int bj = 0; bj < 2; ++bj)
#pragma unroll
                for (int n = 0; n < 2; ++n) gv[bj][n] = *(const f32x4*)(g + 32 * bj + 16 * n + 4 * fq) * sc;
#pragma unroll
            for (int ai = 0; ai < 2; ++ai)
#pragma unroll
                for (int m = 0; m < 4; ++m) {
                    float ss = 0.f;
#pragma unroll
                    for (int bj = 0; bj < 2; ++bj)
#pragma unroll
                        for (int n = 0; n < 2; ++n) { const f32x4 x = acc[ai][bj][m][n]; ss += (x[0] * x[0] + x[1] * x[1]) + (x[2] * x[2] + x[3] * x[3]); }
                    ss += __shfl_xor(ss, 16); ss += __shfl_xor(ss, 32);
                    const float rstd = rsqrtf(ss * (1.0f / 64.0f) + 1e-6f);
                    bf16_t* rowp = dst + (size_t)(row0 + ai * 128 + m * 16) * 512 + cc + 4 * fq;
#pragma unroll
                    for (int bj = 0; bj < 2; ++bj)
#pragma unroll
                        for (int n = 0; n < 2; ++n) { const f32x4 y = acc[ai][bj][m][n] * rstd * gv[bj][n];
                            u32x2 w; w.x = pk2(y[0], y[1]); w.y = pk2(y[2], y[3]); *(u32x2*)(rowp + 32 * bj + 16 * n) = w; }
                }
        } else if (c0 < 1536) {
            const int h = (c0 - 1024) >> 6;
#pragma unroll
            for (int ai = 0; ai < 2; ++ai)
#pragma unroll
                for (int m = 0; m < 4; ++m) {
                    const int r = row0 + ai * 128 + m * 16;
                    bf16_t* base; size_t stride;
                    if (r < MT) { const int b = r / T, t = r % T; base = VT + ((size_t)(b * 8 + h) * 64) * T + t; stride = T; }
                    else { const int rc = r - MT, b = rc / LC, l = rc % LC; base = VTC + ((size_t)(b * 8 + h) * 64) * LC + l; stride = LC; }
#pragma unroll
                    for (int bj = 0; bj < 2; ++bj)
#pragma unroll
                        for (int n = 0; n < 2; ++n)
#pragma unroll
                            for (int e = 0; e < 4; ++e) base[(size_t)(32 * bj + 16 * n + 4 * fq + e) * stride] = f2bf(acc[ai][bj][m][n][e]);
                }
        } else {
            const int cr = c0 - 1536;
            if (cr >= RWP) return;
#pragma unroll
            for (int ai = 0; ai < 2; ++ai)
#pragma unroll
                for (int m = 0; m < 4; ++m) {
                    bf16_t* rowp = PR + (size_t)(row0 + ai * 128 + m * 16) * RWP + cr + 4 * fq;
#pragma unroll
                    for (int bj = 0; bj < 2; ++bj)
#pragma unroll
                        for (int n = 0; n < 2; ++n) { const f32x4 y = acc[ai][bj][m][n];
                            u32x2 w; w.x = pk2(y[0], y[1]); w.y = pk2(y[2], y[3]); *(u32x2*)(rowp + 32 * bj + 16 * n) = w; }
                }
        }
    }
};
struct EpiRes {
    static constexpr bool PERM = false, AFTER_DRAIN = false;
    const float* base; float* out; const float* gate;
    __device__ __forceinline__ void operator()(const f32x4 (&acc)[2][2][4][2], const Unit& u, int wr, int wc, int fr, int fq) const {
        const int c0 = u.pn * 256 + wc * 64 + 4 * fq;
        const int row0 = u.pm * 256 + wr * 64 + fr;
#pragma unroll
        for (int ai = 0; ai < 2; ++ai)
#pragma unroll
            for (int m = 0; m < 4; ++m) {
                const int r = row0 + ai * 128 + m * 16; const int b = r / T;
#pragma unroll
                for (int bj = 0; bj < 2; ++bj)
#pragma unroll
                    for (int n = 0; n < 2; ++n) { const int c = c0 + 32 * bj + 16 * n;
                        const f32x4 gt = *(const f32x4*)(gate + (size_t)b * 6144 + c);
                        const f32x4 bs = *(const f32x4*)(base + (size_t)r * 1024 + c);
                        *(f32x4*)(out + (size_t)r * 1024 + c) = bs + gt * acc[ai][bj][m][n]; }
            }
    }
};
struct EpiGlu {
    static constexpr bool PERM = false, AFTER_DRAIN = false;
    bf16_t* ACT;
    __device__ __forceinline__ void operator()(const f32x4 (&acc)[2][2][4][2], const Unit& u, int wr, int wc, int fr, int fq) const {
        const int g0 = u.pn * 128 + wc * 32 + 4 * fq;
        const int row0 = u.pm * 256 + wr * 64 + fr;
#pragma unroll
        for (int ai = 0; ai < 2; ++ai)
#pragma unroll
            for (int m = 0; m < 4; ++m) {
                bf16_t* rowp = ACT + (size_t)(row0 + ai * 128 + m * 16) * DFF + g0;
#pragma unroll
                for (int n = 0; n < 2; ++n) { const f32x4 ga = acc[ai][0][m][n], up = acc[ai][1][m][n];
                    u32x2 w; w.x = pk2(silu_f(ga[0]) * up[0], silu_f(ga[1]) * up[1]); w.y = pk2(silu_f(ga[2]) * up[2], silu_f(ga[3]) * up[3]);
                    *(u32x2*)(rowp + 16 * n) = w; }
            }
    }
};

__device__ __forceinline__ void transpose_item(const float* W, int K, int Nsrc, int src_col0, bf16_t* WT, int dest_row0, int k0, LAS float* scr, int lane) {
    const int c = lane & 7;
    if (src_col0 < 0) {
#pragma unroll
        for (int j = 0; j < 4; ++j) { const int n = (lane >> 3) + 8 * j; *(u32x4*)(WT + (size_t)(dest_row0 + n) * K + k0 + 8 * c) = (u32x4){0u, 0u, 0u, 0u}; }
        return;
    }
#pragma unroll 8
    for (int i = 0; i < 32; ++i) { const int kk = 2 * i + (lane >> 5); scr[kk * 33 + (lane & 31)] = W[(size_t)(k0 + kk) * Nsrc + src_col0 + (lane & 31)]; }
    asm volatile("s_waitcnt lgkmcnt(0)" ::: "memory");
#pragma unroll
    for (int j = 0; j < 4; ++j) { const int n = (lane >> 3) + 8 * j; const LAS float* s = scr + (8 * c) * 33 + n;
        u32x4 o; o.x = pk2(s[0 * 33], s[1 * 33]); o.y = pk2(s[2 * 33], s[3 * 33]); o.z = pk2(s[4 * 33], s[5 * 33]); o.w = pk2(s[6 * 33], s[7 * 33]);
        *(u32x4*)(WT + (size_t)(dest_row0 + n) * K + k0 + 8 * c) = o; }
    asm volatile("s_waitcnt lgkmcnt(0)" ::: "memory");
}
__device__ __forceinline__ void phase0(const Params& p, LAS unsigned char* lds) {
    const int tid = threadIdx.x, lane = tid & 63, wave = tid >> 6;
    const float* c = p.in[1]; const float* cctx = p.in[3]; const float* w_ada = p.in[6]; const float* b_ada = p.in[7];
    float* mod = (float*)(p.ws + OFF_MOD);
    LAS float* red = (LAS float*)lds;
    for (int cb = blockIdx.x; cb < 256; cb += gridDim.x) {
        const int ks = tid / 6, cgp = tid % 6, col = cb * 24 + cgp * 4;
        if (ks < 84) {
            f32x4 a0 = {0.f, 0.f, 0.f, 0.f}, a1 = a0, a2 = a0;
            for (int k = ks; k < 1024; k += 84) {
                const f32x4 w = *(const f32x4*)(w_ada + (size_t)k * 6144 + col);
                a0 += w * silu_f(c[k]); a1 += w * silu_f(c[1024 + k]); a2 += w * silu_f(cctx[k]);
            }
#pragma unroll
            for (int e = 0; e < 4; ++e) { red[ks * 72 + cgp * 4 + e] = a0[e]; red[ks * 72 + 24 + cgp * 4 + e] = a1[e]; red[ks * 72 + 48 + cgp * 4 + e] = a2[e]; }
        }
        __syncthreads();
        if (tid < 72) { float s = 0.f; for (int k = 0; k < 84; ++k) s += red[k * 72 + tid];
            const int r = tid / 24, cc = cb * 24 + tid % 24; mod[r * 6144 + cc] = s + b_ada[cc]; }
        __syncthreads();
    }
    LAS float* scr = (LAS float*)(lds + 32768 + wave * 8704);
    const int gw = blockIdx.x * 8 + wave, NGW = gridDim.x * 8;
    constexpr int I_IN = (INPP / 32) * 16, I_OUT = 32 * 16, I_F1 = (5632 / 32) * 16, I_F2 = 32 * 44;
    for (int it = gw; it < I_IN + I_OUT + I_F1 + I_F2; it += NGW) {
        int r = it;
        if (r < I_IN) { const int gd = r >> 4, kc = r & 15, t0 = gd * 32, pn = t0 >> 8, bj = (t0 >> 7) & 1, wc = (t0 >> 5) & 3, a0 = pn * 256 + wc * 64 + bj * 32;
            transpose_item(p.in[8], 1024, INP, a0 < INP ? a0 : -1, (bf16_t*)(p.ws + OFF_WIN), t0, kc * 64, scr, lane); continue; }
        r -= I_IN;
        if (r < I_OUT) { const int gd = r >> 4, kc = r & 15, t0 = gd * 32, pn = t0 >> 8, bj = (t0 >> 7) & 1, wc = (t0 >> 5) & 3, a0 = pn * 256 + wc * 64 + bj * 32;
            transpose_item(p.in[24], 1024, 1024, a0, (bf16_t*)(p.ws + OFF_WOUT), t0, kc * 64, scr, lane); continue; }
        r -= I_OUT;
        if (r < I_F1) { const int gd = r >> 4, kc = r & 15, t0 = gd * 32, pn = t0 >> 8, bj = (t0 >> 7) & 1, wc = (t0 >> 5) & 3, src = pn * 128 + wc * 32 + bj * DFF;
            transpose_item(p.in[25], 1024, 2 * DFF, src, (bf16_t*)(p.ws + OFF_WF1), t0, kc * 64, scr, lane); continue; }
        r -= I_F1;
        { const int gd = r / 44, kc = r % 44, t0 = gd * 32, pn = t0 >> 8, bj = (t0 >> 7) & 1, wc = (t0 >> 5) & 3, a0 = pn * 256 + wc * 64 + bj * 32;
            transpose_item(p.in[26], DFF, 1024, a0, (bf16_t*)(p.ws + OFF_WF2), t0, kc * 64, scr, lane); }
    }
}

__device__ __forceinline__ void phase_norm(const Params& p, int which) {
    const int lane = threadIdx.x & 63, wave = threadIdx.x >> 6;
    const float* mod = (const float*)(p.ws + OFF_MOD);
    const float* g = which ? p.in[5] : p.in[4];
    bf16_t* U = (bf16_t*)(p.ws + OFF_U);
    const int nrows = which ? MT : MA, shoff = which ? 3 * 1024 : 0, scoff = which ? 4 * 1024 : 1024;
    for (int row = blockIdx.x * 8 + wave; row < nrows; row += gridDim.x * 8) {
        const float* src; int mrow;
        if (which) { src = p.out + (size_t)row * 1024; mrow = row / T; }
        else if (row < MT) { src = p.in[0] + (size_t)row * 1024; mrow = row / T; }
        else { src = p.in[2] + (size_t)(row - MT) * 1024; mrow = 2; }
        f32x4 v[4]; float ss = 0.f;
#pragma unroll
        for (int j = 0; j < 4; ++j) { v[j] = ((const f32x4*)src)[lane + 64 * j]; ss += (v[j][0] * v[j][0] + v[j][1] * v[j][1]) + (v[j][2] * v[j][2] + v[j][3] * v[j][3]); }
        const float rstd = rsqrtf(wave_sum(ss) * (1.0f / 1024.0f) + 1e-6f);
#pragma unroll
        for (int j = 0; j < 4; ++j) { const int col = 4 * (lane + 64 * j);
            const f32x4 gg = *(const f32x4*)(g + col), sc = *(const f32x4*)(mod + mrow * 6144 + scoff + col), sh = *(const f32x4*)(mod + mrow * 6144 + shoff + col);
            const f32x4 y = v[j] * rstd * gg * (sc + 1.0f) + sh;
            u32x2 w; w.x = pk2(y[0], y[1]); w.y = pk2(y[2], y[3]); *(u32x2*)(U + (size_t)row * 1024 + col) = w; }
    }
}
__device__ __forceinline__ void na_task(const Params& p, int b, int h, int i, int j, int lane) {
    const int fr = lane & 15, fq = lane >> 4;
    const bf16_t* Q = (const bf16_t*)(p.ws + OFF_Q); const bf16_t* K = (const bf16_t*)(p.ws + OFF_K);
    const bf16_t* VT = (const bf16_t*)(p.ws + OFF_VT); const bf16_t* VTC = (const bf16_t*)(p.ws + OFF_VTC);
    const float* rpb = p.in[11] + h * 15 * 31;
    bf16_t* MIX = (bf16_t*)(p.ws + OFF_MIX);
    const size_t qrow = (size_t)b * T + i * 64 + 16 * j + fr;
    const bf16_t* qp = Q + qrow * 512 + h * 64 + 8 * fq;
    const bf16x8 q0 = *(const bf16x8*)qp, q1 = *(const bf16x8*)(qp + 32);
    const int rs = min(max(i - 4, 0), 248);
    const int cb = (j == 0) ? 0 : (j == 1) ? 8 : (j == 2) ? 24 : 32;
    const int c = 16 * j + fr, cs = min(max(c - 8, 0), 48);
    float m_run = -INFINITY, l_run = 0.f;
    f32x4 o[4];
#pragma unroll
    for (int dt = 0; dt < 4; ++dt) o[dt] = (f32x4){0.f, 0.f, 0.f, 0.f};
    const bf16_t* vt_base = VT + ((size_t)(b * 8 + h) * 64 + fr) * T;
    const bf16_t* vtc_base = VTC + ((size_t)(b * 8 + h) * 64 + fr) * LC;
#pragma unroll 1
    for (int grp = 0; grp < 4; ++grp) {
        f32x4 s[8];
        const bool win = grp < 2;
#pragma unroll
        for (int kt = 0; kt < 8; ++kt) {
            size_t krow; int rr = 0, nt = 0;
            if (win) { rr = grp * 4 + (kt >> 1); nt = kt & 1; krow = (size_t)b * T + (rs + rr) * 64 + cb + 16 * nt + fr; }
            else { krow = (size_t)MT + b * LC + (grp - 2) * 128 + kt * 16 + fr; }
            const bf16_t* kp = K + krow * 512 + h * 64 + 8 * fq;
            const bf16x8 k0 = *(const bf16x8*)kp, k1 = *(const bf16x8*)(kp + 32);
            f32x4 a = {0.f, 0.f, 0.f, 0.f};
            a = __builtin_amdgcn_mfma_f32_16x16x32_bf16(k0, q0, a, 0, 0, 0);
            a = __builtin_amdgcn_mfma_f32_16x16x32_bf16(k1, q1, a, 0, 0, 0);
            if (win) {
                const int di = rs + rr - i + 7;
#pragma unroll
                for (int e = 0; e < 4; ++e) { const int kc = cb + 16 * nt + 4 * fq + e; const bool valid = (kc >= cs) && (kc < cs + 16);
                    const int dj = kc - c + 15;
                    a[e] = valid ? a[e] + rpb[di * 31 + (valid ? dj : 0)] : -INFINITY; }
            }
            s[kt] = a;
        }
        float gmax = -INFINITY;
#pragma unroll
        for (int kt = 0; kt < 8; ++kt)
#pragma unroll
            for (int e = 0; e < 4; ++e) gmax = fmaxf(gmax, s[kt][e]);
        gmax = fmaxf(gmax, __shfl_xor(gmax, 16)); gmax = fmaxf(gmax, __shfl_xor(gmax, 32));
        const float m_new = fmaxf(m_run, gmax);
        const float alpha = __expf(m_run - m_new);
        float psum = 0.f;
#pragma unroll
        for (int kt = 0; kt < 8; ++kt)
#pragma unroll
            for (int e = 0; e < 4; ++e) { const float pv = __expf(s[kt][e] - m_new); psum += pv; s[kt][e] = pv; }
        psum += __shfl_xor(psum, 16); psum += __shfl_xor(psum, 32);
        l_run = l_run * alpha + psum; m_run = m_new;
#pragma unroll
        for (int dt = 0; dt < 4; ++dt) o[dt] *= alpha;
#pragma unroll
        for (int k2 = 0; k2 < 4; ++k2) {
            u32x4 pw; pw.x = pk2(s[2 * k2][0], s[2 * k2][1]); pw.y = pk2(s[2 * k2][2], s[2 * k2][3]); pw.z = pk2(s[2 * k2 + 1][0], s[2 * k2 + 1][1]); pw.w = pk2(s[2 * k2 + 1][2], s[2 * k2 + 1][3]);
            const bf16x8 pb = __builtin_bit_cast(bf16x8, pw);
            const bf16_t* vp; size_t dstride;
            if (win) { vp = vt_base + (size_t)(rs + grp * 4 + k2) * 64 + cb + 4 * fq; dstride = (size_t)16 * T; }
            else { vp = vtc_base + (grp - 2) * 128 + k2 * 32 + 4 * fq; dstride = (size_t)16 * LC; }
#pragma unroll
            for (int dt = 0; dt < 4; ++dt) {
                const u32x2 lo = *(const u32x2*)(vp + dt * dstride), hi = *(const u32x2*)(vp + dt * dstride + 16);
                u32x4 vw; vw.x = lo.x; vw.y = lo.y; vw.z = hi.x; vw.w = hi.y;
                o[dt] = __builtin_amdgcn_mfma_f32_16x16x32_bf16(__builtin_bit_cast(bf16x8, vw), pb, o[dt], 0, 0, 0);
            }
        }
    }
    const float inv = 1.0f / l_run;
    bf16_t* op = MIX + qrow * 1024 + h * 64 + 4 * fq;
#pragma unroll
    for (int dt = 0; dt < 4; ++dt) { const f32x4 y = o[dt] * inv; u32x2 w; w.x = pk2(y[0], y[1]); w.y = pk2(y[2], y[3]); *(u32x2*)(op + 16 * dt) = w; }
}
__device__ __forceinline__ void phase_na(const Params& p, int blk, int nblk) {
    const int lane = threadIdx.x & 63, wave = threadIdx.x >> 6;
    for (int u = blk; u < NB * 256 * 4; u += nblk) {
        const int hp = u & 3, i = (u >> 2) & 255, b = u >> 10;
        na_task(p, b, hp * 2 + (wave >> 2), i, wave & 3, lane);
    }
}

constexpr int SC = 32;
__device__ __forceinline__ void scan_pos(int s, int b, int d, int& row, bool& hasp, bool& hasn, int& t) {
    if (s < LC) { const int l = d ? (LC - 1 - s) : s; row = MT + b * LC + l; hasp = l > 0; hasn = l < LC - 1; t = -1; }
    else { t = d ? (T - 1 - (s - LC)) : (s - LC); row = b * T + t; hasp = t > 0; hasn = t < T - 1; }
}
__device__ __forceinline__ void phase_scan(const Params& p, LAS unsigned char* lds, int ch) {
    const int tid = threadIdx.x;
    const int b = ch >> 4, h = (ch >> 1) & 7, d = ch & 1;
    const bf16_t* PR = (const bf16_t*)(p.ws + OFF_PR);
    float* Y = (float*)(p.ws + (d ? OFF_Y1 : OFF_Y0));
    float* BON = (float*)(p.ws + OFF_BON) + (size_t)ch * T;
    const float* mup = p.in[12]; const float* mun = p.in[13];
    LAS float* WUP = (LAS float*)lds;
    LAS float* AUP = WUP + 4096;
    LAS float* XW = AUP + 4096;
    LAS float* XA = XW + SC * 64;
    LAS float* R = XA + SC * 64;
    LAS float* Kd = R + SC * 64;
    LAS float* V = Kd + SC * 64;
    LAS float* Wd = V + SC * 64;
    LAS float* Av = Wd + SC * 64;
    LAS float* Bv = Av + SC * 64;
    LAS float* Yl = Bv + SC * 64;
    for (int idx = tid; idx < 4096; idx += 512) { const int r = idx >> 6, cc = idx & 63;
        WUP[idx] = p.in[15][(size_t)(d * 64 + r) * 512 + h * 64 + cc]; AUP[idx] = p.in[17][(size_t)(d * 64 + r) * 512 + h * 64 + cc]; }
    const int tl2 = tid >> 4, cg4 = (tid & 15) * 4;
    float w0v[4], a0v[4], kkv[4], kav[4], rkv[4];
#pragma unroll
    for (int e = 0; e < 4; ++e) { const int hc = h * 64 + cg4 + e; w0v[e] = p.in[14][d * 512 + hc]; a0v[e] = p.in[16][d * 512 + hc]; kkv[e] = p.in[19][hc]; kav[e] = p.in[20][hc]; rkv[e] = p.in[21][hc]; }
    const int rv = tid >> 3, seg = tid & 7;
    float st[8];
#pragma unroll
    for (int e = 0; e < 8; ++e) st[e] = 0.f;
    __syncthreads();
#pragma unroll 1
    for (int s0 = 0; s0 < LC + T; s0 += SC) {
        for (int idx = tid; idx < SC * 320; idx += 512) {
            const int tl = idx / 320, ci = idx % 320, which = ci >> 6, cc = ci & 63;
            const int col = which == 0 ? h * 64 + cc : which == 1 ? 512 + h * 64 + cc : which == 2 ? 1024 + h * 64 + cc : which == 3 ? 1536 + d * 64 + cc : 1664 + cc;
            int row, t; bool hp_, hn_; scan_pos(s0 + tl, b, d, row, hp_, hn_, t);
            const float pc = bf2f(PR[(size_t)row * RWP + col]);
            const float pp = hp_ ? bf2f(PR[(size_t)(row - 1) * RWP + col]) : 0.f;
            const float pn = hn_ ? bf2f(PR[(size_t)(row + 1) * RWP + col]) : 0.f;
            float val = pc + mup[col] * (pp - pc) + mun[col] * (pn - pc);
            if (which == 3) val = tanhf(val);
            LAS float* dst = which == 0 ? R : which == 1 ? Kd : which == 2 ? V : which == 3 ? XW : XA;
            dst[tl * 64 + cc] = val;
        }
        __syncthreads();
        {
            float lw[4], la[4];
#pragma unroll
            for (int e = 0; e < 4; ++e) { lw[e] = w0v[e]; la[e] = a0v[e]; }
            for (int r = 0; r < 64; ++r) { const float xw = XW[tl2 * 64 + r], xa = XA[tl2 * 64 + r];
                const f32x4 wv = *(const LAS f32x4*)(WUP + r * 64 + cg4), av = *(const LAS f32x4*)(AUP + r * 64 + cg4);
#pragma unroll
                for (int e = 0; e < 4; ++e) { lw[e] += xw * wv[e]; la[e] += xa * av[e]; } }
            const f32x4 kr = *(const LAS f32x4*)(Kd + tl2 * 64 + cg4), rr4 = *(const LAS f32x4*)(R + tl2 * 64 + cg4);
            float kkr[4], ss = 0.f;
#pragma unroll
            for (int e = 0; e < 4; ++e) { kkr[e] = kr[e] * kkv[e]; ss += kkr[e] * kkr[e]; }
            ss += __shfl_xor(ss, 1); ss += __shfl_xor(ss, 2); ss += __shfl_xor(ss, 4); ss += __shfl_xor(ss, 8);
            const float inv = 1.0f / fmaxf(sqrtf(ss), 1e-12f);
            f32x4 wo, ao, bo, ko; float bon = 0.f;
#pragma unroll
            for (int e = 0; e < 4; ++e) {
                const float z = -lw[e]; const float sp = z > 20.f ? z : log1pf(expf(z));
                const float logw = -sp - 0.5f;
                wo[e] = expf(-expf(logw));
                const float a = sigmoid_f(la[e]);
                const float kk = kkr[e] * inv;
                ao[e] = -kk; bo[e] = kk * a;
                ko[e] = kr[e] * (1.0f + (a - 1.0f) * kav[e]);
                bon += rr4[e] * ko[e] * rkv[e];
            }
            bon += __shfl_xor(bon, 1); bon += __shfl_xor(bon, 2); bon += __shfl_xor(bon, 4); bon += __shfl_xor(bon, 8);
            *(LAS f32x4*)(Wd + tl2 * 64 + cg4) = wo; *(LAS f32x4*)(Av + tl2 * 64 + cg4) = ao; *(LAS f32x4*)(Bv + tl2 * 64 + cg4) = bo; *(LAS f32x4*)(Kd + tl2 * 64 + cg4) = ko;
            if ((tid & 15) == 0 && s0 >= LC) { int row, t; bool x1, x2; scan_pos(s0 + tl2, b, d, row, x1, x2, t); BON[t] = bon; }
        }
        __syncthreads();
#pragma unroll 2
        for (int stp = 0; stp < SC; ++stp) {
            const LAS float* base = (const LAS float*)0; (void)base;
            const int o8 = stp * 64 + seg * 8;
            const f32x4 a_lo = *(const LAS f32x4*)(Av + o8), a_hi = *(const LAS f32x4*)(Av + o8 + 4);
            const f32x4 w_lo = *(const LAS f32x4*)(Wd + o8), w_hi = *(const LAS f32x4*)(Wd + o8 + 4);
            const f32x4 b_lo = *(const LAS f32x4*)(Bv + o8), b_hi = *(const LAS f32x4*)(Bv + o8 + 4);
            const f32x4 k_lo = *(const LAS f32x4*)(Kd + o8), k_hi = *(const LAS f32x4*)(Kd + o8 + 4);
            const f32x4 r_lo = *(const LAS f32x4*)(R + o8), r_hi = *(const LAS f32x4*)(R + o8 + 4);
            const float vv = V[stp * 64 + rv];
            float sa = 0.f;
#pragma unroll
            for (int e = 0; e < 4; ++e) { sa += st[e] * a_lo[e]; sa += st[4 + e] * a_hi[e]; }
            sa += __shfl_xor(sa, 1); sa += __shfl_xor(sa, 2); sa += __shfl_xor(sa, 4);
            float y = 0.f;
#pragma unroll
            for (int e = 0; e < 4; ++e) {
                st[e] = st[e] * w_lo[e] + sa * b_lo[e] + vv * k_lo[e];
                st[4 + e] = st[4 + e] * w_hi[e] + sa * b_hi[e] + vv * k_hi[e];
                y += st[e] * r_lo[e]; y += st[4 + e] * r_hi[e];
            }
            y += __shfl_xor(y, 1); y += __shfl_xor(y, 2); y += __shfl_xor(y, 4);
            if (seg == 0) Yl[stp * 64 + rv] = y;
        }
        __syncthreads();
        if (s0 >= LC) {
            for (int idx = tid; idx < SC * 64; idx += 512) { const int tl = idx >> 6, n = idx & 63; int row, t; bool x1, x2; scan_pos(s0 + tl, b, d, row, x1, x2, t);
                Y[(size_t)row * 512 + h * 64 + n] = Yl[idx]; }
        }
    }
}

__device__ __forceinline__ void phase_finish(const Params& p, LAS unsigned char* lds) {
    const int tid = threadIdx.x, lane = tid & 63, wave = tid >> 6;
    const bf16_t* PR = (const bf16_t*)(p.ws + OFF_PR);
    const float* Y0 = (const float*)(p.ws + OFF_Y0); const float* Y1 = (const float*)(p.ws + OFF_Y1);
    const float* BON = (const float*)(p.ws + OFF_BON);
    bf16_t* MIX = (bf16_t*)(p.ws + OFF_MIX);
    const float* mup = p.in[12]; const float* mun = p.in[13]; const float* g_up = p.in[18];
    LAS float* sig = (LAS float*)lds;
    const int c = tid;
    const float lng = p.in[22][c], lnb = p.in[23][c];
    const float mpv = mup[1024 + c], mnv = mun[1024 + c];
    for (int tile = blockIdx.x; tile < MT / 32; tile += gridDim.x) {
        const int row0 = tile * 32;
        for (int idx = tid; idx < 32 * 128; idx += 512) { const int tl = idx >> 7, jj = idx & 127, col = 1728 + jj; const int row = row0 + tl, t = row % T;
            const float pc = bf2f(PR[(size_t)row * RWP + col]);
            const float pp = t > 0 ? bf2f(PR[(size_t)(row - 1) * RWP + col]) : 0.f;
            const float pn = t < T - 1 ? bf2f(PR[(size_t)(row + 1) * RWP + col]) : 0.f;
            sig[idx] = sigmoid_f(pc + mup[col] * (pp - pc) + mun[col] * (pn - pc)); }
        __syncthreads();
        float g[32];
#pragma unroll
        for (int t = 0; t < 32; ++t) g[t] = 0.f;
        for (int j4 = 0; j4 < 128; j4 += 4) {
            const float gu0 = g_up[(size_t)(j4 + 0) * 512 + c], gu1 = g_up[(size_t)(j4 + 1) * 512 + c], gu2 = g_up[(size_t)(j4 + 2) * 512 + c], gu3 = g_up[(size_t)(j4 + 3) * 512 + c];
#pragma unroll
            for (int t = 0; t < 32; ++t) { const f32x4 sv = *(const LAS f32x4*)(sig + t * 128 + j4); g[t] += sv[0] * gu0 + sv[1] * gu1 + sv[2] * gu2 + sv[3] * gu3; }
        }
#pragma unroll
        for (int tl = 0; tl < 32; ++tl) {
            const int row = row0 + tl, b = row / T, t = row % T;
            const float w = Y0[(size_t)row * 512 + c] + Y1[(size_t)row * 512 + c];
            const float mu = wave_sum(w) * (1.0f / 64.0f);
            const float dv = w - mu;
            const float var = wave_sum(dv * dv) * (1.0f / 64.0f);
            float y = dv * rsqrtf(var + 64e-5f) * lng + lnb;
            const float vc = bf2f(PR[(size_t)row * RWP + 1024 + c]);
            const float vp = t > 0 ? bf2f(PR[(size_t)(row - 1) * RWP + 1024 + c]) : 0.f;
            const float vn = t < T - 1 ? bf2f(PR[(size_t)(row + 1) * RWP + 1024 + c]) : 0.f;
            const float vs = vc + mpv * (vp - vc) + mnv * (vn - vc);
            const int ch0 = (b * 8 + wave) * 2;
            const float bon = BON[(size_t)ch0 * T + t] + BON[(size_t)(ch0 + 1) * T + t];
            y = (y + bon * vs) * g[tl];
            MIX[(size_t)row * 1024 + 512 + c] = f2bf(y);
        }
        __syncthreads();
    }
}

__global__ void __launch_bounds__(512) mega(Params p) {
    extern __shared__ __attribute__((aligned(16))) unsigned char shm[];
    LAS unsigned char* lds = (LAS unsigned char*)shm;
    cg::grid_group grid = cg::this_grid();
    const float* mod = (const float*)(p.ws + OFF_MOD);
#ifndef PHMASK
#define PHMASK 0x1ff
#endif
#define HAS(x) ((PHMASK >> (x)) & 1)
#define RUN(k) (HAS(k) && p.ph_lo <= (k) && (k) < p.ph_hi)
#define SYNC(k) do { if (p.ph_lo <= (k) && (k) + 1 < p.ph_hi) grid.sync(); } while (0)
    if (RUN(0)) phase0(p, lds);
    SYNC(0);
    if (RUN(1)) phase_norm(p, 0);
    SYNC(1);
    if (RUN(2)) {
        pg8::Gemm g{(const bf16_t*)(p.ws + OFF_U), (const bf16_t*)(p.ws + OFF_WIN), MA, INPP, 1024};
        pg8::StaticOrder S; S.init(MA, INPP, (int)gridDim.x, (int)blockIdx.x);
        EpiIn E{(bf16_t*)(p.ws + OFF_Q), (bf16_t*)(p.ws + OFF_K), (bf16_t*)(p.ws + OFF_VT), (bf16_t*)(p.ws + OFF_VTC), (bf16_t*)(p.ws + OFF_PR), p.in[9], p.in[10]};
        pg8::gemm_phase<EpiIn, pg8::StaticOrder, false>(lds, g, S, E, nullptr);
    }
    SYNC(2);
    if (RUN(3)) {
        if ((int)blockIdx.x < NCHAIN) phase_scan(p, lds, (int)blockIdx.x);
        else phase_na(p, (int)blockIdx.x - NCHAIN, (int)gridDim.x - NCHAIN);
    }
    SYNC(3);
    if (RUN(4)) phase_finish(p, lds);
    SYNC(4);
    if (RUN(5)) {
        pg8::Gemm g{(const bf16_t*)(p.ws + OFF_MIX), (const bf16_t*)(p.ws + OFF_WOUT), MT, 1024, 1024};
        pg8::StaticOrder S; S.init(MT, 1024, (int)gridDim.x, (int)blockIdx.x);
        EpiRes E{p.in[0], p.out, mod + 2 * 1024};
        pg8::gemm_phase<EpiRes, pg8::StaticOrder, false>(lds, g, S, E, nullptr);
    }
    SYNC(5);
    if (RUN(6)) phase_norm(p, 1);
    SYNC(6);
    if (RUN(7)) {
        pg8::Gemm g{(const bf16_t*)(p.ws + OFF_U), (const bf16_t*)(p.ws + OFF_WF1), MT, 2 * DFF, 1024};
        pg8::StaticOrder S; S.init(MT, 2 * DFF, (int)gridDim.x, (int)blockIdx.x);
        EpiGlu E{(bf16_t*)(p.ws + OFF_ACT)};
        pg8::gemm_phase<EpiGlu, pg8::StaticOrder, false>(lds, g, S, E, nullptr);
    }
    SYNC(7);
    if (RUN(8)) {
        pg8::Gemm g{(const bf16_t*)(p.ws + OFF_ACT), (const bf16_t*)(p.ws + OFF_WF2), MT, 1024, DFF};
        pg8::StaticOrder S; S.init(MT, 1024, (int)gridDim.x, (int)blockIdx.x);
        EpiRes E{p.out, p.out, mod + 5 * 1024};
        pg8::gemm_phase<EpiRes, pg8::StaticOrder, false>(lds, g, S, E, nullptr);
    }
}

extern "C" void kernel_launch(void* const* d_in, const int* in_sizes, int n_in, void* d_out, int out_size, void* d_ws, size_t ws_size, hipStream_t stream) {
    static int grid = 0;
    if (!grid) {
        int dev = 0, cus = 0, per_cu = 0;
        (void)hipGetDevice(&dev);
        (void)hipDeviceGetAttribute(&cus, hipDeviceAttributeMultiprocessorCount, dev);
        (void)hipFuncSetAttribute((const void*)mega, hipFuncAttributeMaxDynamicSharedMemorySize, LDS_BYTES);
        if (hipOccupancyMaxActiveBlocksPerMultiprocessor(&per_cu, (const void*)mega, 512, LDS_BYTES) != hipSuccess || per_cu < 1) { (void)hipGetLastError(); per_cu = 1; }
        grid = cus * per_cu;
        if (ws_size < OFF_END) fprintf(stderr, "kernel_launch: workspace too small: %zu < %zu\n", ws_size, (size_t)OFF_END);
    }
    Params p{};
    for (int i = 0; i < 27; ++i) p.in[i] = (const float*)d_in[i];
    p.out = (float*)d_out; p.ws = (unsigned char*)d_ws; p.ph_lo = 0; p.ph_hi = 9;
    void* args[] = {&p};
    hipError_t e = hipLaunchCooperativeKernel((const void*)mega, dim3(grid), dim3(512), args, LDS_BYTES, stream);
    if (e != hipSuccess) fprintf(stderr, "cooperative launch failed: %s (grid %d)\n", hipGetErrorString(e), grid);
}
```

```cpp
#include <hip/hip_runtime.h>
#include <hip/hip_cooperative_groups.h>
#include <cstdio>
namespace cg = cooperative_groups;
namespace pg8 {
#define PG8_LAS __attribute__((address_space(3)))
typedef unsigned short bf16_t;
typedef short bf16x8 __attribute__((ext_vector_type(8)));
typedef float f32x4 __attribute__((ext_vector_type(4)));
typedef unsigned u32x4 __attribute__((ext_vector_type(4)));
constexpr int BM = 256, BK = 64, HALF = 128, HTB = HALF * BK * 2  , STAGE_BYTES = 8 * HTB, NXCD = 8, WGM = 8;

__host__ __device__ __forceinline__ int lds_byte(int r, int c) { const int st = (r >> 4) * 2 + (c >> 5), rr = r & 15, cc = c & 31, ob = rr * 64 + cc * 2; return st * 1024 + (ob ^ (((ob >> 9) & 1) << 5)); }
__host__ __device__ __forceinline__ void stage_rc(int b, int& R, int& C) { const int st = b / 1024, sb = b % 1024, swz = sb ^ (((sb >> 9) & 1) << 5); R = (st >> 1) * 16 + swz / 64; C = (st & 1) * 32 + (swz % 64) / 2; }
__host__ __device__ __forceinline__ int perm32(int rho) { const int n = rho >> 4, i = rho & 15; return 8 * (i >> 2) + 4 * n + (i & 3); }

struct Unit { int pm, pn; };
struct Gemm { const bf16_t* A; const bf16_t* Bt; int M, N, K; int ld = 0, pn_thr = 1 << 30, koff = 0; };

struct StaticOrder {
    int nM, nN, nwg, G, c;
    __host__ __device__ void init(int M, int N, int G_, int c_) { nM = M / BM; nN = N / BM; nwg = nM * nN; G = G_; c = c_; }
    __host__ __device__ bool next(int i, Unit& u) const {
        const long L = (long)i * G + c; if (L >= nwg) return false;
        int wgid = (int)L; { const int q = nwg / NXCD, r = nwg % NXCD, xcd = wgid % NXCD, off = wgid / NXCD; wgid = (xcd < r ? xcd * (q + 1) : r * (q + 1) + (xcd - r) * q) + off; }
        const int nig = WGM * nN, gid = wgid / nig, fm = gid * WGM, gsz = (nM - fm) < WGM ? (nM - fm) : WGM;
        u.pm = fm + ((wgid % nig) % gsz); u.pn = (wgid % nig) / gsz; return true;
    }
    __device__ __forceinline__ void a_ready(const Unit&) const {}
    __device__ __forceinline__ void done(const Unit&) const {}
};
__device__ __forceinline__ unsigned cvt_pk_bf16(float lo, float hi) { unsigned r; asm volatile("v_cvt_pk_bf16_f32 %0, %1, %2" : "=v"(r) : "v"(lo), "v"(hi)); return r; }
typedef float f32x2 __attribute__((ext_vector_type(2)));
template <class Epi, class Sched, bool STAMP = false>
__device__ __forceinline__ void gemm_phase(PG8_LAS unsigned char* lds, const Gemm g, const Sched& S, const Epi& E, unsigned long long* stamps) {
    const int tid = threadIdx.x, wid = __builtin_amdgcn_readfirstlane(tid >> 6), lane = tid & 63, wr = wid >> 2, wc = wid & 3, fr = lane & 15, fq = lane >> 4;
    const int K = g.ld ? g.ld : g.K, nt = g.K / BK;
    int ts_lo = 0, ts_hi = 0, nts = 0; const unsigned long long rt_entry = STAMP ? (unsigned long long)wall_clock64() : 0ull;
#define PG8_STAMP() do { if (STAMP && wid == 0 && nts < 64) { const unsigned long long _c = (unsigned long long)clock64(); \
        ts_lo = (lane == nts) ? (int)(unsigned)_c : ts_lo; ts_hi = (lane == nts) ? (int)(unsigned)(_c >> 32) : ts_hi; ++nts; } } while (0)
    PG8_STAMP();
    unsigned voffA[2], voffB[2];
#pragma unroll
    for (int i = 0; i < 2; ++i) { int R, C; stage_rc(tid * 16 + i * 8192, R, C); const int Rb = Epi::PERM ? ((R & ~31) + perm32(R & 31)) : R;
        voffA[i] = (unsigned)(R * K + C) * 2u; voffB[i] = (unsigned)(Rb * K + C) * 2u; }
    const size_t kstep = (size_t)(BK * 2);
    const size_t hstep = (size_t)HALF * K * 2;
    const size_t tstep = 2 * hstep;
    const unsigned ldsw = (unsigned)wid * 1024u;
    const int aoff = lds_byte(wr * 64 + fr, fq * 8), boff = lds_byte(wc * 32 + fr, fq * 8);
#define PG8_SA(b, h) (((b) * 2 + (h)) * HTB)
#define PG8_SB(b, h) ((4 + (b) * 2 + (h)) * HTB)
#define PG8_STAGE(bufoff, gbase, voff) do { _Pragma("unroll") for (int _i = 0; _i < 2; ++_i) \
        __builtin_amdgcn_global_load_lds((const unsigned*)((const char*)(gbase) + (voff)[_i]), (PG8_LAS unsigned*)(lds + (bufoff) + ldsw + _i * 8192), 16, 0, 0); } while (0)
#define PG8_LDA(dst, b, h) do { _Pragma("unroll") for (int m = 0; m < 4; ++m) _Pragma("unroll") for (int k = 0; k < 2; ++k) dst[m][k] = *(const PG8_LAS bf16x8*)(lds + PG8_SA(b, h) + aoff + m * 2048 + k * 1024); } while (0)
#define PG8_LDB(dst, b, h) do { _Pragma("unroll") for (int n = 0; n < 2; ++n) _Pragma("unroll") for (int k = 0; k < 2; ++k) dst[n][k] = *(const PG8_LAS bf16x8*)(lds + PG8_SB(b, h) + boff + n * 2048 + k * 1024); } while (0)
#define PG8_MMA(ai, bj, At, Bt) do { __builtin_amdgcn_s_setprio(1); _Pragma("unroll") for (int m = 0; m < 4; ++m) _Pragma("unroll") for (int n = 0; n < 2; ++n) _Pragma("unroll") for (int k = 0; k < 2; ++k) \
        acc[ai][bj][m][n] = __builtin_amdgcn_mfma_f32_16x16x32_bf16(Bt[n][k], At[m][k], acc[ai][bj][m][n], 0, 0, 0); __builtin_amdgcn_s_setprio(0); } while (0)
#define PG8_WAIT_V(n) asm volatile("s_waitcnt vmcnt(" #n ")" ::: "memory")
#define PG8_WAIT_L(n) asm volatile("s_waitcnt lgkmcnt(" #n ")" ::: "memory")
#define PG8_BAR __builtin_amdgcn_s_barrier()
#define PG8_SCHED __builtin_amdgcn_sched_barrier(0)
    Unit cur, nxt; int ui = 0;
    if (!S.next(0, cur)) return;
    f32x4 acc[2][2][4][2];
#pragma unroll
    for (int a = 0; a < 2; ++a)
#pragma unroll
        for (int b = 0; b < 2; ++b)
#pragma unroll
            for (int m = 0; m < 4; ++m)
#pragma unroll
                for (int n = 0; n < 2; ++n) acc[a][b][m][n] = (f32x4){0.f, 0.f, 0.f, 0.f};
    bf16x8 At[4][2], B0[2][2], B1[2][2];
    const char* cA = (const char*)g.A + (size_t)cur.pm * tstep + (cur.pn >= g.pn_thr ? g.koff * 2 : 0); const char* cB = (const char*)g.Bt + (size_t)cur.pn * tstep + (cur.pn >= g.pn_thr ? g.koff * 2 : 0);
    S.a_ready(cur);
    PG8_STAGE(PG8_SB(0, 0), cB, voffB); PG8_STAGE(PG8_SA(0, 0), cA, voffA); PG8_STAGE(PG8_SB(0, 1), cB + hstep, voffB); PG8_STAGE(PG8_SA(0, 1), cA + hstep, voffA);
    if (wr == 1) PG8_BAR;
    PG8_WAIT_V(4); PG8_BAR;
    PG8_STAGE(PG8_SB(1, 0), cB + kstep, voffB); PG8_STAGE(PG8_SA(1, 0), cA + kstep, voffA); PG8_STAGE(PG8_SB(1, 1), cB + hstep + kstep, voffB);
    PG8_WAIT_V(6); PG8_BAR;
    PG8_STAMP();
    for (;;) {
        const bool has_next = S.next(ui + 1, nxt);
        const int nko = (has_next && nxt.pn >= g.pn_thr) ? g.koff * 2 : 0;
        const char* nA = has_next ? (const char*)g.A + (size_t)nxt.pm * tstep + nko : cA; const char* nB = has_next ? (const char*)g.Bt + (size_t)nxt.pn * tstep + nko : cB;
        for (int t = 0; t < nt; t += 2) {
            const bool last = (t == nt - 2);
            const char* a1 = cA + (size_t)(t + 1) * kstep;
            const char* a2 = last ? nA : cA + (size_t)(t + 2) * kstep; const char* b2 = last ? nB : cB + (size_t)(t + 2) * kstep;
            const char* a3 = a2 + kstep; const char* b3 = b2 + kstep;
            if (last && has_next) S.a_ready(nxt);
            PG8_LDB(B0, 0, 0); PG8_SCHED; PG8_LDA(At, 0, 0); PG8_STAGE(PG8_SA(1, 1), a1 + hstep, voffA);
            PG8_WAIT_L(8); PG8_BAR; PG8_WAIT_L(0); PG8_MMA(0, 0, At, B0); PG8_BAR; PG8_SCHED;
            PG8_LDB(B1, 0, 1); PG8_STAGE(PG8_SB(0, 0), b2, voffB);
            PG8_BAR; PG8_WAIT_L(0); PG8_MMA(0, 1, At, B1); PG8_BAR;
            PG8_LDA(At, 0, 1); PG8_STAGE(PG8_SA(0, 0), a2, voffA);
            PG8_BAR; PG8_WAIT_L(0); PG8_MMA(1, 0, At, B0); PG8_BAR; PG8_SCHED;
            PG8_STAGE(PG8_SB(0, 1), b2 + hstep, voffB);
            PG8_WAIT_V(6); PG8_BAR; PG8_MMA(1, 1, At, B1); PG8_BAR;
            PG8_LDB(B0, 1, 0); PG8_SCHED; PG8_LDA(At, 1, 0); PG8_STAGE(PG8_SA(0, 1), a2 + hstep, voffA);
            PG8_WAIT_L(8); PG8_BAR; PG8_WAIT_L(0); PG8_MMA(0, 0, At, B0); PG8_BAR; PG8_SCHED;
            PG8_LDB(B1, 1, 1); PG8_STAGE(PG8_SB(1, 0), b3, voffB);
            PG8_BAR; PG8_WAIT_L(0); PG8_MMA(0, 1, At, B1); PG8_BAR;
            PG8_LDA(At, 1, 1); PG8_STAGE(PG8_SA(1, 0), a3, voffA);
            PG8_BAR; PG8_WAIT_L(0); PG8_MMA(1, 0, At, B0); PG8_BAR; PG8_SCHED;
            PG8_STAGE(PG8_SB(1, 1), b3 + hstep, voffB);
            PG8_WAIT_V(6); PG8_BAR; PG8_MMA(1, 1, At, B1); PG8_BAR;
        }
        PG8_STAMP();
        if constexpr (!Epi::AFTER_DRAIN) { E(acc, cur, wr, wc, fr, fq); S.done(cur); }
        PG8_STAMP();
        if (!has_next) break;
#pragma unroll
        for (int a = 0; a < 2; ++a)
#pragma unroll
            for (int b = 0; b < 2; ++b)
#pragma unroll
                for (int m = 0; m < 4; ++m)
#pragma unroll
                    for (int n = 0; n < 2; ++n) acc[a][b][m][n] = (f32x4){0.f, 0.f, 0.f, 0.f};
        cur = nxt; cA = nA; cB = nB; ++ui;
    }
    PG8_WAIT_V(0);
    if (wr == 0) PG8_BAR;
    PG8_BAR;
    if constexpr (Epi::AFTER_DRAIN) { E.fused(acc, cur, wr, wc, fr, fq, lds, wid, lane); S.done(cur); }
    PG8_STAMP();
    if (STAMP && wid == 0) { stamps[lane] = lane < nts ? (((unsigned long long)(unsigned)ts_hi << 32) | (unsigned)ts_lo) : 0ull;
        if (lane == 62) stamps[62] = rt_entry; if (lane == 63) stamps[63] = (unsigned long long)wall_clock64(); }
#undef PG8_STAMP
#undef PG8_SA
#undef PG8_SB
#undef PG8_STAGE
#undef PG8_LDA
#undef PG8_LDB
#undef PG8_MMA
#undef PG8_WAIT_V
#undef PG8_WAIT_L
#undef PG8_BAR
#undef PG8_SCHED
}
}
using pg8::bf16_t; using pg8::bf16x8; using pg8::f32x4; using pg8::u32x4; using pg8::Unit;
typedef unsigned u32x2 __attribute__((ext_vector_type(2)));
typedef short s16x4 __attribute__((ext_vector_type(4)));
#define LAS __attribute__((address_space(3)))

constexpr int D = 1024, NB = 2, T = 16384, LC = 256, MT = NB * T, MC = NB * LC, MA = MT + MC;
constexpr int RWP = 1856, INP = 3392, INPP = 3584, DFF = 2816;
constexpr int LDS_BYTES = 131072;
constexpr int NCHAIN = 32;

constexpr size_t OFF_MOD = 0;
constexpr size_t OFF_WIN = 131072;
constexpr size_t OFF_WOUT = OFF_WIN + (size_t)INPP * 1024 * 2;
constexpr size_t OFF_WF1 = OFF_WOUT + (size_t)1024 * 1024 * 2;
constexpr size_t OFF_WF2 = OFF_WF1 + (size_t)5632 * 1024 * 2;
constexpr size_t OFF_LORAB = OFF_WF2 + (size_t)1024 * 2816 * 2;
constexpr size_t OFF_MIX = OFF_LORAB + (size_t)2560 * 384 * 2;
constexpr size_t OFF_U = OFF_MIX + (size_t)MT * 1024 * 2;
constexpr size_t OFF_Q = OFF_U + (size_t)MA * 1024 * 2;
constexpr size_t OFF_K = OFF_Q + (size_t)MA * 512 * 2;
constexpr size_t OFF_VT = OFF_K + (size_t)MA * 512 * 2;
constexpr size_t OFF_VTC = OFF_VT + (size_t)NB * 8 * 64 * T * 2;
constexpr size_t OFF_PR = OFF_VTC + (size_t)NB * 8 * 64 * LC * 2;
constexpr size_t OFF_DEC = OFF_PR + (size_t)MA * RWP * 2;
constexpr size_t OFF_AR = OFF_DEC + (size_t)MA * 1024 * 2;
constexpr size_t OFF_BON = OFF_AR + (size_t)MA * 1024 * 2;
constexpr size_t OFF_LA = OFF_U;
constexpr size_t OFF_SST = OFF_U + (size_t)32 * 1024 * 1024;
constexpr size_t OFF_IDENT = OFF_BON + (size_t)NCHAIN * T * 4;
constexpr size_t OFF_BAR = OFF_IDENT + 16384;
constexpr size_t OFF_END = OFF_BAR + 16384;
constexpr size_t OFF_ACT = OFF_Q;
static_assert(OFF_ACT + (size_t)MT * DFF * 2 <= OFF_DEC, "ACT alias overflow");
static_assert(OFF_END <= (size_t)536870912, "workspace");

struct Params {
    const float* in[27];
    float* out; unsigned char* ws;
    int ph_lo, ph_hi;
};

__device__ __forceinline__ float bf2f(bf16_t v) { return __uint_as_float(((unsigned)v) << 16); }
typedef __bf16 hwbf16x2 __attribute__((ext_vector_type(2)));
typedef float cvf32x2 __attribute__((ext_vector_type(2)));
__device__ __forceinline__ unsigned pk2(float lo, float hi) { const hwbf16x2 r = __builtin_convertvector((cvf32x2){lo, hi}, hwbf16x2); return __builtin_bit_cast(unsigned, r); }
__device__ __forceinline__ bf16_t f2bf(float f) { return (bf16_t)(pk2(f, 0.0f) & 0xffffu); }
__device__ __forceinline__ float dpp_f(float v, int ctrl_quad) { return v; }
#define DPPF(v, ctrl) __builtin_bit_cast(float, __builtin_amdgcn_update_dpp(0, __builtin_bit_cast(int, (v)), (ctrl), 0xf, 0xf, true))
__device__ __forceinline__ float wave_sum(float v) {
    v += DPPF(v, 0xB1);
    v += DPPF(v, 0x4E);
    v += DPPF(v, 0x141);
    v += DPPF(v, 0x140);
    const float s0 = __builtin_bit_cast(float, __builtin_amdgcn_readlane(__builtin_bit_cast(int, v), 0)), s1 = __builtin_bit_cast(float, __builtin_amdgcn_readlane(__builtin_bit_cast(int, v), 16));
    const float s2 = __builtin_bit_cast(float, __builtin_amdgcn_readlane(__builtin_bit_cast(int, v), 32)), s3 = __builtin_bit_cast(float, __builtin_amdgcn_readlane(__builtin_bit_cast(int, v), 48));
    return (s0 + s1) + (s2 + s3);
}
__device__ __forceinline__ float silu_f(float x) { return x * __builtin_amdgcn_rcpf(1.0f + __expf(-x)); }
__device__ __forceinline__ float sigmoid_f(float x) { return __builtin_amdgcn_rcpf(1.0f + __expf(-x)); }

struct EpiIn {
    static constexpr bool PERM = false, AFTER_DRAIN = false;
    bf16_t *Q, *K, *VT, *VTC, *PR; const float *qg, *kg;
    __device__ __forceinline__ void operator()(const f32x4 (&acc)[2][2][4][2], const Unit& u, int wr, int wc, int fr, int fq) const {
        const int c0 = u.pn * 256 + wc * 64;
        const int row0 = u.pm * 256 + wr * 64 + fr;
        if (c0 < 1024) {
            const bool isq = c0 < 512; const float* g = isq ? qg : kg; bf16_t* dst = isq ? Q : K; const int cc = c0 & 511; const float sc = isq ? 0.125f : 1.0f;
            f32x4 gv[2][2];
#pragma unroll
            for (int bj = 0; bj < 2; ++bj)
#pragma unroll
                for (int n = 0; n < 2; ++n) gv[bj][n] = *(const f32x4*)(g + 32 * bj + 8 * fq + 4 * n) * sc;
#pragma unroll
            for (int ai = 0; ai < 2; ++ai)
#pragma unroll
                for (int m = 0; m < 4; ++m) {
                    float ss = 0.f;
#pragma unroll
                    for (int bj = 0; bj < 2; ++bj)
#pragma unroll
                        for (int n = 0; n < 2; ++n) { const f32x4 x = acc[ai][bj][m][n]; ss += (x[0] * x[0] + x[1] * x[1]) + (x[2] * x[2] + x[3] * x[3]); }
                    ss += __shfl_xor(ss, 16); ss += __shfl_xor(ss, 32);
                    const float rstd = rsqrtf(ss * (1.0f / 64.0f) + 1e-6f);
                    bf16_t* rowp = dst + (size_t)(row0 + ai * 128 + m * 16) * 512 + cc + 8 * fq;
#pragma unroll
                    for (int bj = 0; bj < 2; ++bj) { const f32x4 y0 = acc[ai][bj][m][0] * rstd * gv[bj][0], y1 = acc[ai][bj][m][1] * rstd * gv[bj][1];
                        u32x4 w; w.x = pk2(y0[0], y0[1]); w.y = pk2(y0[2], y0[3]); w.z = pk2(y1[0], y1[1]); w.w = pk2(y1[2], y1[3]); *(u32x4*)(rowp + 32 * bj) = w; }
                }
        } else if (c0 < 1536) {
            const int h = (c0 - 1024) >> 6;
#pragma unroll
            for (int ai = 0; ai < 2; ++ai)
#pragma unroll
                for (int m = 0; m < 4; ++m) {
                    const int r = row0 + ai * 128 + m * 16;
                    bf16_t* base; size_t stride;
                    if (r < MT) { const int b = r / T, t = r % T; base = VT + ((size_t)(b * 8 + h) * 64) * T + t; stride = T; }
                    else { const int rc = r - MT, b = rc / LC, l = rc % LC; base = VTC + ((size_t)(b * 8 + h) * 64) * LC + l; stride = LC; }
#pragma unroll
                    for (int bj = 0; bj < 2; ++bj)
#pragma unroll
                        for (int n = 0; n < 2; ++n)
#pragma unroll
                            for (int e = 0; e < 4; ++e) base[(size_t)(32 * bj + 8 * fq + 4 * n + e) * stride] = f2bf(acc[ai][bj][m][n][e]);
                }
        } else {
            const int cr = c0 - 1536;
            if (cr >= RWP) return;
#pragma unroll
            for (int ai = 0; ai < 2; ++ai)
#pragma unroll
                for (int m = 0; m < 4; ++m) {
                    bf16_t* rowp = PR + (size_t)(row0 + ai * 128 + m * 16) * RWP + cr + 8 * fq;
#pragma unroll
                    for (int bj = 0; bj < 2; ++bj) { const f32x4 y0 = acc[ai][bj][m][0], y1 = acc[ai][bj][m][1];
                        u32x4 w; w.x = pk2(y0[0], y0[1]); w.y = pk2(y0[2], y0[3]); w.z = pk2(y1[0], y1[1]); w.w = pk2(y1[2], y1[3]); *(u32x4*)(rowp + 32 * bj) = w; }
                }
        }
    }
};
struct EpiRes {
    static constexpr bool PERM = false, AFTER_DRAIN = false;
    const float* base; float* out; const float* gate;
    __device__ __forceinline__ void operator()(const f32x4 (&acc)[2][2][4][2], const Unit& u, int wr, int wc, int fr, int fq) const {
        const int c0 = u.pn * 256 + wc * 64 + 4 * fq;
        const int row0 = u.pm * 256 + wr * 64 + fr;
#pragma unroll
        for (int ai = 0; ai < 2; ++ai)
#pragma unroll
            for (int m = 0; m < 4; ++m) {
                const int r = row0 + ai * 128 + m * 16; const int b = r / T;
#pragma unroll
                for (int bj = 0; bj < 2; ++bj)
#pragma unroll
                    for (int n = 0; n < 2; ++n) { const int c = c0 + 32 * bj + 16 * n;
                        const f32x4 gt = *(const f32x4*)(gate + (size_t)b * 6144 + c);
                        const f32x4 bs = *(const f32x4*)(base + (size_t)r * 1024 + c);
                        *(f32x4*)(out + (size_t)r * 1024 + c) = bs + gt * acc[ai][bj][m][n]; }
            }
    }
};
struct EpiGlu {
    static constexpr bool PERM = false, AFTER_DRAIN = false;
    bf16_t* ACT;
    __device__ __forceinline__ void operator()(const f32x4 (&acc)[2][2][4][2], const Unit& u, int wr, int wc, int fr, int fq) const {
        const int g0 = u.pn * 128 + wc * 32 + 8 * fq;
        const int row0 = u.pm * 256 + wr * 64 + fr;
#pragma unroll
        for (int ai = 0; ai < 2; ++ai)
#pragma unroll
            for (int m = 0; m < 4; ++m) {
                bf16_t* rowp = ACT + (size_t)(row0 + ai * 128 + m * 16) * DFF + g0;
                const f32x4 ga0 = acc[ai][0][m][0], up0 = acc[ai][1][m][0], ga1 = acc[ai][0][m][1], up1 = acc[ai][1][m][1];
                u32x4 w; w.x = pk2(silu_f(ga0[0]) * up0[0], silu_f(ga0[1]) * up0[1]); w.y = pk2(silu_f(ga0[2]) * up0[2], silu_f(ga0[3]) * up0[3]);
                w.z = pk2(silu_f(ga1[0]) * up1[0], silu_f(ga1[1]) * up1[1]); w.w = pk2(silu_f(ga1[2]) * up1[2], silu_f(ga1[3]) * up1[3]);
                *(u32x4*)rowp = w;
            }
    }
};

__device__ __forceinline__ void transpose_item(const float* Wk0, int K, int Nsrc, int src_col0, bf16_t* WT, int dest_row0, int k0, LAS float* scr, int lane, bool perm = false) {
    const int c = lane & 7;
    if (src_col0 < 0) {
#pragma unroll
        for (int j = 0; j < 4; ++j) { const int n = (lane >> 3) + 8 * j; *(u32x4*)(WT + (size_t)(dest_row0 + n) * K + k0 + 8 * c) = (u32x4){0u, 0u, 0u, 0u}; }
        return;
    }
#pragma unroll 8
    for (int i = 0; i < 32; ++i) { const int kk = 2 * i + (lane >> 5); scr[kk * 33 + (lane & 31)] = Wk0[(size_t)kk * Nsrc + src_col0 + (lane & 31)]; }
    asm volatile("s_waitcnt lgkmcnt(0)" ::: "memory");
#pragma unroll
    for (int j = 0; j < 4; ++j) { const int n = (lane >> 3) + 8 * j; const LAS float* s = scr + (8 * c) * 33 + (perm ? pg8::perm32(n) : n);
        u32x4 o; o.x = pk2(s[0 * 33], s[1 * 33]); o.y = pk2(s[2 * 33], s[3 * 33]); o.z = pk2(s[4 * 33], s[5 * 33]); o.w = pk2(s[6 * 33], s[7 * 33]);
        *(u32x4*)(WT + (size_t)(dest_row0 + n) * K + k0 + 8 * c) = o; }
    asm volatile("s_waitcnt lgkmcnt(0)" ::: "memory");
}
constexpr int W_EARLY = 80 * 6 + (INPP / 32) * 16, W_ALL = W_EARLY + 32 * 16 + (5632 / 32) * 16 + 32 * 44;
__device__ __forceinline__ void weight_transposes(const Params& p, LAS unsigned char* lds, int it_lo, int it_hi, int gw, int NGW) {
    const int lane = threadIdx.x & 63, wave = threadIdx.x >> 6;
    LAS float* scr = (LAS float*)(lds + 32768 + wave * 8704);
    constexpr int I_IN = (INPP / 32) * 16, I_OUT = 32 * 16, I_F1 = (5632 / 32) * 16, I_F2 = 32 * 44, I_LO = 80 * 6;
    for (int it = it_lo + gw; it < it_hi; it += NGW) {
        int r = it;
        if (r < I_LO) { const int gd = r / 6, kc = r % 6, t0 = gd * 32, pn = t0 >> 8, bj = (t0 >> 7) & 1, wc = (t0 >> 5) & 3, a0 = pn * 256 + wc * 64 + bj * 32;
            const int grp = a0 >> 9, hc0 = a0 & 511;
            const float* W = nullptr;
            if (grp < 2) { if (kc == grp) W = p.in[15] + (size_t)grp * 64 * 512; }
            else if (grp < 4) { if (kc == 2) W = p.in[17] + (size_t)(grp & 1) * 64 * 512; }
            else { if (kc == 3 || kc == 4) W = p.in[18] + (size_t)(kc - 3) * 64 * 512; }
            transpose_item(W ? W : p.in[15], 384, 512, W ? hc0 : -1, (bf16_t*)(p.ws + OFF_LORAB), t0, kc * 64, scr, lane, true); continue; }
        r -= I_LO;
        if (r < I_IN) { const int gd = r >> 4, kc = r & 15, t0 = gd * 32, pn = t0 >> 8, bj = (t0 >> 7) & 1, wc = (t0 >> 5) & 3, a0 = pn * 256 + wc * 64 + bj * 32;
            transpose_item(p.in[8] + (size_t)kc * 64 * INP, 1024, INP, a0 < INP ? a0 : -1, (bf16_t*)(p.ws + OFF_WIN), t0, kc * 64, scr, lane, true); continue; }
        r -= I_IN;
        if (r < I_OUT) { const int gd = r >> 4, kc = r & 15, t0 = gd * 32, pn = t0 >> 8, bj = (t0 >> 7) & 1, wc = (t0 >> 5) & 3, a0 = pn * 256 + wc * 64 + bj * 32;
            transpose_item(p.in[24] + (size_t)kc * 64 * 1024, 1024, 1024, a0, (bf16_t*)(p.ws + OFF_WOUT), t0, kc * 64, scr, lane); continue; }
        r -= I_OUT;
        if (r < I_F1) { const int gd = r >> 4, kc = r & 15, t0 = gd * 32, pn = t0 >> 8, bj = (t0 >> 7) & 1, wc = (t0 >> 5) & 3, src = pn * 128 + wc * 32 + bj * DFF;
            transpose_item(p.in[25] + (size_t)kc * 64 * 2 * DFF, 1024, 2 * DFF, src, (bf16_t*)(p.ws + OFF_WF1), t0, kc * 64, scr, lane, true); continue; }
        r -= I_F1;
        { const int gd = r / 44, kc = r % 44, t0 = gd * 32, pn = t0 >> 8, bj = (t0 >> 7) & 1, wc = (t0 >> 5) & 3, a0 = pn * 256 + wc * 64 + bj * 32;
            transpose_item(p.in[26] + (size_t)kc * 64 * 1024, DFF, 1024, a0, (bf16_t*)(p.ws + OFF_WF2), t0, kc * 64, scr, lane); }
    }
}


__device__ __forceinline__ void phase0(const Params& p, LAS unsigned char* lds) {
    const int tid = threadIdx.x, lane = tid & 63, wave = tid >> 6;
    const float* c = p.in[1]; const float* cctx = p.in[3]; const float* w_ada = p.in[6]; const float* b_ada = p.in[7];
    float* mod = (float*)(p.ws + OFF_MOD);
    LAS float* red = (LAS float*)lds;
    for (int cb = blockIdx.x; cb < 256; cb += gridDim.x) {
        const int ks = tid / 6, cgp = tid % 6, col = cb * 24 + cgp * 4;
        if (ks < 84) {
            f32x4 a0 = {0.f, 0.f, 0.f, 0.f}, a1 = a0, a2 = a0;
            for (int k = ks; k < 1024; k += 84) {
                const f32x4 w = *(const f32x4*)(w_ada + (size_t)k * 6144 + col);
                a0 += w * silu_f(c[k]); a1 += w * silu_f(c[1024 + k]); a2 += w * silu_f(cctx[k]);
            }
#pragma unroll
            for (int e = 0; e < 4; ++e) { red[ks * 72 + cgp * 4 + e] = a0[e]; red[ks * 72 + 24 + cgp * 4 + e] = a1[e]; red[ks * 72 + 48 + cgp * 4 + e] = a2[e]; }
        }
        __syncthreads();
        if (tid < 72) { float s = 0.f; for (int k = 0; k < 84; ++k) s += red[k * 72 + tid];
            const int r = tid / 24, cc = cb * 24 + tid % 24; mod[r * 6144 + cc] = s + b_ada[cc]; }
        __syncthreads();
    }
    { float* ident = (float*)(p.ws + OFF_IDENT); for (int idx = blockIdx.x * 512 + tid; idx < 4096; idx += gridDim.x * 512) ident[idx] = ((idx >> 6) == (idx & 63)) ? 1.0f : 0.0f; }
    weight_transposes(p, lds, 0, W_EARLY, blockIdx.x * 8 + wave, gridDim.x * 8);
}

__device__ __forceinline__ void phase_norm(const Params& p, int which) {
    const int lane = threadIdx.x & 63, wave = threadIdx.x >> 6;
    const float* mod = (const float*)(p.ws + OFF_MOD);
    const float* g = which ? p.in[5] : p.in[4];
    bf16_t* U = (bf16_t*)(p.ws + OFF_U);
    const int nrows = which ? MT : MA, shoff = which ? 3 * 1024 : 0, scoff = which ? 4 * 1024 : 1024;
    for (int row = blockIdx.x * 8 + wave; row < nrows; row += gridDim.x * 8) {
        const float* src; int mrow;
        if (which) { src = p.out + (size_t)row * 1024; mrow = row / T; }
        else if (row < MT) { src = p.in[0] + (size_t)row * 1024; mrow = row / T; }
        else { src = p.in[2] + (size_t)(row - MT) * 1024; mrow = 2; }
        f32x4 v[4]; float ss = 0.f;
#pragma unroll
        for (int j = 0; j < 4; ++j) { v[j] = ((const f32x4*)src)[lane + 64 * j]; ss += (v[j][0] * v[j][0] + v[j][1] * v[j][1]) + (v[j][2] * v[j][2] + v[j][3] * v[j][3]); }
        const float rstd = rsqrtf(wave_sum(ss) * (1.0f / 1024.0f) + 1e-6f);
#pragma unroll
        for (int j = 0; j < 4; ++j) { const int col = 4 * (lane + 64 * j);
            const f32x4 gg = *(const f32x4*)(g + col), sc = *(const f32x4*)(mod + mrow * 6144 + scoff + col), sh = *(const f32x4*)(mod + mrow * 6144 + shoff + col);
            const f32x4 y = v[j] * rstd * gg * (sc + 1.0f) + sh;
            u32x2 w; w.x = pk2(y[0], y[1]); w.y = pk2(y[2], y[3]); *(u32x2*)(U + (size_t)row * 1024 + col) = w; }
    }
}

__device__ __forceinline__ void phase_shiftprep(const Params& p) {
    const int lane = threadIdx.x & 63, wave = threadIdx.x >> 6;
    const bf16_t* PR = (const bf16_t*)(p.ws + OFF_PR); bf16_t* LA = (bf16_t*)(p.ws + OFF_LA);
    float mp[5], mn[5];
#pragma unroll
    for (int j = 0; j < 5; ++j) { mp[j] = p.in[12][1536 + lane + 64 * j]; mn[j] = p.in[13][1536 + lane + 64 * j]; }
    constexpr int NRW = 4;
    const int stride = gridDim.x * 8;
    for (int row0 = blockIdx.x * 8 + wave; row0 < MA; row0 += NRW * stride) {
        unsigned short pc[NRW][5], pp[NRW][5], pn[NRW][5]; float mpf[NRW], mnf[NRW]; bool ok[NRW];
#pragma unroll
        for (int u = 0; u < NRW; ++u) { const int rw = row0 + u * stride; ok[u] = rw < MA; const int row = ok[u] ? rw : row0;
            bool hp_, hn_;
            if (row < MT) { const int t = row % T; hp_ = t > 0; hn_ = t < T - 1; } else { const int l = (row - MT) % LC; hp_ = l > 0; hn_ = l < LC - 1; }
            const bf16_t* pr = PR + (size_t)row * RWP + 1536; const bf16_t* prp = hp_ ? pr - RWP : pr; const bf16_t* prn = hn_ ? pr + RWP : pr;
            mpf[u] = hp_ ? 1.0f : 0.0f; mnf[u] = hn_ ? 1.0f : 0.0f;
#pragma unroll
            for (int j = 0; j < 5; ++j) { const int col = lane + 64 * j; pc[u][j] = pr[col]; pp[u][j] = prp[col]; pn[u][j] = prn[col]; } }
#pragma unroll
        for (int u = 0; u < NRW; ++u) { if (!ok[u]) continue; const int row = row0 + u * stride;
#pragma unroll
            for (int j = 0; j < 5; ++j) { const int col = lane + 64 * j;
                const float c_ = bf2f(pc[u][j]), p_ = mpf[u] * bf2f(pp[u][j]), n_ = mnf[u] * bf2f(pn[u][j]);
                float v = c_ + mp[j] * (p_ - c_) + mn[j] * (n_ - c_);
                if (j < 2) v = 1.0f - 2.0f * __builtin_amdgcn_rcpf(1.0f + __expf(2.0f * v));
                else if (j >= 3) v = sigmoid_f(v);
                LA[(size_t)row * 384 + col] = f2bf(v); }
            LA[(size_t)row * 384 + 320 + lane] = 0; }
    }
}
struct EpiLora {
    static constexpr bool PERM = false, AFTER_DRAIN = false;
    bf16_t *DEC, *AR, *MIXG; const float *w0, *a0;
    __device__ __forceinline__ void operator()(const f32x4 (&acc)[2][2][4][2], const Unit& u, int wr, int wc, int fr, int fq) const {
        const int ac = u.pn * 256 + wc * 64, grp = ac >> 9, hc0 = (ac & 511) + 8 * fq, d = grp & 1;
        const int row0 = u.pm * 256 + wr * 64 + fr;
        if (grp == 4) {
#pragma unroll
            for (int ai = 0; ai < 2; ++ai)
#pragma unroll
                for (int m = 0; m < 4; ++m) { const int r = row0 + ai * 128 + m * 16; if (r >= MT) continue;
                    bf16_t* rowp = MIXG + (size_t)r * 1024 + 512 + hc0;
#pragma unroll
                    for (int bj = 0; bj < 2; ++bj) { const f32x4 y0 = acc[ai][bj][m][0], y1 = acc[ai][bj][m][1]; u32x4 w; w.x = pk2(y0[0], y0[1]); w.y = pk2(y0[2], y0[3]); w.z = pk2(y1[0], y1[1]); w.w = pk2(y1[2], y1[3]); *(u32x4*)(rowp + 32 * bj) = w; } }
            return;
        }
        const bool isw = grp < 2;
        const float* bias = (isw ? w0 : a0) + d * 512 + hc0;
        bf16_t* dst = (isw ? DEC : AR) + d * 512 + hc0;
        f32x4 bv[2][2];
#pragma unroll
        for (int bj = 0; bj < 2; ++bj)
#pragma unroll
            for (int n = 0; n < 2; ++n) bv[bj][n] = *(const f32x4*)(bias + 32 * bj + 4 * n);
#pragma unroll
        for (int ai = 0; ai < 2; ++ai)
#pragma unroll
            for (int m = 0; m < 4; ++m) {
                bf16_t* rowp = dst + (size_t)(row0 + ai * 128 + m * 16) * 1024;
#pragma unroll
                for (int bj = 0; bj < 2; ++bj) { u32x4 w;
#pragma unroll
                    for (int n = 0; n < 2; ++n) { const f32x4 x = acc[ai][bj][m][n] + bv[bj][n]; f32x4 y;
#pragma unroll
                        for (int e = 0; e < 4; ++e) {
                            if (isw) y[e] = -0.60653066f * sigmoid_f(x[e]);
                            else y[e] = sigmoid_f(x[e]); }
                        if (n == 0) { w.x = pk2(y[0], y[1]); w.y = pk2(y[2], y[3]); } else { w.z = pk2(y[0], y[1]); w.w = pk2(y[2], y[3]); } }
                    *(u32x4*)(rowp + 32 * bj) = w;
                    asm volatile("" ::: "memory"); }
            }
    }
};
#define XB_TMO      128
#define XB_XCNT(j)  (256  + 64 * (j))
#define XB_XSUB(j)  (1280 + 64 * (j))
#define XB_XGEN(j)  (2304 + 64 * (j))
#define XB_TOP      3328
#define XB_TOPGEN   3392
#define XCD_BAR_WORDS 3456
#define XB_SPIN_CAP (1u << 18)

__device__ __forceinline__ unsigned xb_ld(unsigned* p)              { return __hip_atomic_load(p, __ATOMIC_RELAXED, __HIP_MEMORY_SCOPE_AGENT); }
__device__ __forceinline__ unsigned xb_add(unsigned* p, unsigned v) { return __hip_atomic_fetch_add(p, v, __ATOMIC_RELAXED, __HIP_MEMORY_SCOPE_AGENT); }
__device__ __forceinline__ unsigned xb_xcc_id() { return (unsigned)__builtin_amdgcn_s_getreg((3 << 11) | 20) & 0xFu; }
#define XB_SPIN(cond, bar) do { unsigned _sp = 0; while (cond) { __builtin_amdgcn_s_sleep(1); \
    if ((++_sp & 255u) == 0u) { if (xb_ld(&(bar)[XB_TMO])) break; if (_sp > XB_SPIN_CAP) { atomicAdd(&(bar)[XB_TMO], 1u); break; } } } } while (0)

struct XcdBarrier {
    unsigned* bar; unsigned x;
    volatile LAS unsigned* st;
};

__device__ __forceinline__ XcdBarrier xcd_barrier_post(unsigned* bar, volatile LAS unsigned* st) {
    XcdBarrier b; b.bar = bar; b.x = xb_xcc_id(); b.st = st;
    if (threadIdx.x == 0) (void)xb_add(&bar[XB_XCNT(b.x)], 1u);
    return b;
}
__device__ __forceinline__ void xcd_barrier_complete(unsigned* bar, unsigned x, unsigned& nloc, unsigned& nx) {
    const unsigned G = gridDim.x * gridDim.y * gridDim.z;
    unsigned sum, cnt, mine, sp = 0u;
    for (;;) {
        sum = 0u; cnt = 0u; mine = 0u;
#pragma unroll
        for (unsigned j = 0; j < 16; ++j) { const unsigned c = xb_ld(&bar[XB_XCNT(j)]); sum += c; cnt += (c > 0u) ? 1u : 0u; mine = (j == x) ? c : mine; }
        if (sum == G) break;
        __builtin_amdgcn_s_sleep(1);
        if ((++sp & 255u) == 0u) { if (xb_ld(&bar[XB_TMO])) break; if (sp > XB_SPIN_CAP) { atomicAdd(&bar[XB_TMO], 1u); break; } }
    }
    nloc = mine > 0u ? mine : 1u; nx = cnt > 0u ? cnt : 1u;
}

__device__ __forceinline__ void xcd_barrier(const XcdBarrier& b) {
    asm volatile("s_waitcnt vmcnt(0)" ::: "memory");
    __syncthreads();
    if (threadIdx.x == 0) {
        unsigned* bar = b.bar;
        __builtin_amdgcn_s_waitcnt(0);
        unsigned nloc = b.st[0], nx = b.st[1];
        if (nloc == 0u) { xcd_barrier_complete(bar, b.x, nloc, nx); b.st[0] = nloc; b.st[1] = nx; }
        const unsigned old = xb_add(&bar[XB_XSUB(b.x)], 1u);
        const unsigned gen = old / nloc;
        if (old + 1u == (gen + 1u) * nloc) {
            __builtin_amdgcn_fence(__ATOMIC_RELEASE, "agent");
            asm volatile("s_waitcnt vmcnt(0)" ::: "memory");
            const unsigned og = xb_add(&bar[XB_TOP], 1u);
            const unsigned tg = og / nx;
            if (og + 1u == (tg + 1u) * nx) xb_add(&bar[XB_TOPGEN], 1u);
            else XB_SPIN(xb_ld(&bar[XB_TOPGEN]) == tg, bar);
            __builtin_amdgcn_fence(__ATOMIC_ACQUIRE, "agent");
            xb_add(&bar[XB_XGEN(b.x)], 1u);
            asm volatile("s_waitcnt vmcnt(0)" ::: "memory");
        } else {
            XB_SPIN(xb_ld(&bar[XB_XGEN(b.x)]) == gen, bar);
            __builtin_amdgcn_fence(__ATOMIC_ACQUIRE, "agent");
            asm volatile("s_waitcnt vmcnt(0)" ::: "memory");
        }
    }
    __syncthreads();
}
constexpr int NA_KLD = 72, NA_VLD = 264;
__device__ __forceinline__ void na_task(const Params& p, int b, int h, int i, int j, int lane, const LAS bf16_t* Kc, const LAS bf16_t* VTc, const LAS float* rpb) {
    const int fr = lane & 15, fq = lane >> 4;
    const bf16_t* Q = (const bf16_t*)(p.ws + OFF_Q); const bf16_t* K = (const bf16_t*)(p.ws + OFF_K);
    const bf16_t* VT = (const bf16_t*)(p.ws + OFF_VT);
    bf16_t* MIX = (bf16_t*)(p.ws + OFF_MIX);
    const size_t qrow = (size_t)b * T + i * 64 + 16 * j + fr;
    const bf16_t* qp = Q + qrow * 512 + h * 64 + 8 * fq;
    const bf16x8 q0 = *(const bf16x8*)qp, q1 = *(const bf16x8*)(qp + 32);
    const int rs = min(max(i - 4, 0), 248);
    const int cb = (j == 0) ? 0 : (j == 1) ? 8 : (j == 2) ? 24 : 32;
    const int c = 16 * j + fr, cs = min(max(c - 8, 0), 48);
    float m_run = -INFINITY, l_run = 0.f;
    f32x4 o[4];
#pragma unroll
    for (int dt = 0; dt < 4; ++dt) o[dt] = (f32x4){0.f, 0.f, 0.f, 0.f};
    const bf16_t* vt_base = VT + ((size_t)(b * 8 + h) * 64 + fr) * T;
#pragma unroll
    for (int half = 0; half < 2; ++half) {
    const bool win = half == 0;
#pragma unroll 1
    for (int grp = 2 * half; grp < 2 * half + 2; ++grp) {
        f32x4 s[8];
#pragma unroll
        for (int kt = 0; kt < 8; ++kt) {
            int rr = 0, nt = 0; bf16x8 k0, k1;
            if (win) { rr = grp * 4 + (kt >> 1); nt = kt & 1; const size_t krow = (size_t)b * T + (rs + rr) * 64 + cb + 16 * nt + fr;
                const bf16_t* kp = K + krow * 512 + h * 64 + 8 * fq; k0 = *(const bf16x8*)kp; k1 = *(const bf16x8*)(kp + 32); }
            else { const LAS bf16_t* kp = Kc + ((grp - 2) * 128 + kt * 16 + fr) * NA_KLD + 8 * fq; k0 = *(const LAS bf16x8*)kp; k1 = *(const LAS bf16x8*)(kp + 32); }
            f32x4 a = {0.f, 0.f, 0.f, 0.f};
            a = __builtin_amdgcn_mfma_f32_16x16x32_bf16(k0, q0, a, 0, 0, 0);
            a = __builtin_amdgcn_mfma_f32_16x16x32_bf16(k1, q1, a, 0, 0, 0);
            if (win) {
                const int di = rs + rr - i + 7;
#pragma unroll
                for (int e = 0; e < 4; ++e) { const int kc = cb + 16 * nt + 4 * fq + e; const bool valid = (kc >= cs) && (kc < cs + 16);
                    const int dj = min(max(kc - c + 15, 0), 30);
                    const float bias = rpb[di * 31 + dj];
                    a[e] = valid ? a[e] + bias : -INFINITY; }
            }
            s[kt] = a;
        }
        float gmax = -INFINITY;
#pragma unroll
        for (int kt = 0; kt < 8; ++kt)
#pragma unroll
            for (int e = 0; e < 4; ++e) gmax = fmaxf(gmax, s[kt][e]);
        gmax = fmaxf(gmax, __shfl_xor(gmax, 16)); gmax = fmaxf(gmax, __shfl_xor(gmax, 32));
        const float m_new = fmaxf(m_run, gmax);
        const float alpha = __expf(m_run - m_new);
        float psum = 0.f;
#pragma unroll
        for (int kt = 0; kt < 8; ++kt)
#pragma unroll
            for (int e = 0; e < 4; ++e) { const float pv = __expf(s[kt][e] - m_new); psum += pv; s[kt][e] = pv; }
        psum += __shfl_xor(psum, 16); psum += __shfl_xor(psum, 32);
        l_run = l_run * alpha + psum; m_run = m_new;
#pragma unroll
        for (int dt = 0; dt < 4; ++dt) o[dt] *= alpha;
#pragma unroll
        for (int k2 = 0; k2 < 4; ++k2) {
            u32x4 pw; pw.x = pk2(s[2 * k2][0], s[2 * k2][1]); pw.y = pk2(s[2 * k2][2], s[2 * k2][3]); pw.z = pk2(s[2 * k2 + 1][0], s[2 * k2 + 1][1]); pw.w = pk2(s[2 * k2 + 1][2], s[2 * k2 + 1][3]);
            const bf16x8 pb = __builtin_bit_cast(bf16x8, pw);
            if (win) {
                const bf16_t* vp = vt_base + (size_t)(rs + grp * 4 + k2) * 64 + cb + 4 * fq; const size_t dstride = (size_t)16 * T;
#pragma unroll
                for (int dt = 0; dt < 4; ++dt) {
                    const u32x2 lo = *(const u32x2*)(vp + dt * dstride), hi = *(const u32x2*)(vp + dt * dstride + 16);
                    u32x4 vw; vw.x = lo.x; vw.y = lo.y; vw.z = hi.x; vw.w = hi.y;
                    o[dt] = __builtin_amdgcn_mfma_f32_16x16x32_bf16(__builtin_bit_cast(bf16x8, vw), pb, o[dt], 0, 0, 0);
                }
            } else {
                const LAS bf16_t* vp = VTc + fr * NA_VLD + (grp - 2) * 128 + k2 * 32 + 4 * fq;
#pragma unroll
                for (int dt = 0; dt < 4; ++dt) {
                    const u32x2 lo = *(const LAS u32x2*)(vp + dt * 16 * NA_VLD), hi = *(const LAS u32x2*)(vp + dt * 16 * NA_VLD + 16);
                    u32x4 vw; vw.x = lo.x; vw.y = lo.y; vw.z = hi.x; vw.w = hi.y;
                    o[dt] = __builtin_amdgcn_mfma_f32_16x16x32_bf16(__builtin_bit_cast(bf16x8, vw), pb, o[dt], 0, 0, 0);
                }
            }
        }
    }
    }
    const float inv = 1.0f / l_run;
    bf16_t* op = MIX + qrow * 1024 + h * 64 + 4 * fq;
#pragma unroll
    for (int dt = 0; dt < 4; ++dt) { const f32x4 y = o[dt] * inv; u32x2 w; w.x = pk2(y[0], y[1]); w.y = pk2(y[2], y[3]); *(u32x2*)(op + 16 * dt) = w; }
}
template <int NTL>
__device__ __forceinline__ void na_softmax_n(f32x4 (&s)[NTL], float& m_run, float& l_run, f32x4 (&o)[4]) {
    float gmax = -INFINITY;
#pragma unroll
    for (int kt = 0; kt < NTL; ++kt)
#pragma unroll
        for (int e = 0; e < 4; ++e) gmax = fmaxf(gmax, s[kt][e]);
    gmax = fmaxf(gmax, __shfl_xor(gmax, 16)); gmax = fmaxf(gmax, __shfl_xor(gmax, 32));
    const float m_new = fmaxf(m_run, gmax);
    const float alpha = __expf(m_run - m_new);
    float psum = 0.f;
#pragma unroll
    for (int kt = 0; kt < NTL; ++kt)
#pragma unroll
        for (int e = 0; e < 4; ++e) { const float pv = __expf(s[kt][e] - m_new); psum += pv; s[kt][e] = pv; }
    psum += __shfl_xor(psum, 16); psum += __shfl_xor(psum, 32);
    l_run = l_run * alpha + psum; m_run = m_new;
#pragma unroll
    for (int dt = 0; dt < 4; ++dt) o[dt] *= alpha;
}
__device__ __forceinline__ bf16x8 na_pack2(const f32x4& x, const f32x4& y) {
    u32x4 pw; pw.x = pk2(x[0], x[1]); pw.y = pk2(x[2], x[3]); pw.z = pk2(y[0], y[1]); pw.w = pk2(y[2], y[3]); return __builtin_bit_cast(bf16x8, pw);
}
__device__ __forceinline__ void na_task2(const Params& p, int b, int h, int ip, int j, int lane, const LAS bf16_t* Kc, const LAS bf16_t* VTc, const LAS float* rpb) {
    const int fr = lane & 15, fq = lane >> 4;
    const bf16_t* Q = (const bf16_t*)(p.ws + OFF_Q); const bf16_t* K = (const bf16_t*)(p.ws + OFF_K);
    const bf16_t* VT = (const bf16_t*)(p.ws + OFF_VT);
    bf16_t* MIX = (bf16_t*)(p.ws + OFF_MIX);
    const int i0 = 2 * ip;
    const int rs0 = min(max(i0 - 4, 0), 248), rs1 = min(max(i0 - 3, 0), 248);
    const int cb = (j == 0) ? 0 : (j == 1) ? 8 : (j == 2) ? 24 : 32;
    const int c = 16 * j + fr, cs = min(max(c - 8, 0), 48);
    const size_t qrow0 = (size_t)b * T + i0 * 64 + 16 * j + fr;
    bf16x8 q[2][2];
#pragma unroll
    for (int a = 0; a < 2; ++a) { const bf16_t* qp = Q + (qrow0 + a * 64) * 512 + h * 64 + 8 * fq; q[a][0] = *(const bf16x8*)qp; q[a][1] = *(const bf16x8*)(qp + 32); }
    float m_run[2] = {-INFINITY, -INFINITY}, l_run[2] = {0.f, 0.f};
    f32x4 o[2][4];
#pragma unroll
    for (int a = 0; a < 2; ++a)
#pragma unroll
        for (int dt = 0; dt < 4; ++dt) o[a][dt] = (f32x4){0.f, 0.f, 0.f, 0.f};
    const bf16_t* vt_base = VT + ((size_t)(b * 8 + h) * 64 + fr) * T;
#pragma unroll 1
    for (int g = 0; g < 2; ++g) {
        f32x4 s[2][8];
#pragma unroll
        for (int kt = 0; kt < 8; ++kt) { const LAS bf16_t* kp = Kc + (g * 128 + kt * 16 + fr) * NA_KLD + 8 * fq;
            const bf16x8 k0 = *(const LAS bf16x8*)kp, k1 = *(const LAS bf16x8*)(kp + 32);
#pragma unroll
            for (int a = 0; a < 2; ++a) { f32x4 acc = {0.f, 0.f, 0.f, 0.f};
                acc = __builtin_amdgcn_mfma_f32_16x16x32_bf16(k0, q[a][0], acc, 0, 0, 0);
                s[a][kt] = __builtin_amdgcn_mfma_f32_16x16x32_bf16(k1, q[a][1], acc, 0, 0, 0); } }
#pragma unroll
        for (int a = 0; a < 2; ++a) na_softmax_n<8>(s[a], m_run[a], l_run[a], o[a]);
#pragma unroll
        for (int k2 = 0; k2 < 4; ++k2) { const bf16x8 pb0 = na_pack2(s[0][2 * k2], s[0][2 * k2 + 1]), pb1 = na_pack2(s[1][2 * k2], s[1][2 * k2 + 1]);
            const LAS bf16_t* vp = VTc + fr * NA_VLD + g * 128 + k2 * 32 + 4 * fq;
#pragma unroll
            for (int dt = 0; dt < 4; ++dt) { const u32x2 lo = *(const LAS u32x2*)(vp + dt * 16 * NA_VLD), hi = *(const LAS u32x2*)(vp + dt * 16 * NA_VLD + 16);
                u32x4 vw; vw.x = lo.x; vw.y = lo.y; vw.z = hi.x; vw.w = hi.y; const bf16x8 vf = __builtin_bit_cast(bf16x8, vw);
                o[0][dt] = __builtin_amdgcn_mfma_f32_16x16x32_bf16(vf, pb0, o[0][dt], 0, 0, 0);
                o[1][dt] = __builtin_amdgcn_mfma_f32_16x16x32_bf16(vf, pb1, o[1][dt], 0, 0, 0); } }
    }
#pragma unroll 1
    for (int wg = 0; wg < 3; ++wg) {
        f32x4 s[2][6];
#pragma unroll
        for (int kt = 0; kt < 6; ++kt) { const int rr = 3 * wg + (kt >> 1), nt = kt & 1, kru = rs0 + rr, kr = min(kru, 255);
            const bf16_t* kp = K + ((size_t)b * T + kr * 64 + cb + 16 * nt + fr) * 512 + h * 64 + 8 * fq;
            const bf16x8 k0 = *(const bf16x8*)kp, k1 = *(const bf16x8*)(kp + 32);
#pragma unroll
            for (int a = 0; a < 2; ++a) { const int rsa = a ? rs1 : rs0;
                f32x4 acc = {0.f, 0.f, 0.f, 0.f};
                acc = __builtin_amdgcn_mfma_f32_16x16x32_bf16(k0, q[a][0], acc, 0, 0, 0);
                acc = __builtin_amdgcn_mfma_f32_16x16x32_bf16(k1, q[a][1], acc, 0, 0, 0);
                const bool rv = (kru >= rsa) && (kru < rsa + 8);
                const int di = min(max(kru - (i0 + a) + 7, 0), 14);
#pragma unroll
                for (int e = 0; e < 4; ++e) { const int kc = cb + 16 * nt + 4 * fq + e; const bool valid = rv && (kc >= cs) && (kc < cs + 16);
                    const int dj = min(max(kc - c + 15, 0), 30);
                    const float bias = rpb[di * 31 + dj];
                    acc[e] = (acc[e] + bias) + (valid ? 0.0f : -INFINITY); }
                s[a][kt] = acc; } }
#pragma unroll
        for (int a = 0; a < 2; ++a) na_softmax_n<6>(s[a], m_run[a], l_run[a], o[a]);
#pragma unroll
        for (int k2 = 0; k2 < 3; ++k2) { const bf16x8 pb0 = na_pack2(s[0][2 * k2], s[0][2 * k2 + 1]), pb1 = na_pack2(s[1][2 * k2], s[1][2 * k2 + 1]);
            const int kr = min(rs0 + 3 * wg + k2, 255);
            const bf16_t* vp = vt_base + (size_t)kr * 64 + cb + 4 * fq;
#pragma unroll
            for (int dt = 0; dt < 4; ++dt) { const u32x2 lo = *(const u32x2*)(vp + (size_t)dt * 16 * T), hi = *(const u32x2*)(vp + (size_t)dt * 16 * T + 16);
                u32x4 vw; vw.x = lo.x; vw.y = lo.y; vw.z = hi.x; vw.w = hi.y; const bf16x8 vf = __builtin_bit_cast(bf16x8, vw);
                o[0][dt] = __builtin_amdgcn_mfma_f32_16x16x32_bf16(vf, pb0, o[0][dt], 0, 0, 0);
                o[1][dt] = __builtin_amdgcn_mfma_f32_16x16x32_bf16(vf, pb1, o[1][dt], 0, 0, 0); } }
    }
#pragma unroll
    for (int a = 0; a < 2; ++a) { const float inv = 1.0f / l_run[a];
        bf16_t* op = MIX + (qrow0 + a * 64) * 1024 + h * 64 + 4 * fq;
#pragma unroll
        for (int dt = 0; dt < 4; ++dt) { const f32x4 y = o[a][dt] * inv; u32x2 w; w.x = pk2(y[0], y[1]); w.y = pk2(y[2], y[3]); *(u32x2*)(op + 16 * dt) = w; } }
}
template <int NTL>
__device__ __forceinline__ void na_expsum(f32x4 (&s)[NTL], float& l_part) {
#pragma unroll
    for (int kt = 0; kt < NTL; ++kt)
#pragma unroll
        for (int e = 0; e < 4; ++e) { const float pv = __builtin_amdgcn_exp2f(s[kt][e] * 1.44269504f - 14.4269504f); l_part += pv; s[kt][e] = pv; }
}
template <int NR>
__device__ __forceinline__ void na_taskN(const Params& p, int b, int h, int ig, int j, int lane, const LAS bf16_t* Kc, const LAS bf16_t* VTc, const LAS float* rpb) {
    constexpr int NWG = NR + 7;
    const int fr = lane & 15, fq = lane >> 4;
    const bf16_t* Q = (const bf16_t*)(p.ws + OFF_Q); const bf16_t* K = (const bf16_t*)(p.ws + OFF_K);
    const bf16_t* VT = (const bf16_t*)(p.ws + OFF_VT);
    bf16_t* MIX = (bf16_t*)(p.ws + OFF_MIX);
    const int i0 = NR * ig;
    const int rs0 = min(max(i0 - 4, 0), 248);
    const int cb = (j == 0) ? 0 : (j == 1) ? 8 : (j == 2) ? 24 : 32;
    const int c = 16 * j + fr, cs = min(max(c - 8, 0), 48);
    const size_t qrow0 = (size_t)b * T + i0 * 64 + 16 * j + fr;
    bf16x8 q[NR][2];
#pragma unroll
    for (int a = 0; a < NR; ++a) { const bf16_t* qp = Q + (qrow0 + a * 64) * 512 + h * 64 + 8 * fq; q[a][0] = *(const bf16x8*)qp; q[a][1] = *(const bf16x8*)(qp + 32); }
    float l_run[NR];
    f32x4 o[NR][4];
#pragma unroll
    for (int a = 0; a < NR; ++a) { l_run[a] = 0.f;
#pragma unroll
        for (int dt = 0; dt < 4; ++dt) o[a][dt] = (f32x4){0.f, 0.f, 0.f, 0.f}; }
    const bf16_t* vt_base = VT + ((size_t)(b * 8 + h) * 64 + fr) * T;
#pragma unroll 1
    for (int g = 0; g < 8; ++g) {
        f32x4 s[NR][2];
#pragma unroll
        for (int kt = 0; kt < 2; ++kt) { const LAS bf16_t* kp = Kc + (g * 32 + kt * 16 + fr) * NA_KLD + 8 * fq;
            const bf16x8 k0 = *(const LAS bf16x8*)kp, k1 = *(const LAS bf16x8*)(kp + 32);
#pragma unroll
            for (int a = 0; a < NR; ++a) { f32x4 acc = {0.f, 0.f, 0.f, 0.f};
                acc = __builtin_amdgcn_mfma_f32_16x16x32_bf16(k0, q[a][0], acc, 0, 0, 0);
                s[a][kt] = __builtin_amdgcn_mfma_f32_16x16x32_bf16(k1, q[a][1], acc, 0, 0, 0); } }
#pragma unroll
        for (int a = 0; a < NR; ++a) na_expsum<2>(s[a], l_run[a]);
#pragma unroll
        for (int k2 = 0; k2 < 1; ++k2) { bf16x8 pb[NR];
#pragma unroll
            for (int a = 0; a < NR; ++a) pb[a] = na_pack2(s[a][2 * k2], s[a][2 * k2 + 1]);
            const LAS bf16_t* vp = VTc + fr * NA_VLD + g * 32 + k2 * 32 + 4 * fq;
#pragma unroll
            for (int dt = 0; dt < 4; ++dt) { const u32x2 lo = *(const LAS u32x2*)(vp + dt * 16 * NA_VLD), hi = *(const LAS u32x2*)(vp + dt * 16 * NA_VLD + 16);
                u32x4 vw; vw.x = lo.x; vw.y = lo.y; vw.z = hi.x; vw.w = hi.y; const bf16x8 vf = __builtin_bit_cast(bf16x8, vw);
#pragma unroll
                for (int a = 0; a < NR; ++a) o[a][dt] = __builtin_amdgcn_mfma_f32_16x16x32_bf16(vf, pb[a], o[a][dt], 0, 0, 0); } }
    }
#pragma unroll 1
    for (int wg = 0; wg < NWG; ++wg) {
        f32x4 s[NR][2];
        const int kru = rs0 + wg, kr = min(kru, 255);
        bf16x8 kf[2][2];
#pragma unroll
        for (int nt = 0; nt < 2; ++nt) { const bf16_t* kp = K + ((size_t)b * T + kr * 64 + cb + 16 * nt + fr) * 512 + h * 64 + 8 * fq;
            kf[nt][0] = *(const bf16x8*)kp; kf[nt][1] = *(const bf16x8*)(kp + 32); }
        bool rv[NR];
#pragma unroll
        for (int a = 0; a < NR; ++a) { const int rsa = min(max(i0 + a - 4, 0), 248); rv[a] = (kru >= rsa) && (kru < rsa + 8);
            if (rv[a]) {
                const int di = min(max(kru - (i0 + a) + 7, 0), 14);
#pragma unroll
                for (int nt = 0; nt < 2; ++nt) { f32x4 acc = {0.f, 0.f, 0.f, 0.f};
                    acc = __builtin_amdgcn_mfma_f32_16x16x32_bf16(kf[nt][0], q[a][0], acc, 0, 0, 0);
                    acc = __builtin_amdgcn_mfma_f32_16x16x32_bf16(kf[nt][1], q[a][1], acc, 0, 0, 0);
#pragma unroll
                    for (int e = 0; e < 4; ++e) { const int kc = cb + 16 * nt + 4 * fq + e; const bool valid = (kc >= cs) && (kc < cs + 16);
                        const int dj = min(max(kc - c + 15, 0), 30);
                        const float bias = rpb[di * 31 + dj];
                        acc[e] = (acc[e] + bias) + (valid ? 0.0f : -INFINITY); }
                    s[a][nt] = acc; }
                na_expsum<2>(s[a], l_run[a]);
            } else { s[a][0] = (f32x4){0.f, 0.f, 0.f, 0.f}; s[a][1] = (f32x4){0.f, 0.f, 0.f, 0.f}; } }
        bf16x8 pb[NR];
#pragma unroll
        for (int a = 0; a < NR; ++a) pb[a] = na_pack2(s[a][0], s[a][1]);
        const bf16_t* vp = vt_base + (size_t)kr * 64 + cb + 4 * fq;
#pragma unroll
        for (int dt = 0; dt < 4; ++dt) { const u32x2 lo = *(const u32x2*)(vp + (size_t)dt * 16 * T), hi = *(const u32x2*)(vp + (size_t)dt * 16 * T + 16);
            u32x4 vw; vw.x = lo.x; vw.y = lo.y; vw.z = hi.x; vw.w = hi.y; const bf16x8 vf = __builtin_bit_cast(bf16x8, vw);
#pragma unroll
            for (int a = 0; a < NR; ++a) if (rv[a]) o[a][dt] = __builtin_amdgcn_mfma_f32_16x16x32_bf16(vf, pb[a], o[a][dt], 0, 0, 0); }
    }
#pragma unroll
    for (int a = 0; a < NR; ++a) { float lt = l_run[a]; lt += __shfl_xor(lt, 16); lt += __shfl_xor(lt, 32); const float inv = 1.0f / lt;
        bf16_t* op = MIX + (qrow0 + a * 64) * 1024 + h * 64 + 4 * fq;
#pragma unroll
        for (int dt = 0; dt < 4; ++dt) { const f32x4 y = o[a][dt] * inv; u32x2 w; w.x = pk2(y[0], y[1]); w.y = pk2(y[2], y[3]); *(u32x2*)(op + 16 * dt) = w; } }
}
__device__ __forceinline__ void phase_na(const Params& p, LAS unsigned char* lds, int blk, int nblk) {
    const int tid = threadIdx.x, lane = tid & 63, wave = tid >> 6;
    const int bh = blk & 15, sub = blk >> 4, nsub = (nblk - bh + 15) >> 4, b = bh >> 3, h = bh & 7;
    LAS bf16_t* Kc = (LAS bf16_t*)lds; LAS bf16_t* VTc = Kc + 256 * NA_KLD;
    const bf16_t* K = (const bf16_t*)(p.ws + OFF_K); const bf16_t* VTC = (const bf16_t*)(p.ws + OFF_VTC);
    for (int idx = tid; idx < 256 * 8; idx += 512) { const int l = idx >> 3, c8 = idx & 7;
        *(LAS u32x4*)(Kc + l * NA_KLD + 8 * c8) = *(const u32x4*)(K + ((size_t)MT + b * LC + l) * 512 + h * 64 + 8 * c8); }
    for (int idx = tid; idx < 64 * 32; idx += 512) { const int dd = idx >> 5, c8 = idx & 31;
        *(LAS u32x4*)(VTc + dd * NA_VLD + 8 * c8) = *(const u32x4*)(VTC + ((size_t)(b * 8 + h) * 64 + dd) * LC + 8 * c8); }
    LAS float* rpbl = (LAS float*)(VTc + 64 * NA_VLD);
    for (int idx = tid; idx < 15 * 31; idx += 512) rpbl[idx] = p.in[11][h * 15 * 31 + idx];
    __syncthreads();
    for (int wt = sub * 8 + wave; wt < 256; wt += nsub * 8) na_taskN<4>(p, b, h, wt >> 2, wt & 3, lane, Kc, VTc, rpbl);
}

typedef float f32x16 __attribute__((ext_vector_type(16)));
typedef float f32x2 __attribute__((ext_vector_type(2)));
constexpr int SC = 2;
constexpr int CL = 260;
__device__ __forceinline__ void chunk_pos(int b, int d, int q, int i, int& row, bool& hasp, bool& hasn, int& t) {
    const int s = q * CL + i;
    if (s < LC) { const int l = d ? (LC - 1 - s) : s; row = MT + b * LC + l; hasp = l > 0; hasn = l < LC - 1; t = -1; }
    else { const int off = s - LC; t = d ? (T - 1 - off) : off; row = b * T + t; hasp = t > 0; hasn = t < T - 1; }
}
__device__ __forceinline__ void prep_consts(const Params& p, int h, int lane, LAS float* cst) {
    const int hc = h * 64 + lane;
    cst[lane] = p.in[12][hc]; cst[64 + lane] = p.in[13][hc]; cst[128 + lane] = p.in[12][512 + hc]; cst[192 + lane] = p.in[13][512 + hc];
    cst[256 + lane] = p.in[12][1024 + hc]; cst[320 + lane] = p.in[13][1024 + hc];
    cst[384 + lane] = p.in[19][hc]; cst[448 + lane] = p.in[20][hc]; cst[512 + lane] = p.in[21][hc];
}
typedef unsigned short us2 __attribute__((ext_vector_type(2)));
struct RawTok { us2 rk, vd, pa, pb, nn, vn_ar; };
__device__ __forceinline__ RawTok prep_load(const bf16_t* PR, const bf16_t* DEC, const bf16_t* AR, int row, bool hp, bool hn, int hc, int dcol) {
    const bf16_t* pr = PR + (size_t)row * RWP;
    const bf16_t* prp = hp ? pr - RWP : pr; const bf16_t* prn = hn ? pr + RWP : pr;
    RawTok x;
    x.rk = (us2){pr[hc], pr[512 + hc]}; x.vd = (us2){pr[1024 + hc], (DEC + (size_t)row * 1024)[dcol]};
    x.pa = (us2){prp[hc], prp[512 + hc]}; x.pb = (us2){prp[1024 + hc], prn[hc]};
    x.nn = (us2){prn[512 + hc], prn[1024 + hc]}; x.vn_ar = (us2){(AR + (size_t)row * 1024)[dcol], (unsigned short)0};
    return x;
}
__device__ __forceinline__ void prep_compute(const RawTok& x, bool hp, bool hn, const LAS float* cst, LAS float* o, int lane) {
    const float mp_ = hp ? 1.0f : 0.0f, mn_ = hn ? 1.0f : 0.0f;
    const float rc = bf2f(x.rk[0]), kc = bf2f(x.rk[1]), vc = bf2f(x.vd[0]);
    const float rp = mp_ * bf2f(x.pa[0]), kp = mp_ * bf2f(x.pa[1]), vp = mp_ * bf2f(x.pb[0]);
    const float rn = mn_ * bf2f(x.pb[1]), kn = mn_ * bf2f(x.nn[0]), vn = mn_ * bf2f(x.nn[1]);
    const float r = rc + cst[lane] * (rp - rc) + cst[64 + lane] * (rn - rc);
    const float k = kc + cst[128 + lane] * (kp - kc) + cst[192 + lane] * (kn - kc);
    const float v = vc + cst[256 + lane] * (vp - vc) + cst[320 + lane] * (vn - vc);
    const float w = __expf(bf2f(x.vd[1]));
    const float a = bf2f(x.vn_ar[0]);
    const float kkr = k * cst[384 + lane];
    const float ss = wave_sum(kkr * kkr);
    const float kk = kkr * __builtin_amdgcn_rsqf(fmaxf(ss, 1e-24f));
    const float kd = k * (1.0f + (a - 1.0f) * cst[448 + lane]);
    o[lane] = w; o[64 + lane] = -kk; o[128 + lane] = kk * a; o[192 + lane] = kd; o[256 + lane] = r; o[320 + lane] = v;
}
#define LO2(x) ((f32x2){(x)[0], (x)[1]})
#define HI2(x) ((f32x2){(x)[2], (x)[3]})
template <int MODE>
__device__ __forceinline__ float rec_step(f32x2 (&s)[32], f32x2 (&pm)[32], const LAS float* o, int lane, float& zout) {
    constexpr int GA = 2;
    constexpr int GU = 1;
    const float vv = o[320 + lane];
    f32x2 sacc0 = {0.f, 0.f}, sacc1 = {0.f, 0.f}, pacc0 = {0.f, 0.f}, pacc1 = {0.f, 0.f};
    f32x4 abuf[2][GA];
#pragma unroll
    for (int i = 0; i < GA; ++i) abuf[0][i] = *(const LAS f32x4*)(o + 64 + 4 * i);
    f32x4 wb[2][GU], bb[2][GU], kb[2][GU], rb[2][GU];
#pragma unroll
    for (int gg = 0; gg < 16 / GA; ++gg) {
        if (gg < 16 / GA - 1) {
#pragma unroll
            for (int i = 0; i < GA; ++i) abuf[(gg + 1) & 1][i] = *(const LAS f32x4*)(o + 64 + 4 * GA * (gg + 1) + 4 * i);
        } else {
#pragma unroll
            for (int i = 0; i < GU; ++i) { wb[0][i] = *(const LAS f32x4*)(o + 4 * i); bb[0][i] = *(const LAS f32x4*)(o + 128 + 4 * i); kb[0][i] = *(const LAS f32x4*)(o + 192 + 4 * i);
                if (MODE != 0) rb[0][i] = *(const LAS f32x4*)(o + 256 + 4 * i); }
        }
        ;
#pragma unroll
        for (int i = 0; i < GA; ++i) { const int g = GA * gg + i; const f32x4 a4 = abuf[gg & 1][i];
            sacc0 += s[2 * g] * LO2(a4); sacc1 += s[2 * g + 1] * HI2(a4);
            if (MODE != 1) { pacc0 += pm[2 * g] * LO2(a4); pacc1 += pm[2 * g + 1] * HI2(a4); } }
        ;
    }
    const f32x2 sacc = sacc0 + sacc1, pacc = pacc0 + pacc1;
    const float sa = sacc.x + sacc.y, pa = pacc.x + pacc.y;
    const f32x2 sa2 = {sa, sa}, pa2 = {pa, pa}, vv2 = {vv, vv};
    f32x2 yacc0 = {0.f, 0.f}, yacc1 = {0.f, 0.f}, zacc0 = {0.f, 0.f}, zacc1 = {0.f, 0.f};
#pragma unroll
    for (int gg = 0; gg < 16 / GU; ++gg) {
        if (gg < 16 / GU - 1) {
#pragma unroll
            for (int i = 0; i < GU; ++i) { const int g = GU * (gg + 1) + i; wb[(gg + 1) & 1][i] = *(const LAS f32x4*)(o + 4 * g); bb[(gg + 1) & 1][i] = *(const LAS f32x4*)(o + 128 + 4 * g);
                kb[(gg + 1) & 1][i] = *(const LAS f32x4*)(o + 192 + 4 * g); if (MODE != 0) rb[(gg + 1) & 1][i] = *(const LAS f32x4*)(o + 256 + 4 * g); }
        }
        ;
#pragma unroll
        for (int i = 0; i < GU; ++i) { const int g = GU * gg + i; const f32x4 w4 = wb[gg & 1][i], b4 = bb[gg & 1][i], k4 = kb[gg & 1][i];
            s[2 * g] = s[2 * g] * LO2(w4) + sa2 * LO2(b4) + vv2 * LO2(k4);
            s[2 * g + 1] = s[2 * g + 1] * HI2(w4) + sa2 * HI2(b4) + vv2 * HI2(k4);
            if (MODE != 1) { pm[2 * g] = pm[2 * g] * LO2(w4) + pa2 * LO2(b4); pm[2 * g + 1] = pm[2 * g + 1] * HI2(w4) + pa2 * HI2(b4); }
            if (MODE != 0) { const f32x4 r4 = rb[gg & 1][i]; yacc0 += s[2 * g] * LO2(r4); yacc1 += s[2 * g + 1] * HI2(r4);
                if (MODE == 2) { zacc0 += pm[2 * g] * LO2(r4); zacc1 += pm[2 * g + 1] * HI2(r4); } } }
        ;
    }
    const f32x2 yacc = yacc0 + yacc1, zacc = zacc0 + zacc1;
    zout = zacc.x + zacc.y;
    return yacc.x + yacc.y;
}
template <bool DO_PREP = true, bool DO_REC = true, bool DUMMY = false>
__device__ __forceinline__ void phase_pass1(const Params& p, LAS unsigned char* lds) {
    const int lane = threadIdx.x & 63, wave = __builtin_amdgcn_readfirstlane(threadIdx.x >> 6);
    const bf16_t* PR = (const bf16_t*)(p.ws + OFF_PR); const bf16_t* DEC = (const bf16_t*)(p.ws + OFF_DEC); const bf16_t* AR = (const bf16_t*)(p.ws + OFF_AR);
    LAS float* stg = (LAS float*)lds + wave * (SC * 384);
    LAS float* cst = (LAS float*)lds + 8 * (SC * 384) + wave * 576;
    for (int tk = blockIdx.x; tk < 256; tk += gridDim.x) {
        const int b = tk >> 7, d = (tk >> 6) & 1, q = tk & 63, h = wave, ch = (b * 8 + h) * 2 + d;
        prep_consts(p, h, lane, cst);
        const int hc = h * 64 + lane, dcol = d * 512 + hc;
        unsigned* YZ = d ? (unsigned*)(p.ws + OFF_Q) : (unsigned*)p.out;
        f32x2 s[32], pm[32];
#pragma unroll
        for (int i = 0; i < 32; i += 2) { const f32x4 x = *(const f32x4*)((const float*)(p.ws + OFF_IDENT) + lane * 64 + 2 * i);
            s[i] = (f32x2){0.f, 0.f}; s[i + 1] = (f32x2){0.f, 0.f}; pm[i] = (f32x2){x[0], x[1]}; pm[i + 1] = (f32x2){x[2], x[3]}; }
        RawTok raw[SC];
#pragma unroll
        for (int j = 0; j < SC; ++j) { int row, t; bool hp_, hn_; chunk_pos(b, d, q, j, row, hp_, hn_, t); raw[j] = prep_load(PR, DEC, AR, row, hp_, hn_, hc, dcol); }
#pragma unroll 1
        for (int it = 0; it < CL / SC; ++it) {
            int row0 = 0, t0 = 0;
            { int hr_, ht_; bool x1, x2; chunk_pos(b, d, q, it * SC, hr_, x1, x2, ht_); row0 = hr_; t0 = ht_; }
            if (DO_PREP) {
#pragma unroll
                for (int j = 0; j < SC; ++j) { int row, t; bool hp_, hn_; chunk_pos(b, d, q, it * SC + j, row, hp_, hn_, t); prep_compute(raw[j], hp_, hn_, cst, stg + j * 384, lane); asm volatile("" ::: "memory"); }
                const int itn = min(it + 1, CL / SC - 1);
#pragma unroll
                for (int j = 0; j < SC; ++j) { int row, t; bool hp_, hn_; chunk_pos(b, d, q, itn * SC + j, row, hp_, hn_, t); raw[j] = prep_load(PR, DEC, AR, row, hp_, hn_, hc, dcol); }
            }
            if (DO_REC) {
                const bool latent = t0 >= 0 && !DUMMY;
                int rowc = row0; const int rstep = d ? -1 : 1;
#pragma unroll 1
                for (int st = 0; st < SC; ++st) { float z; const float y = rec_step<2>(s, pm, stg + st * 384, lane, z);
                    if (latent) (YZ + (size_t)rowc * 512)[hc] = pk2(y, z); rowc += rstep; }
            }
        }
        float* hp = p.out + (DUMMY ? 0 : (size_t)MT * 512) + ((size_t)(ch * 64 + q) * 2) * 4096 + lane * 64;
        if (!DUMMY) {
#pragma unroll
        for (int i = 0; i < 32; i += 2) { *(f32x4*)(hp + 2 * i) = (f32x4){s[i].x, s[i].y, s[i + 1].x, s[i + 1].y}; *(f32x4*)(hp + 4096 + 2 * i) = (f32x4){pm[i].x, pm[i].y, pm[i + 1].x, pm[i + 1].y}; }
        }
    }
}
__device__ __forceinline__ void phase_pass2(const Params& p, LAS unsigned char* lds, int ch, int mt) {
    constexpr int LDP = 68;
    LAS float* Sl = (LAS float*)lds; LAS float* Pl = Sl + 16 * LDP;
    const int tid = threadIdx.x, lane = tid & 63, w = tid >> 6, fr = lane & 15, fq = lane >> 4;
    const float* HP = p.out + (size_t)MT * 512 + (size_t)ch * 64 * 8192;
    float* SST = (float*)(p.ws + OFF_SST) + (size_t)ch * 65 * 4096;
    __syncthreads();
    for (int idx = tid; idx < 16 * LDP; idx += 512) Sl[idx] = 0.f;
    for (int idx = tid; idx < 1024; idx += 512) SST[mt * 1024 + idx] = 0.f;
    const int pidx = tid * 8, pj = pidx >> 6, pk = pidx & 63;
    f32x4 px0 = *(const f32x4*)(HP + 4096 + pidx), px1 = *(const f32x4*)(HP + 4096 + pidx + 4);
    f32x4 hx = {0.f, 0.f, 0.f, 0.f};
    if (w < 4) {
#pragma unroll
        for (int e = 0; e < 4; ++e) hx[e] = HP[(16 * mt + 4 * fq + e) * 64 + 16 * w + fr];
    }
#pragma unroll 1
    for (int q = 0; q < 63; ++q) {
        *(LAS f32x4*)(Pl + pj * LDP + pk) = px0; *(LAS f32x4*)(Pl + pj * LDP + pk + 4) = px1;
        f32x4 acc = hx;
        const float* Hn = HP + (size_t)min(q + 1, 62) * 8192;
        px0 = *(const f32x4*)(Hn + 4096 + pidx); px1 = *(const f32x4*)(Hn + 4096 + pidx + 4);
        if (w < 4) {
#pragma unroll
            for (int e = 0; e < 4; ++e) hx[e] = Hn[(16 * mt + 4 * fq + e) * 64 + 16 * w + fr];
        }
        asm volatile("s_waitcnt lgkmcnt(0)\n\ts_barrier" ::: "memory");
        if (w < 4) {
#pragma unroll
            for (int ks = 0; ks < 16; ++ks) {
                const float a = Sl[fr * LDP + 4 * ks + fq];
                const float b0 = Pl[(4 * ks + fq) * LDP + 16 * w + fr];
                acc = __builtin_amdgcn_mfma_f32_16x16x4f32(a, b0, acc, 0, 0, 0);
            }
        }
        asm volatile("s_waitcnt lgkmcnt(0)\n\ts_barrier" ::: "memory");
        if (w < 4) {
#pragma unroll
            for (int e = 0; e < 4; ++e) { const int vl = 4 * fq + e, k = 16 * w + fr; Sl[vl * LDP + k] = acc[e]; SST[(size_t)(q + 1) * 4096 + (16 * mt + vl) * 64 + k] = acc[e]; }
        }
    }
}
struct FinRaw { unsigned yz0, yz1; us2 gv, rk, pa, pb, nn, aa; };
__device__ __forceinline__ FinRaw fin_load(const bf16_t* PR, const bf16_t* AR, const bf16_t* MIX, const unsigned* YZ0, const unsigned* YZ1, int b, int t, int c) {
    const int row = b * T + t;
    const bf16_t* pr = PR + (size_t)row * RWP; const bf16_t* prp = t > 0 ? pr - RWP : pr; const bf16_t* prn = t < T - 1 ? pr + RWP : pr;
    const bf16_t* ar = AR + (size_t)row * 1024;
    FinRaw x;
    x.yz0 = (YZ0 + (size_t)row * 512)[c]; x.yz1 = (YZ1 + (size_t)row * 512)[c]; x.gv = (us2){(MIX + (size_t)row * 1024 + 512)[c], pr[1024 + c]};
    x.rk = (us2){pr[c], pr[512 + c]}; x.pa = (us2){prp[c], prp[512 + c]}; x.pb = (us2){prp[1024 + c], prn[c]};
    x.nn = (us2){prn[512 + c], prn[1024 + c]}; x.aa = (us2){ar[c], ar[512 + c]};
    return x;
}
__device__ __forceinline__ void phase_fixfinish(const Params& p, LAS unsigned char* lds) {
    const int tid = threadIdx.x, lane = tid & 63, wave = __builtin_amdgcn_readfirstlane(tid >> 6);
    const bf16_t* PR = (const bf16_t*)(p.ws + OFF_PR); const bf16_t* AR = (const bf16_t*)(p.ws + OFF_AR);
    bf16_t* MIX = (bf16_t*)(p.ws + OFF_MIX);
    const float* mup = p.in[12]; const float* mun = p.in[13];
    const int h = wave, c = h * 64 + lane;
    const float lng = p.in[22][c], lnb = p.in[23][c];
    const float mpv = mup[1024 + c], mnv = mun[1024 + c], mpr = mup[c], mnr = mun[c], mpk = mup[512 + c], mnk = mun[512 + c], kac = p.in[20][c], rkc = p.in[21][c];
    const unsigned* YZ0 = (const unsigned*)p.out; const unsigned* YZ1 = (const unsigned*)(p.ws + OFF_Q);
    const float* SSTb = (const float*)(p.ws + OFF_SST);
    LAS float* zb = (LAS float*)lds + wave * 128;
    constexpr int NT = 2;
    for (int tk = blockIdx.x; tk < 256; tk += gridDim.x) {
        const int b = tk >> 7, m = tk & 127;
        const float* S0base = SSTb + (size_t)((b * 8 + h) * 2 + 0) * 65 * 4096 + lane * 64;
        const float* S1base = SSTb + (size_t)((b * 8 + h) * 2 + 1) * 65 * 4096 + lane * 64;
        f32x2 s0[32], s1[32]; int q0c = -1, q1c = -1;
        FinRaw fr[NT];
#pragma unroll
        for (int j = 0; j < NT; ++j) fr[j] = fin_load(PR, AR, MIX, YZ0, YZ1, b, m * 128 + j, c);
#pragma unroll 1
        for (int tl0 = 0; tl0 < 128; tl0 += NT) {
            FinRaw cur[NT];
#pragma unroll
            for (int j = 0; j < NT; ++j) cur[j] = fr[j];
            const int tn0 = m * 128 + min(tl0 + NT, 128 - NT);
#pragma unroll
            for (int j = 0; j < NT; ++j) fr[j] = fin_load(PR, AR, MIX, YZ0, YZ1, b, tn0 + j, c);
#pragma unroll
            for (int j = 0; j < NT; ++j) {
                const int t = m * 128 + tl0 + j, row = b * T + t;
                const int q0 = (LC + t) / CL, q1 = (LC + T - 1 - t) / CL;
                if (q0 != q0c) { q0c = q0; const float* sp = S0base + (size_t)q0 * 4096;
#pragma unroll
                    for (int i = 0; i < 32; i += 2) { const f32x4 x = *(const f32x4*)(sp + 2 * i); s0[i] = (f32x2){x[0], x[1]}; s0[i + 1] = (f32x2){x[2], x[3]}; } }
                if (q1 != q1c) { q1c = q1; const float* sp = S1base + (size_t)q1 * 4096;
#pragma unroll
                    for (int i = 0; i < 32; i += 2) { const f32x4 x = *(const f32x4*)(sp + 2 * i); s1[i] = (f32x2){x[0], x[1]}; s1[i + 1] = (f32x2){x[2], x[3]}; } }
                const FinRaw& x = cur[j];
                zb[lane] = __uint_as_float(x.yz0 & 0xffff0000u); zb[64 + lane] = __uint_as_float(x.yz1 & 0xffff0000u);
                float w = __uint_as_float(x.yz0 << 16) + __uint_as_float(x.yz1 << 16);
                const float gte = bf2f(x.gv[0]);
                const float mp_ = t > 0 ? 1.0f : 0.0f, mn_ = t < T - 1 ? 1.0f : 0.0f;
                const float vc = bf2f(x.gv[1]), rc = bf2f(x.rk[0]), kc = bf2f(x.rk[1]);
                const float rp = mp_ * bf2f(x.pa[0]), kp = mp_ * bf2f(x.pa[1]), vp = mp_ * bf2f(x.pb[0]);
                const float rn = mn_ * bf2f(x.pb[1]), kn = mn_ * bf2f(x.nn[0]), vn = mn_ * bf2f(x.nn[1]);
                const float a0 = bf2f(x.aa[0]), a1 = bf2f(x.aa[1]);
                f32x2 acc0 = {0.f, 0.f}, acc1 = {0.f, 0.f};
#pragma unroll
                for (int g = 0; g < 16; ++g) { const f32x4 za = *(const LAS f32x4*)(zb + 4 * g), zc = *(const LAS f32x4*)(zb + 64 + 4 * g);
                    acc0 += s0[2 * g] * LO2(za); acc0 += s0[2 * g + 1] * HI2(za); acc1 += s1[2 * g] * LO2(zc); acc1 += s1[2 * g + 1] * HI2(zc); }
                const f32x2 acc = acc0 + acc1; w += acc.x + acc.y;
                const float mu = wave_sum(w) * (1.0f / 64.0f);
                const float dv = w - mu;
                const float var = wave_sum(dv * dv) * (1.0f / 64.0f);
                float y = dv * rsqrtf(var + 64e-5f) * lng + lnb;
                const float vs = vc + mpv * (vp - vc) + mnv * (vn - vc);
                const float rs = rc + mpr * (rp - rc) + mnr * (rn - rc);
                const float ks = kc + mpk * (kp - kc) + mnk * (kn - kc);
                const float bon = wave_sum(rs * ks * rkc * (2.0f + (a0 + a1 - 2.0f) * kac));
                y = (y + bon * vs) * gte;
                MIX[(size_t)row * 1024 + 512 + c] = f2bf(y);
            }
        }
    }
}

__global__ void __launch_bounds__(512) mega(Params p) {
    extern __shared__ __attribute__((aligned(16))) unsigned char shm[];
    LAS unsigned char* lds = (LAS unsigned char*)shm;
    cg::grid_group grid = cg::this_grid();
    __shared__ unsigned xb_words[4];
    if (threadIdx.x < 4) xb_words[threadIdx.x] = 0u;
    __syncthreads();
    const XcdBarrier xb = xcd_barrier_post((unsigned*)(p.ws + OFF_BAR), (volatile LAS unsigned*)xb_words);
    const float* mod = (const float*)(p.ws + OFF_MOD);
#ifndef PHMASK
#define PHMASK 0x1fff
#endif
#ifndef REPMASK
#define REPMASK 0
#endif
#define HAS(x) ((PHMASK >> (x)) & 1)
#define RUN(k) (HAS(k) && p.ph_lo <= (k) && (k) < p.ph_hi)
#define SYNC(k) do { if (p.ph_lo <= (k) && (k) + 1 < p.ph_hi) { if ((k) == 0) grid.sync(); else xcd_barrier(xb); } } while (0)
#define PHASE(k, ...) do { if (RUN(k)) { __VA_ARGS__; if ((REPMASK >> (k)) & 1) { xcd_barrier(xb); __VA_ARGS__; } } SYNC(k); } while (0)
#define GEMM_PH_W(EPI, Aoff, Boff, M_, N_, K_, LD_, THR_, KOFF_, ...) { int kk_ = (K_); asm volatile("" : "+s"(kk_)); pg8::Gemm g{(const bf16_t*)(p.ws + (Aoff)), (const bf16_t*)(p.ws + (Boff)), (M_), (N_), kk_, (LD_), (THR_), (KOFF_)}; \
        pg8::StaticOrder S; S.init((M_), (N_), (int)gridDim.x, (int)blockIdx.x); EPI E{__VA_ARGS__}; pg8::gemm_phase<EPI, pg8::StaticOrder, false>(lds, g, S, E, nullptr); }
#define GEMM_PH(EPI, Aoff, Boff, M_, N_, K_, ...) { int kk_ = (K_); asm volatile("" : "+s"(kk_)); pg8::Gemm g{(const bf16_t*)(p.ws + (Aoff)), (const bf16_t*)(p.ws + (Boff)), (M_), (N_), kk_}; \
        pg8::StaticOrder S; S.init((M_), (N_), (int)gridDim.x, (int)blockIdx.x); EPI E{__VA_ARGS__}; pg8::gemm_phase<EPI, pg8::StaticOrder, false>(lds, g, S, E, nullptr); }
    PHASE(0, phase0(p, lds));
    PHASE(1, phase_norm(p, 0));
    PHASE(2, GEMM_PH(EpiIn, OFF_U, OFF_WIN, MA, INPP, 1024, (bf16_t*)(p.ws + OFF_Q), (bf16_t*)(p.ws + OFF_K), (bf16_t*)(p.ws + OFF_VT), (bf16_t*)(p.ws + OFF_VTC), (bf16_t*)(p.ws + OFF_PR), p.in[9], p.in[10]));
    PHASE(3, phase_shiftprep(p); phase_na(p, lds, (int)blockIdx.x, (int)gridDim.x));
    PHASE(4, GEMM_PH_W(EpiLora, OFF_LA, OFF_LORAB, MA, 2560, 256, 384, 8, 128, (bf16_t*)(p.ws + OFF_DEC), (bf16_t*)(p.ws + OFF_AR), (bf16_t*)(p.ws + OFF_MIX), p.in[14], p.in[16]));
    PHASE(6, phase_pass1(p, lds));
    PHASE(7, if ((int)gridDim.x > NCHAIN * 4 && (int)blockIdx.x >= NCHAIN * 4) weight_transposes(p, lds, W_EARLY, W_ALL, ((int)blockIdx.x - NCHAIN * 4) * 8 + (int)(threadIdx.x >> 6), ((int)gridDim.x - NCHAIN * 4) * 8);
             else { for (int it_ = blockIdx.x; it_ < NCHAIN * 4; it_ += ((int)gridDim.x > NCHAIN * 4 ? NCHAIN * 4 : (int)gridDim.x)) phase_pass2(p, lds, it_ >> 2, it_ & 3);
                    if ((int)gridDim.x <= NCHAIN * 4) weight_transposes(p, lds, W_EARLY, W_ALL, (int)blockIdx.x * 8 + (int)(threadIdx.x >> 6), (int)gridDim.x * 8); });
    PHASE(8, phase_fixfinish(p, lds));
    PHASE(9, GEMM_PH(EpiRes, OFF_MIX, OFF_WOUT, MT, 1024, 1024, p.in[0], p.out, mod + 2 * 1024));
    PHASE(10, phase_norm(p, 1));
    PHASE(11, GEMM_PH(EpiGlu, OFF_U, OFF_WF1, MT, 2 * DFF, 1024, (bf16_t*)(p.ws + OFF_ACT)));
    PHASE(12, GEMM_PH(EpiRes, OFF_ACT, OFF_WF2, MT, 1024, DFF, p.out, p.out, mod + 5 * 1024));
}

extern "C" void kernel_launch(void* const* d_in, const int* in_sizes, int n_in, void* d_out, int out_size, void* d_ws, size_t ws_size, hipStream_t stream) {
    static int grid = 0;
    if (!grid) {
        int dev = 0, cus = 0, per_cu = 0;
        (void)hipGetDevice(&dev);
        (void)hipDeviceGetAttribute(&cus, hipDeviceAttributeMultiprocessorCount, dev);
        (void)hipFuncSetAttribute((const void*)mega, hipFuncAttributeMaxDynamicSharedMemorySize, LDS_BYTES);
        if (hipOccupancyMaxActiveBlocksPerMultiprocessor(&per_cu, (const void*)mega, 512, LDS_BYTES) != hipSuccess || per_cu < 1) { (void)hipGetLastError(); per_cu = 1; }
        grid = cus * per_cu;
        if (ws_size < OFF_END) fprintf(stderr, "kernel_launch: workspace too small: %zu < %zu\n", ws_size, (size_t)OFF_END);
    }
    Params p{};
    for (int i = 0; i < 27; ++i) p.in[i] = (const float*)d_in[i];
    p.out = (float*)d_out; p.ws = (unsigned char*)d_ws; p.ph_lo = 0; p.ph_hi = 13;
    (void)hipMemsetAsync((unsigned char*)d_ws + OFF_BAR, 0, 16384, stream);
    void* args[] = {&p};
    hipError_t e = hipLaunchCooperativeKernel((const void*)mega, dim3(grid), dim3(512), args, LDS_BYTES, stream);
    if (e != hipSuccess) fprintf(stderr, "cooperative launch failed: %s (grid %d)\n", hipGetErrorString(e), grid);
}
```

```cpp
#include <hip/hip_runtime.h>
#include <hip/hip_cooperative_groups.h>
#include <cstdio>
namespace cg = cooperative_groups;
namespace pg8 {
#define PG8_LAS __attribute__((address_space(3)))
typedef unsigned short bf16_t;
typedef short bf16x8 __attribute__((ext_vector_type(8)));
typedef float f32x4 __attribute__((ext_vector_type(4)));
typedef unsigned u32x4 __attribute__((ext_vector_type(4)));
constexpr int BM = 256, BK = 64, HALF = 128, HTB = HALF * BK * 2  , STAGE_BYTES = 8 * HTB, NXCD = 8, WGM = 8;

__host__ __device__ __forceinline__ int lds_byte(int r, int c) { const int st = (r >> 4) * 2 + (c >> 5), rr = r & 15, cc = c & 31, ob = rr * 64 + cc * 2; return st * 1024 + (ob ^ (((ob >> 9) & 1) << 5)); }
__host__ __device__ __forceinline__ void stage_rc(int b, int& R, int& C) { const int st = b / 1024, sb = b % 1024, swz = sb ^ (((sb >> 9) & 1) << 5); R = (st >> 1) * 16 + swz / 64; C = (st & 1) * 32 + (swz % 64) / 2; }
__host__ __device__ __forceinline__ int perm32(int rho) { const int n = rho >> 4, i = rho & 15; return 8 * (i >> 2) + 4 * n + (i & 3); }

struct Unit { int pm, pn; };
struct Gemm { const bf16_t* A; const bf16_t* Bt; int M, N, K; int ld = 0, pn_thr = 1 << 30, koff = 0; };

struct StaticOrder {
    int nM, nN, nwg, G, c;
    __host__ __device__ void init(int M, int N, int G_, int c_) { nM = M / BM; nN = N / BM; nwg = nM * nN; G = G_; c = c_; }
    __host__ __device__ bool next(int i, Unit& u) const {
        const long L = (long)i * G + c; if (L >= nwg) return false;
        int wgid = (int)L; { const int q = nwg / NXCD, r = nwg % NXCD, xcd = wgid % NXCD, off = wgid / NXCD; wgid = (xcd < r ? xcd * (q + 1) : r * (q + 1) + (xcd - r) * q) + off; }
        const int nig = WGM * nN, gid = wgid / nig, fm = gid * WGM, gsz = (nM - fm) < WGM ? (nM - fm) : WGM;
        u.pm = fm + ((wgid % nig) % gsz); u.pn = (wgid % nig) / gsz; return true;
    }
    __device__ __forceinline__ void a_ready(const Unit&) const {}
    __device__ __forceinline__ void done(const Unit&) const {}
};
__device__ __forceinline__ unsigned cvt_pk_bf16(float lo, float hi) { unsigned r; asm volatile("v_cvt_pk_bf16_f32 %0, %1, %2" : "=v"(r) : "v"(lo), "v"(hi)); return r; }
typedef float f32x2 __attribute__((ext_vector_type(2)));
template <class Epi, class Sched, bool STAMP = false>
__device__ __forceinline__ void gemm_phase(PG8_LAS unsigned char* lds, const Gemm g, const Sched& S, const Epi& E, unsigned long long* stamps) {
    const int tid = threadIdx.x, wid = __builtin_amdgcn_readfirstlane(tid >> 6), lane = tid & 63, wr = wid >> 2, wc = wid & 3, fr = lane & 15, fq = lane >> 4;
    const int K = g.ld ? g.ld : g.K, nt = g.K / BK;
    int ts_lo = 0, ts_hi = 0, nts = 0; const unsigned long long rt_entry = STAMP ? (unsigned long long)wall_clock64() : 0ull;
#define PG8_STAMP() do { if (STAMP && wid == 0 && nts < 64) { const unsigned long long _c = (unsigned long long)clock64(); \
        ts_lo = (lane == nts) ? (int)(unsigned)_c : ts_lo; ts_hi = (lane == nts) ? (int)(unsigned)(_c >> 32) : ts_hi; ++nts; } } while (0)
    PG8_STAMP();
    unsigned voffA[2], voffB[2];
#pragma unroll
    for (int i = 0; i < 2; ++i) { int R, C; stage_rc(tid * 16 + i * 8192, R, C); const int Rb = Epi::PERM ? ((R & ~31) + perm32(R & 31)) : R;
        voffA[i] = (unsigned)(R * K + C) * 2u; voffB[i] = (unsigned)(Rb * K + C) * 2u; }
    const size_t kstep = (size_t)(BK * 2);
    const size_t hstep = (size_t)HALF * K * 2;
    const size_t tstep = 2 * hstep;
    const unsigned ldsw = (unsigned)wid * 1024u;
    const int aoff = lds_byte(wr * 64 + fr, fq * 8), boff = lds_byte(wc * 32 + fr, fq * 8);
#define PG8_SA(b, h) (((b) * 2 + (h)) * HTB)
#define PG8_SB(b, h) ((4 + (b) * 2 + (h)) * HTB)
#define PG8_STAGE(bufoff, gbase, voff) do { _Pragma("unroll") for (int _i = 0; _i < 2; ++_i) \
        __builtin_amdgcn_global_load_lds((const unsigned*)((const char*)(gbase) + (voff)[_i]), (PG8_LAS unsigned*)(lds + (bufoff) + ldsw + _i * 8192), 16, 0, 0); } while (0)
#define PG8_LDA(dst, b, h) do { _Pragma("unroll") for (int m = 0; m < 4; ++m) _Pragma("unroll") for (int k = 0; k < 2; ++k) dst[m][k] = *(const PG8_LAS bf16x8*)(lds + PG8_SA(b, h) + aoff + m * 2048 + k * 1024); } while (0)
#define PG8_LDB(dst, b, h) do { _Pragma("unroll") for (int n = 0; n < 2; ++n) _Pragma("unroll") for (int k = 0; k < 2; ++k) dst[n][k] = *(const PG8_LAS bf16x8*)(lds + PG8_SB(b, h) + boff + n * 2048 + k * 1024); } while (0)
#define PG8_MMA(ai, bj, At, Bt) do { __builtin_amdgcn_s_setprio(1); _Pragma("unroll") for (int m = 0; m < 4; ++m) _Pragma("unroll") for (int n = 0; n < 2; ++n) _Pragma("unroll") for (int k = 0; k < 2; ++k) \
        acc[ai][bj][m][n] = __builtin_amdgcn_mfma_f32_16x16x32_bf16(Bt[n][k], At[m][k], acc[ai][bj][m][n], 0, 0, 0); __builtin_amdgcn_s_setprio(0); } while (0)
#define PG8_WAIT_V(n) asm volatile("s_waitcnt vmcnt(" #n ")" ::: "memory")
#define PG8_WAIT_L(n) asm volatile("s_waitcnt lgkmcnt(" #n ")" ::: "memory")
#define PG8_BAR __builtin_amdgcn_s_barrier()
#define PG8_SCHED __builtin_amdgcn_sched_barrier(0)
    Unit cur, nxt; int ui = 0;
    if (!S.next(0, cur)) return;
    f32x4 acc[2][2][4][2];
#pragma unroll
    for (int a = 0; a < 2; ++a)
#pragma unroll
        for (int b = 0; b < 2; ++b)
#pragma unroll
            for (int m = 0; m < 4; ++m)
#pragma unroll
                for (int n = 0; n < 2; ++n) acc[a][b][m][n] = (f32x4){0.f, 0.f, 0.f, 0.f};
    bf16x8 At[4][2], B0[2][2], B1[2][2];
    const char* cA = (const char*)g.A + (size_t)cur.pm * tstep + (cur.pn >= g.pn_thr ? g.koff * 2 : 0); const char* cB = (const char*)g.Bt + (size_t)cur.pn * tstep + (cur.pn >= g.pn_thr ? g.koff * 2 : 0);
    S.a_ready(cur);
    PG8_STAGE(PG8_SB(0, 0), cB, voffB); PG8_STAGE(PG8_SA(0, 0), cA, voffA); PG8_STAGE(PG8_SB(0, 1), cB + hstep, voffB); PG8_STAGE(PG8_SA(0, 1), cA + hstep, voffA);
    if (wr == 1) PG8_BAR;
    PG8_WAIT_V(4); PG8_BAR;
    PG8_STAGE(PG8_SB(1, 0), cB + kstep, voffB); PG8_STAGE(PG8_SA(1, 0), cA + kstep, voffA); PG8_STAGE(PG8_SB(1, 1), cB + hstep + kstep, voffB);
    PG8_WAIT_V(6); PG8_BAR;
    PG8_STAMP();
    for (;;) {
        const bool has_next = S.next(ui + 1, nxt);
        const int nko = (has_next && nxt.pn >= g.pn_thr) ? g.koff * 2 : 0;
        const char* nA = has_next ? (const char*)g.A + (size_t)nxt.pm * tstep + nko : cA; const char* nB = has_next ? (const char*)g.Bt + (size_t)nxt.pn * tstep + nko : cB;
        for (int t = 0; t < nt; t += 2) {
            const bool last = (t == nt - 2);
            const char* a1 = cA + (size_t)(t + 1) * kstep;
            const char* a2 = last ? nA : cA + (size_t)(t + 2) * kstep; const char* b2 = last ? nB : cB + (size_t)(t + 2) * kstep;
            const char* a3 = a2 + kstep; const char* b3 = b2 + kstep;
            if (last && has_next) S.a_ready(nxt);
            PG8_LDB(B0, 0, 0); PG8_SCHED; PG8_LDA(At, 0, 0); PG8_STAGE(PG8_SA(1, 1), a1 + hstep, voffA);
            PG8_WAIT_L(8); PG8_BAR; PG8_WAIT_L(0); PG8_MMA(0, 0, At, B0); PG8_BAR; PG8_SCHED;
            PG8_LDB(B1, 0, 1); PG8_STAGE(PG8_SB(0, 0), b2, voffB);
            PG8_BAR; PG8_WAIT_L(0); PG8_MMA(0, 1, At, B1); PG8_BAR;
            PG8_LDA(At, 0, 1); PG8_STAGE(PG8_SA(0, 0), a2, voffA);
            PG8_BAR; PG8_WAIT_L(0); PG8_MMA(1, 0, At, B0); PG8_BAR; PG8_SCHED;
            PG8_STAGE(PG8_SB(0, 1), b2 + hstep, voffB);
            PG8_WAIT_V(6); PG8_BAR; PG8_MMA(1, 1, At, B1); PG8_BAR;
            PG8_LDB(B0, 1, 0); PG8_SCHED; PG8_LDA(At, 1, 0); PG8_STAGE(PG8_SA(0, 1), a2 + hstep, voffA);
            PG8_WAIT_L(8); PG8_BAR; PG8_WAIT_L(0); PG8_MMA(0, 0, At, B0); PG8_BAR; PG8_SCHED;
            PG8_LDB(B1, 1, 1); PG8_STAGE(PG8_SB(1, 0), b3, voffB);
            PG8_BAR; PG8_WAIT_L(0); PG8_MMA(0, 1, At, B1); PG8_BAR;
            PG8_LDA(At, 1, 1); PG8_STAGE(PG8_SA(1, 0), a3, voffA);
            PG8_BAR; PG8_WAIT_L(0); PG8_MMA(1, 0, At, B0); PG8_BAR; PG8_SCHED;
            PG8_STAGE(PG8_SB(1, 1), b3 + hstep, voffB);
            PG8_WAIT_V(6); PG8_BAR; PG8_MMA(1, 1, At, B1); PG8_BAR;
        }
        PG8_STAMP();
        if constexpr (!Epi::AFTER_DRAIN) { E(acc, cur, wr, wc, fr, fq); S.done(cur); }
        PG8_STAMP();
        if (!has_next) break;
#pragma unroll
        for (int a = 0; a < 2; ++a)
#pragma unroll
            for (int b = 0; b < 2; ++b)
#pragma unroll
                for (int m = 0; m < 4; ++m)
#pragma unroll
                    for (int n = 0; n < 2; ++n) acc[a][b][m][n] = (f32x4){0.f, 0.f, 0.f, 0.f};
        cur = nxt; cA = nA; cB = nB; ++ui;
    }
    PG8_WAIT_V(0);
    if (wr == 0) PG8_BAR;
    PG8_BAR;
    if constexpr (Epi::AFTER_DRAIN) { E.fused(acc, cur, wr, wc, fr, fq, lds, wid, lane); S.done(cur); }
    PG8_STAMP();
    if (STAMP && wid == 0) { stamps[lane] = lane < nts ? (((unsigned long long)(unsigned)ts_hi << 32) | (unsigned)ts_lo) : 0ull;
        if (lane == 62) stamps[62] = rt_entry; if (lane == 63) stamps[63] = (unsigned long long)wall_clock64(); }
#undef PG8_STAMP
#undef PG8_SA
#undef PG8_SB
#undef PG8_STAGE
#undef PG8_LDA
#undef PG8_LDB
#undef PG8_MMA
#undef PG8_WAIT_V
#undef PG8_WAIT_L
#undef PG8_BAR
#undef PG8_SCHED
}
}
using pg8::bf16_t; using pg8::bf16x8; using pg8::f32x4; using pg8::u32x4; using pg8::Unit;
typedef unsigned u32x2 __attribute__((ext_vector_type(2)));
typedef short s16x4 __attribute__((ext_vector_type(4)));
#define LAS __attribute__((address_space(3)))

constexpr int D = 1024, NB = 2, T = 16384, LC = 256, MT = NB * T, MC = NB * LC, MA = MT + MC;
constexpr int RWP = 1856, INP = 3392, INPP = 3584, DFF = 2816;
constexpr int LDS_BYTES = 131072;
constexpr int NCHAIN = 32;

constexpr size_t OFF_MOD = 0;
constexpr size_t OFF_WIN = 131072;
constexpr size_t OFF_WOUT = OFF_WIN + (size_t)INPP * 1024 * 2;
constexpr size_t OFF_WF1 = OFF_WOUT + (size_t)1024 * 1024 * 2;
constexpr size_t OFF_WF2 = OFF_WF1 + (size_t)5632 * 1024 * 2;
constexpr size_t OFF_LORAB = OFF_WF2 + (size_t)1024 * 2816 * 2;
constexpr size_t OFF_MIX = OFF_LORAB + (size_t)2560 * 384 * 2;
constexpr size_t OFF_U = OFF_MIX + (size_t)MT * 1024 * 2;
constexpr size_t OFF_Q = OFF_U + (size_t)MA * 1024 * 2;
constexpr size_t OFF_K = OFF_Q + (size_t)MA * 512 * 2;
constexpr size_t OFF_VT = OFF_K + (size_t)MA * 512 * 2;
constexpr size_t OFF_VTC = OFF_VT + (size_t)NB * 8 * 64 * T * 2;
constexpr size_t OFF_PR = OFF_VTC + (size_t)NB * 8 * 64 * LC * 2;
constexpr size_t OFF_DEC = OFF_PR + (size_t)MA * RWP * 2;
constexpr size_t OFF_AR = OFF_DEC + (size_t)MA * 1024 * 2;
constexpr size_t OFF_BON = OFF_AR + (size_t)MA * 1024 * 2;
constexpr size_t OFF_LA = OFF_U;
constexpr size_t OFF_SST = OFF_U + (size_t)32 * 1024 * 1024;
constexpr size_t OFF_IDENT = OFF_BON + (size_t)NCHAIN * T * 4;
constexpr size_t OFF_BAR = OFF_IDENT + 16384;
constexpr size_t OFF_END = OFF_BAR + 16384;
constexpr size_t OFF_ACT = OFF_Q;
static_assert(OFF_ACT + (size_t)MT * DFF * 2 <= OFF_DEC, "ACT alias overflow");
static_assert(OFF_END <= (size_t)536870912, "workspace");

struct Params {
    const float* in[27];
    float* out; unsigned char* ws;
    int ph_lo, ph_hi;
};

__device__ __forceinline__ float bf2f(bf16_t v) { return __uint_as_float(((unsigned)v) << 16); }
typedef __bf16 hwbf16x2 __attribute__((ext_vector_type(2)));
typedef float cvf32x2 __attribute__((ext_vector_type(2)));
__device__ __forceinline__ unsigned pk2(float lo, float hi) { const hwbf16x2 r = __builtin_convertvector((cvf32x2){lo, hi}, hwbf16x2); return __builtin_bit_cast(unsigned, r); }
__device__ __forceinline__ bf16_t f2bf(float f) { return (bf16_t)(pk2(f, 0.0f) & 0xffffu); }
__device__ __forceinline__ float dpp_f(float v, int ctrl_quad) { return v; }
#define DPPF(v, ctrl) __builtin_bit_cast(float, __builtin_amdgcn_update_dpp(0, __builtin_bit_cast(int, (v)), (ctrl), 0xf, 0xf, true))
__device__ __forceinline__ float wave_sum(float v) {
    v += DPPF(v, 0xB1);
    v += DPPF(v, 0x4E);
    v += DPPF(v, 0x141);
    v += DPPF(v, 0x140);
    const float s0 = __builtin_bit_cast(float, __builtin_amdgcn_readlane(__builtin_bit_cast(int, v), 0)), s1 = __builtin_bit_cast(float, __builtin_amdgcn_readlane(__builtin_bit_cast(int, v), 16));
    const float s2 = __builtin_bit_cast(float, __builtin_amdgcn_readlane(__builtin_bit_cast(int, v), 32)), s3 = __builtin_bit_cast(float, __builtin_amdgcn_readlane(__builtin_bit_cast(int, v), 48));
    return (s0 + s1) + (s2 + s3);
}
__device__ __forceinline__ float silu_f(float x) { return x * __builtin_amdgcn_rcpf(1.0f + __expf(-x)); }
__device__ __forceinline__ float sigmoid_f(float x) { return __builtin_amdgcn_rcpf(1.0f + __expf(-x)); }

struct EpiIn {
    static constexpr bool PERM = false, AFTER_DRAIN = false;
    bf16_t *Q, *K, *VT, *VTC, *PR; const float *qg, *kg;
    __device__ __forceinline__ void operator()(const f32x4 (&acc)[2][2][4][2], const Unit& u, int wr, int wc, int fr, int fq) const {
        const int c0 = u.pn * 256 + wc * 64;
        const int row0 = u.pm * 256 + wr * 64 + fr;
        if (c0 < 1024) {
            const bool isq = c0 < 512; const float* g = isq ? qg : kg; bf16_t* dst = isq ? Q : K; const int cc = c0 & 511; const float sc = isq ? 0.125f : 1.0f;
            f32x4 gv[2][2];
#pragma unroll
            for (int bj = 0; bj < 2; ++bj)
#pragma unroll
                for (int n = 0; n < 2; ++n) gv[bj][n] = *(const f32x4*)(g + 32 * bj + 8 * fq + 4 * n) * sc;
#pragma unroll
            for (int ai = 0; ai < 2; ++ai)
#pragma unroll
                for (int m = 0; m < 4; ++m) {
                    float ss = 0.f;
#pragma unroll
                    for (int bj = 0; bj < 2; ++bj)
#pragma unroll
                        for (int n = 0; n < 2; ++n) { const f32x4 x = acc[ai][bj][m][n]; ss += (x[0] * x[0] + x[1] * x[1]) + (x[2] * x[2] + x[3] * x[3]); }
                    ss += __shfl_xor(ss, 16); ss += __shfl_xor(ss, 32);
                    const float rstd = rsqrtf(ss * (1.0f / 64.0f) + 1e-6f);
                    bf16_t* rowp = dst + (size_t)(row0 + ai * 128 + m * 16) * 512 + cc + 8 * fq;
#pragma unroll
                    for (int bj = 0; bj < 2; ++bj) { const f32x4 y0 = acc[ai][bj][m][0] * rstd * gv[bj][0], y1 = acc[ai][bj][m][1] * rstd * gv[bj][1];
                        u32x4 w; w.x = pk2(y0[0], y0[1]); w.y = pk2(y0[2], y0[3]); w.z = pk2(y1[0], y1[1]); w.w = pk2(y1[2], y1[3]); *(u32x4*)(rowp + 32 * bj) = w; }
                }
        } else if (c0 < 1536) {
            const int h = (c0 - 1024) >> 6;
#pragma unroll
            for (int ai = 0; ai < 2; ++ai)
#pragma unroll
                for (int m = 0; m < 4; ++m) {
                    const int r = row0 + ai * 128 + m * 16;
                    bf16_t* base; size_t stride;
                    if (r < MT) { const int b = r / T, t = r % T; base = VT + ((size_t)(b * 8 + h) * 64) * T + t; stride = T; }
                    else { const int rc = r - MT, b = rc / LC, l = rc % LC; base = VTC + ((size_t)(b * 8 + h) * 64) * LC + l; stride = LC; }
#pragma unroll
                    for (int bj = 0; bj < 2; ++bj)
#pragma unroll
                        for (int n = 0; n < 2; ++n)
#pragma unroll
                            for (int e = 0; e < 4; ++e) base[(size_t)(32 * bj + 8 * fq + 4 * n + e) * stride] = f2bf(acc[ai][bj][m][n][e]);
                }
        } else {
            const int cr = c0 - 1536;
            if (cr >= RWP) return;
#pragma unroll
            for (int ai = 0; ai < 2; ++ai)
#pragma unroll
                for (int m = 0; m < 4; ++m) {
                    bf16_t* rowp = PR + (size_t)(row0 + ai * 128 + m * 16) * RWP + cr + 8 * fq;
#pragma unroll
                    for (int bj = 0; bj < 2; ++bj) { const f32x4 y0 = acc[ai][bj][m][0], y1 = acc[ai][bj][m][1];
                        u32x4 w; w.x = pk2(y0[0], y0[1]); w.y = pk2(y0[2], y0[3]); w.z = pk2(y1[0], y1[1]); w.w = pk2(y1[2], y1[3]); *(u32x4*)(rowp + 32 * bj) = w; }
                }
        }
    }
};
struct EpiRes {
    static constexpr bool PERM = false, AFTER_DRAIN = false;
    const float* base; float* out; const float* gate;
    __device__ __forceinline__ void operator()(const f32x4 (&acc)[2][2][4][2], const Unit& u, int wr, int wc, int fr, int fq) const {
        const int c0 = u.pn * 256 + wc * 64 + 4 * fq;
        const int row0 = u.pm * 256 + wr * 64 + fr;
#pragma unroll
        for (int ai = 0; ai < 2; ++ai)
#pragma unroll
            for (int m = 0; m < 4; ++m) {
                const int r = row0 + ai * 128 + m * 16; const int b = r / T;
#pragma unroll
                for (int bj = 0; bj < 2; ++bj)
#pragma unroll
                    for (int n = 0; n < 2; ++n) { const int c = c0 + 32 * bj + 16 * n;
                        const f32x4 gt = *(const f32x4*)(gate + (size_t)b * 6144 + c);
                        const f32x4 bs = *(const f32x4*)(base + (size_t)r * 1024 + c);
                        *(f32x4*)(out + (size_t)r * 1024 + c) = bs + gt * acc[ai][bj][m][n]; }
            }
    }
};
struct EpiGlu {
    static constexpr bool PERM = false, AFTER_DRAIN = false;
    bf16_t* ACT;
    __device__ __forceinline__ void operator()(const f32x4 (&acc)[2][2][4][2], const Unit& u, int wr, int wc, int fr, int fq) const {
        const int g0 = u.pn * 128 + wc * 32 + 8 * fq;
        const int row0 = u.pm * 256 + wr * 64 + fr;
#pragma unroll
        for (int ai = 0; ai < 2; ++ai)
#pragma unroll
            for (int m = 0; m < 4; ++m) {
                bf16_t* rowp = ACT + (size_t)(row0 + ai * 128 + m * 16) * DFF + g0;
                const f32x4 ga0 = acc[ai][0][m][0], up0 = acc[ai][1][m][0], ga1 = acc[ai][0][m][1], up1 = acc[ai][1][m][1];
                u32x4 w; w.x = pk2(silu_f(ga0[0]) * up0[0], silu_f(ga0[1]) * up0[1]); w.y = pk2(silu_f(ga0[2]) * up0[2], silu_f(ga0[3]) * up0[3]);
                w.z = pk2(silu_f(ga1[0]) * up1[0], silu_f(ga1[1]) * up1[1]); w.w = pk2(silu_f(ga1[2]) * up1[2], silu_f(ga1[3]) * up1[3]);
                *(u32x4*)rowp = w;
            }
    }
};

__device__ __forceinline__ void transpose_item(const float* Wk0, int K, int Nsrc, int src_col0, bf16_t* WT, int dest_row0, int k0, LAS float* scr, int lane, bool perm = false) {
    const int c = lane & 7;
    if (src_col0 < 0) {
#pragma unroll
        for (int j = 0; j < 4; ++j) { const int n = (lane >> 3) + 8 * j; *(u32x4*)(WT + (size_t)(dest_row0 + n) * K + k0 + 8 * c) = (u32x4){0u, 0u, 0u, 0u}; }
        return;
    }
#pragma unroll 8
    for (int i = 0; i < 32; ++i) { const int kk = 2 * i + (lane >> 5); scr[kk * 33 + (lane & 31)] = Wk0[(size_t)kk * Nsrc + src_col0 + (lane & 31)]; }
    asm volatile("s_waitcnt lgkmcnt(0)" ::: "memory");
#pragma unroll
    for (int j = 0; j < 4; ++j) { const int n = (lane >> 3) + 8 * j; const LAS float* s = scr + (8 * c) * 33 + (perm ? pg8::perm32(n) : n);
        u32x4 o; o.x = pk2(s[0 * 33], s[1 * 33]); o.y = pk2(s[2 * 33], s[3 * 33]); o.z = pk2(s[4 * 33], s[5 * 33]); o.w = pk2(s[6 * 33], s[7 * 33]);
        *(u32x4*)(WT + (size_t)(dest_row0 + n) * K + k0 + 8 * c) = o; }
    asm volatile("s_waitcnt lgkmcnt(0)" ::: "memory");
}
constexpr int W_EARLY = 80 * 6 + (INPP / 32) * 16, W_ALL = W_EARLY + 32 * 16 + (5632 / 32) * 16 + 32 * 44;
__device__ __forceinline__ void weight_transposes(const Params& p, LAS unsigned char* lds, int it_lo, int it_hi, int gw, int NGW) {
    const int lane = threadIdx.x & 63, wave = threadIdx.x >> 6;
    LAS float* scr = (LAS float*)(lds + 32768 + wave * 8704);
    constexpr int I_IN = (INPP / 32) * 16, I_OUT = 32 * 16, I_F1 = (5632 / 32) * 16, I_F2 = 32 * 44, I_LO = 80 * 6;
    for (int it = it_lo + gw; it < it_hi; it += NGW) {
        int r = it;
        if (r < I_LO) { const int gd = r / 6, kc = r % 6, t0 = gd * 32, pn = t0 >> 8, bj = (t0 >> 7) & 1, wc = (t0 >> 5) & 3, a0 = pn * 256 + wc * 64 + bj * 32;
            const int grp = a0 >> 9, hc0 = a0 & 511;
            const float* W = nullptr;
            if (grp < 2) { if (kc == grp) W = p.in[15] + (size_t)grp * 64 * 512; }
            else if (grp < 4) { if (kc == 2) W = p.in[17] + (size_t)(grp & 1) * 64 * 512; }
            else { if (kc == 3 || kc == 4) W = p.in[18] + (size_t)(kc - 3) * 64 * 512; }
            transpose_item(W ? W : p.in[15], 384, 512, W ? hc0 : -1, (bf16_t*)(p.ws + OFF_LORAB), t0, kc * 64, scr, lane, true); continue; }
        r -= I_LO;
        if (r < I_IN) { const int gd = r >> 4, kc = r & 15, t0 = gd * 32, pn = t0 >> 8, bj = (t0 >> 7) & 1, wc = (t0 >> 5) & 3, a0 = pn * 256 + wc * 64 + bj * 32;
            transpose_item(p.in[8] + (size_t)kc * 64 * INP, 1024, INP, a0 < INP ? a0 : -1, (bf16_t*)(p.ws + OFF_WIN), t0, kc * 64, scr, lane, true); continue; }
        r -= I_IN;
        if (r < I_OUT) { const int gd = r >> 4, kc = r & 15, t0 = gd * 32, pn = t0 >> 8, bj = (t0 >> 7) & 1, wc = (t0 >> 5) & 3, a0 = pn * 256 + wc * 64 + bj * 32;
            transpose_item(p.in[24] + (size_t)kc * 64 * 1024, 1024, 1024, a0, (bf16_t*)(p.ws + OFF_WOUT), t0, kc * 64, scr, lane); continue; }
        r -= I_OUT;
        if (r < I_F1) { const int gd = r >> 4, kc = r & 15, t0 = gd * 32, pn = t0 >> 8, bj = (t0 >> 7) & 1, wc = (t0 >> 5) & 3, src = pn * 128 + wc * 32 + bj * DFF;
            transpose_item(p.in[25] + (size_t)kc * 64 * 2 * DFF, 1024, 2 * DFF, src, (bf16_t*)(p.ws + OFF_WF1), t0, kc * 64, scr, lane, true); continue; }
        r -= I_F1;
        { const int gd = r / 44, kc = r % 44, t0 = gd * 32, pn = t0 >> 8, bj = (t0 >> 7) & 1, wc = (t0 >> 5) & 3, a0 = pn * 256 + wc * 64 + bj * 32;
            transpose_item(p.in[26] + (size_t)kc * 64 * 1024, DFF, 1024, a0, (bf16_t*)(p.ws + OFF_WF2), t0, kc * 64, scr, lane); }
    }
}


__device__ __forceinline__ void phase0(const Params& p, LAS unsigned char* lds) {
    const int tid = threadIdx.x, lane = tid & 63, wave = tid >> 6;
    const float* c = p.in[1]; const float* cctx = p.in[3]; const float* w_ada = p.in[6]; const float* b_ada = p.in[7];
    float* mod = (float*)(p.ws + OFF_MOD);
    LAS float* red = (LAS float*)lds;
    for (int cb = blockIdx.x; cb < 256; cb += gridDim.x) {
        const int ks = tid / 6, cgp = tid % 6, col = cb * 24 + cgp * 4;
        if (ks < 84) {
            f32x4 a0 = {0.f, 0.f, 0.f, 0.f}, a1 = a0, a2 = a0;
            for (int k = ks; k < 1024; k += 84) {
                const f32x4 w = *(const f32x4*)(w_ada + (size_t)k * 6144 + col);
                a0 += w * silu_f(c[k]); a1 += w * silu_f(c[1024 + k]); a2 += w * silu_f(cctx[k]);
            }
#pragma unroll
            for (int e = 0; e < 4; ++e) { red[ks * 72 + cgp * 4 + e] = a0[e]; red[ks * 72 + 24 + cgp * 4 + e] = a1[e]; red[ks * 72 + 48 + cgp * 4 + e] = a2[e]; }
        }
        __syncthreads();
        if (tid < 72) { float s = 0.f; for (int k = 0; k < 84; ++k) s += red[k * 72 + tid];
            const int r = tid / 24, cc = cb * 24 + tid % 24; mod[r * 6144 + cc] = s + b_ada[cc]; }
        __syncthreads();
    }
    { float* ident = (float*)(p.ws + OFF_IDENT); for (int idx = blockIdx.x * 512 + tid; idx < 4096; idx += gridDim.x * 512) ident[idx] = ((idx >> 6) == (idx & 63)) ? 1.0f : 0.0f; }
    weight_transposes(p, lds, 0, W_EARLY, blockIdx.x * 8 + wave, gridDim.x * 8);
}

__device__ __forceinline__ void phase_norm(const Params& p, int which) {
    const int lane = threadIdx.x & 63, wave = threadIdx.x >> 6;
    const float* mod = (const float*)(p.ws + OFF_MOD);
    const float* g = which ? p.in[5] : p.in[4];
    bf16_t* U = (bf16_t*)(p.ws + OFF_U);
    const int nrows = which ? MT : MA, shoff = which ? 3 * 1024 : 0, scoff = which ? 4 * 1024 : 1024;
    for (int row = blockIdx.x * 8 + wave; row < nrows; row += gridDim.x * 8) {
        const float* src; int mrow;
        if (which) { src = p.out + (size_t)row * 1024; mrow = row / T; }
        else if (row < MT) { src = p.in[0] + (size_t)row * 1024; mrow = row / T; }
        else { src = p.in[2] + (size_t)(row - MT) * 1024; mrow = 2; }
        f32x4 v[4]; float ss = 0.f;
#pragma unroll
        for (int j = 0; j < 4; ++j) { v[j] = ((const f32x4*)src)[lane + 64 * j]; ss += (v[j][0] * v[j][0] + v[j][1] * v[j][1]) + (v[j][2] * v[j][2] + v[j][3] * v[j][3]); }
        const float rstd = rsqrtf(wave_sum(ss) * (1.0f / 1024.0f) + 1e-6f);
#pragma unroll
        for (int j = 0; j < 4; ++j) { const int col = 4 * (lane + 64 * j);
            const f32x4 gg = *(const f32x4*)(g + col), sc = *(const f32x4*)(mod + mrow * 6144 + scoff + col), sh = *(const f32x4*)(mod + mrow * 6144 + shoff + col);
            const f32x4 y = v[j] * rstd * gg * (sc + 1.0f) + sh;
            u32x2 w; w.x = pk2(y[0], y[1]); w.y = pk2(y[2], y[3]); *(u32x2*)(U + (size_t)row * 1024 + col) = w; }
    }
}

__device__ __forceinline__ void phase_shiftprep(const Params& p) {
    const int lane = threadIdx.x & 63, wave = threadIdx.x >> 6;
    const bf16_t* PR = (const bf16_t*)(p.ws + OFF_PR); bf16_t* LA = (bf16_t*)(p.ws + OFF_LA);
    float mp[5], mn[5];
#pragma unroll
    for (int j = 0; j < 5; ++j) { mp[j] = p.in[12][1536 + lane + 64 * j]; mn[j] = p.in[13][1536 + lane + 64 * j]; }
    constexpr int NRW = 4;
    const int stride = gridDim.x * 8;
    for (int row0 = blockIdx.x * 8 + wave; row0 < MA; row0 += NRW * stride) {
        unsigned short pc[NRW][5], pp[NRW][5], pn[NRW][5]; float mpf[NRW], mnf[NRW]; bool ok[NRW];
#pragma unroll
        for (int u = 0; u < NRW; ++u) { const int rw = row0 + u * stride; ok[u] = rw < MA; const int row = ok[u] ? rw : row0;
            bool hp_, hn_;
            if (row < MT) { const int t = row % T; hp_ = t > 0; hn_ = t < T - 1; } else { const int l = (row - MT) % LC; hp_ = l > 0; hn_ = l < LC - 1; }
            const bf16_t* pr = PR + (size_t)row * RWP + 1536; const bf16_t* prp = hp_ ? pr - RWP : pr; const bf16_t* prn = hn_ ? pr + RWP : pr;
            mpf[u] = hp_ ? 1.0f : 0.0f; mnf[u] = hn_ ? 1.0f : 0.0f;
#pragma unroll
            for (int j = 0; j < 5; ++j) { const int col = lane + 64 * j; pc[u][j] = pr[col]; pp[u][j] = prp[col]; pn[u][j] = prn[col]; } }
#pragma unroll
        for (int u = 0; u < NRW; ++u) { if (!ok[u]) continue; const int row = row0 + u * stride;
#pragma unroll
            for (int j = 0; j < 5; ++j) { const int col = lane + 64 * j;
                const float c_ = bf2f(pc[u][j]), p_ = mpf[u] * bf2f(pp[u][j]), n_ = mnf[u] * bf2f(pn[u][j]);
                float v = c_ + mp[j] * (p_ - c_) + mn[j] * (n_ - c_);
                if (j < 2) v = 1.0f - 2.0f / (1.0f + __expf(2.0f * v));
                else if (j >= 3) v = sigmoid_f(v);
                LA[(size_t)row * 384 + col] = f2bf(v); }
            LA[(size_t)row * 384 + 320 + lane] = 0; }
    }
}
struct EpiLora {
    static constexpr bool PERM = false, AFTER_DRAIN = false;
    bf16_t *DEC, *AR, *MIXG; const float *w0, *a0;
    __device__ __forceinline__ void operator()(const f32x4 (&acc)[2][2][4][2], const Unit& u, int wr, int wc, int fr, int fq) const {
        const int ac = u.pn * 256 + wc * 64, grp = ac >> 9, hc0 = (ac & 511) + 8 * fq, d = grp & 1;
        const int row0 = u.pm * 256 + wr * 64 + fr;
        if (grp == 4) {
#pragma unroll
            for (int ai = 0; ai < 2; ++ai)
#pragma unroll
                for (int m = 0; m < 4; ++m) { const int r = row0 + ai * 128 + m * 16; if (r >= MT) continue;
                    bf16_t* rowp = MIXG + (size_t)r * 1024 + 512 + hc0;
#pragma unroll
                    for (int bj = 0; bj < 2; ++bj) { const f32x4 y0 = acc[ai][bj][m][0], y1 = acc[ai][bj][m][1]; u32x4 w; w.x = pk2(y0[0], y0[1]); w.y = pk2(y0[2], y0[3]); w.z = pk2(y1[0], y1[1]); w.w = pk2(y1[2], y1[3]); *(u32x4*)(rowp + 32 * bj) = w; } }
            return;
        }
        const bool isw = grp < 2;
        const float* bias = (isw ? w0 : a0) + d * 512 + hc0;
        bf16_t* dst = (isw ? DEC : AR) + d * 512 + hc0;
        f32x4 bv[2][2];
#pragma unroll
        for (int bj = 0; bj < 2; ++bj)
#pragma unroll
            for (int n = 0; n < 2; ++n) bv[bj][n] = *(const f32x4*)(bias + 32 * bj + 4 * n);
#pragma unroll
        for (int ai = 0; ai < 2; ++ai)
#pragma unroll
            for (int m = 0; m < 4; ++m) {
                bf16_t* rowp = dst + (size_t)(row0 + ai * 128 + m * 16) * 1024;
#pragma unroll
                for (int bj = 0; bj < 2; ++bj) { u32x4 w;
#pragma unroll
                    for (int n = 0; n < 2; ++n) { const f32x4 x = acc[ai][bj][m][n] + bv[bj][n]; f32x4 y;
#pragma unroll
                        for (int e = 0; e < 4; ++e) {
                            if (isw) y[e] = -0.60653066f * sigmoid_f(x[e]);
                            else y[e] = sigmoid_f(x[e]); }
                        if (n == 0) { w.x = pk2(y[0], y[1]); w.y = pk2(y[2], y[3]); } else { w.z = pk2(y[0], y[1]); w.w = pk2(y[2], y[3]); } }
                    *(u32x4*)(rowp + 32 * bj) = w;
                    asm volatile("" ::: "memory"); }
            }
    }
};
#define XB_TMO      128
#define XB_XCNT(j)  (256  + 64 * (j))
#define XB_XSUB(j)  (1280 + 64 * (j))
#define XB_XGEN(j)  (2304 + 64 * (j))
#define XB_TOP      3328
#define XB_TOPGEN   3392
#define XCD_BAR_WORDS 3456
#define XB_SPIN_CAP (1u << 18)

__device__ __forceinline__ unsigned xb_ld(unsigned* p)              { return __hip_atomic_load(p, __ATOMIC_RELAXED, __HIP_MEMORY_SCOPE_AGENT); }
__device__ __forceinline__ unsigned xb_add(unsigned* p, unsigned v) { return __hip_atomic_fetch_add(p, v, __ATOMIC_RELAXED, __HIP_MEMORY_SCOPE_AGENT); }
__device__ __forceinline__ unsigned xb_xcc_id() { return (unsigned)__builtin_amdgcn_s_getreg((3 << 11) | 20) & 0xFu; }
#define XB_SPIN(cond, bar) do { unsigned _sp = 0; while (cond) { __builtin_amdgcn_s_sleep(1); \
    if ((++_sp & 255u) == 0u) { if (xb_ld(&(bar)[XB_TMO])) break; if (_sp > XB_SPIN_CAP) { atomicAdd(&(bar)[XB_TMO], 1u); break; } } } } while (0)

struct XcdBarrier {
    unsigned* bar; unsigned x;
    volatile LAS unsigned* st;
};

__device__ __forceinline__ XcdBarrier xcd_barrier_post(unsigned* bar, volatile LAS unsigned* st) {
    XcdBarrier b; b.bar = bar; b.x = xb_xcc_id(); b.st = st;
    if (threadIdx.x == 0) (void)xb_add(&bar[XB_XCNT(b.x)], 1u);
    return b;
}
__device__ __forceinline__ void xcd_barrier_complete(unsigned* bar, unsigned x, unsigned& nloc, unsigned& nx) {
    const unsigned G = gridDim.x * gridDim.y * gridDim.z;
    unsigned sum, cnt, mine, sp = 0u;
    for (;;) {
        sum = 0u; cnt = 0u; mine = 0u;
#pragma unroll
        for (unsigned j = 0; j < 16; ++j) { const unsigned c = xb_ld(&bar[XB_XCNT(j)]); sum += c; cnt += (c > 0u) ? 1u : 0u; mine = (j == x) ? c : mine; }
        if (sum == G) break;
        __builtin_amdgcn_s_sleep(1);
        if ((++sp & 255u) == 0u) { if (xb_ld(&bar[XB_TMO])) break; if (sp > XB_SPIN_CAP) { atomicAdd(&bar[XB_TMO], 1u); break; } }
    }
    nloc = mine > 0u ? mine : 1u; nx = cnt > 0u ? cnt : 1u;
}

__device__ __forceinline__ void xcd_barrier(const XcdBarrier& b) {
    asm volatile("s_waitcnt vmcnt(0)" ::: "memory");
    __syncthreads();
    if (threadIdx.x == 0) {
        unsigned* bar = b.bar;
        __builtin_amdgcn_s_waitcnt(0);
        unsigned nloc = b.st[0], nx = b.st[1];
        if (nloc == 0u) { xcd_barrier_complete(bar, b.x, nloc, nx); b.st[0] = nloc; b.st[1] = nx; }
        const unsigned old = xb_add(&bar[XB_XSUB(b.x)], 1u);
        const unsigned gen = old / nloc;
        if (old + 1u == (gen + 1u) * nloc) {
            __builtin_amdgcn_fence(__ATOMIC_RELEASE, "agent");
            asm volatile("s_waitcnt vmcnt(0)" ::: "memory");
            const unsigned og = xb_add(&bar[XB_TOP], 1u);
            const unsigned tg = og / nx;
            if (og + 1u == (tg + 1u) * nx) xb_add(&bar[XB_TOPGEN], 1u);
            else XB_SPIN(xb_ld(&bar[XB_TOPGEN]) == tg, bar);
            __builtin_amdgcn_fence(__ATOMIC_ACQUIRE, "agent");
            xb_add(&bar[XB_XGEN(b.x)], 1u);
            asm volatile("s_waitcnt vmcnt(0)" ::: "memory");
        } else {
            XB_SPIN(xb_ld(&bar[XB_XGEN(b.x)]) == gen, bar);
            __builtin_amdgcn_fence(__ATOMIC_ACQUIRE, "agent");
            asm volatile("s_waitcnt vmcnt(0)" ::: "memory");
        }
    }
    __syncthreads();
}
constexpr int NA_KLD = 72, NA_VLD = 264;
__device__ __forceinline__ void na_task(const Params& p, int b, int h, int i, int j, int lane, const LAS bf16_t* Kc, const LAS bf16_t* VTc, const LAS float* rpb) {
    const int fr = lane & 15, fq = lane >> 4;
    const bf16_t* Q = (const bf16_t*)(p.ws + OFF_Q); const bf16_t* K = (const bf16_t*)(p.ws + OFF_K);
    const bf16_t* VT = (const bf16_t*)(p.ws + OFF_VT);
    bf16_t* MIX = (bf16_t*)(p.ws + OFF_MIX);
    const size_t qrow = (size_t)b * T + i * 64 + 16 * j + fr;
    const bf16_t* qp = Q + qrow * 512 + h * 64 + 8 * fq;
    const bf16x8 q0 = *(const bf16x8*)qp, q1 = *(const bf16x8*)(qp + 32);
    const int rs = min(max(i - 4, 0), 248);
    const int cb = (j == 0) ? 0 : (j == 1) ? 8 : (j == 2) ? 24 : 32;
    const int c = 16 * j + fr, cs = min(max(c - 8, 0), 48);
    float m_run = -INFINITY, l_run = 0.f;
    f32x4 o[4];
#pragma unroll
    for (int dt = 0; dt < 4; ++dt) o[dt] = (f32x4){0.f, 0.f, 0.f, 0.f};
    const bf16_t* vt_base = VT + ((size_t)(b * 8 + h) * 64 + fr) * T;
#pragma unroll
    for (int half = 0; half < 2; ++half) {
    const bool win = half == 0;
#pragma unroll 1
    for (int grp = 2 * half; grp < 2 * half + 2; ++grp) {
        f32x4 s[8];
#pragma unroll
        for (int kt = 0; kt < 8; ++kt) {
            int rr = 0, nt = 0; bf16x8 k0, k1;
            if (win) { rr = grp * 4 + (kt >> 1); nt = kt & 1; const size_t krow = (size_t)b * T + (rs + rr) * 64 + cb + 16 * nt + fr;
                const bf16_t* kp = K + krow * 512 + h * 64 + 8 * fq; k0 = *(const bf16x8*)kp; k1 = *(const bf16x8*)(kp + 32); }
            else { const LAS bf16_t* kp = Kc + ((grp - 2) * 128 + kt * 16 + fr) * NA_KLD + 8 * fq; k0 = *(const LAS bf16x8*)kp; k1 = *(const LAS bf16x8*)(kp + 32); }
            f32x4 a = {0.f, 0.f, 0.f, 0.f};
            a = __builtin_amdgcn_mfma_f32_16x16x32_bf16(k0, q0, a, 0, 0, 0);
            a = __builtin_amdgcn_mfma_f32_16x16x32_bf16(k1, q1, a, 0, 0, 0);
            if (win) {
                const int di = rs + rr - i + 7;
#pragma unroll
                for (int e = 0; e < 4; ++e) { const int kc = cb + 16 * nt + 4 * fq + e; const bool valid = (kc >= cs) && (kc < cs + 16);
                    const int dj = min(max(kc - c + 15, 0), 30);
                    const float bias = rpb[di * 31 + dj];
                    a[e] = valid ? a[e] + bias : -INFINITY; }
            }
            s[kt] = a;
        }
        float gmax = -INFINITY;
#pragma unroll
        for (int kt = 0; kt < 8; ++kt)
#pragma unroll
            for (int e = 0; e < 4; ++e) gmax = fmaxf(gmax, s[kt][e]);
        gmax = fmaxf(gmax, __shfl_xor(gmax, 16)); gmax = fmaxf(gmax, __shfl_xor(gmax, 32));
        const float m_new = fmaxf(m_run, gmax);
        const float alpha = __expf(m_run - m_new);
        float psum = 0.f;
#pragma unroll
        for (int kt = 0; kt < 8; ++kt)
#pragma unroll
            for (int e = 0; e < 4; ++e) { const float pv = __expf(s[kt][e] - m_new); psum += pv; s[kt][e] = pv; }
        psum += __shfl_xor(psum, 16); psum += __shfl_xor(psum, 32);
        l_run = l_run * alpha + psum; m_run = m_new;
#pragma unroll
        for (int dt = 0; dt < 4; ++dt) o[dt] *= alpha;
#pragma unroll
        for (int k2 = 0; k2 < 4; ++k2) {
            u32x4 pw; pw.x = pk2(s[2 * k2][0], s[2 * k2][1]); pw.y = pk2(s[2 * k2][2], s[2 * k2][3]); pw.z = pk2(s[2 * k2 + 1][0], s[2 * k2 + 1][1]); pw.w = pk2(s[2 * k2 + 1][2], s[2 * k2 + 1][3]);
            const bf16x8 pb = __builtin_bit_cast(bf16x8, pw);
            if (win) {
                const bf16_t* vp = vt_base + (size_t)(rs + grp * 4 + k2) * 64 + cb + 4 * fq; const size_t dstride = (size_t)16 * T;
#pragma unroll
                for (int dt = 0; dt < 4; ++dt) {
                    const u32x2 lo = *(const u32x2*)(vp + dt * dstride), hi = *(const u32x2*)(vp + dt * dstride + 16);
                    u32x4 vw; vw.x = lo.x; vw.y = lo.y; vw.z = hi.x; vw.w = hi.y;
                    o[dt] = __builtin_amdgcn_mfma_f32_16x16x32_bf16(__builtin_bit_cast(bf16x8, vw), pb, o[dt], 0, 0, 0);
                }
            } else {
                const LAS bf16_t* vp = VTc + fr * NA_VLD + (grp - 2) * 128 + k2 * 32 + 4 * fq;
#pragma unroll
                for (int dt = 0; dt < 4; ++dt) {
                    const u32x2 lo = *(const LAS u32x2*)(vp + dt * 16 * NA_VLD), hi = *(const LAS u32x2*)(vp + dt * 16 * NA_VLD + 16);
                    u32x4 vw; vw.x = lo.x; vw.y = lo.y; vw.z = hi.x; vw.w = hi.y;
                    o[dt] = __builtin_amdgcn_mfma_f32_16x16x32_bf16(__builtin_bit_cast(bf16x8, vw), pb, o[dt], 0, 0, 0);
                }
            }
        }
    }
    }
    const float inv = 1.0f / l_run;
    bf16_t* op = MIX + qrow * 1024 + h * 64 + 4 * fq;
#pragma unroll
    for (int dt = 0; dt < 4; ++dt) { const f32x4 y = o[dt] * inv; u32x2 w; w.x = pk2(y[0], y[1]); w.y = pk2(y[2], y[3]); *(u32x2*)(op + 16 * dt) = w; }
}
template <int NTL>
__device__ __forceinline__ void na_softmax_n(f32x4 (&s)[NTL], float& m_run, float& l_run, f32x4 (&o)[4]) {
    float gmax = -INFINITY;
#pragma unroll
    for (int kt = 0; kt < NTL; ++kt)
#pragma unroll
        for (int e = 0; e < 4; ++e) gmax = fmaxf(gmax, s[kt][e]);
    gmax = fmaxf(gmax, __shfl_xor(gmax, 16)); gmax = fmaxf(gmax, __shfl_xor(gmax, 32));
    const float m_new = fmaxf(m_run, gmax);
    const float alpha = __expf(m_run - m_new);
    float psum = 0.f;
#pragma unroll
    for (int kt = 0; kt < NTL; ++kt)
#pragma unroll
        for (int e = 0; e < 4; ++e) { const float pv = __expf(s[kt][e] - m_new); psum += pv; s[kt][e] = pv; }
    psum += __shfl_xor(psum, 16); psum += __shfl_xor(psum, 32);
    l_run = l_run * alpha + psum; m_run = m_new;
#pragma unroll
    for (int dt = 0; dt < 4; ++dt) o[dt] *= alpha;
}
__device__ __forceinline__ bf16x8 na_pack2(const f32x4& x, const f32x4& y) {
    u32x4 pw; pw.x = pk2(x[0], x[1]); pw.y = pk2(x[2], x[3]); pw.z = pk2(y[0], y[1]); pw.w = pk2(y[2], y[3]); return __builtin_bit_cast(bf16x8, pw);
}
__device__ __forceinline__ void na_task2(const Params& p, int b, int h, int ip, int j, int lane, const LAS bf16_t* Kc, const LAS bf16_t* VTc, const LAS float* rpb) {
    const int fr = lane & 15, fq = lane >> 4;
    const bf16_t* Q = (const bf16_t*)(p.ws + OFF_Q); const bf16_t* K = (const bf16_t*)(p.ws + OFF_K);
    const bf16_t* VT = (const bf16_t*)(p.ws + OFF_VT);
    bf16_t* MIX = (bf16_t*)(p.ws + OFF_MIX);
    const int i0 = 2 * ip;
    const int rs0 = min(max(i0 - 4, 0), 248), rs1 = min(max(i0 - 3, 0), 248);
    const int cb = (j == 0) ? 0 : (j == 1) ? 8 : (j == 2) ? 24 : 32;
    const int c = 16 * j + fr, cs = min(max(c - 8, 0), 48);
    const size_t qrow0 = (size_t)b * T + i0 * 64 + 16 * j + fr;
    bf16x8 q[2][2];
#pragma unroll
    for (int a = 0; a < 2; ++a) { const bf16_t* qp = Q + (qrow0 + a * 64) * 512 + h * 64 + 8 * fq; q[a][0] = *(const bf16x8*)qp; q[a][1] = *(const bf16x8*)(qp + 32); }
    float m_run[2] = {-INFINITY, -INFINITY}, l_run[2] = {0.f, 0.f};
    f32x4 o[2][4];
#pragma unroll
    for (int a = 0; a < 2; ++a)
#pragma unroll
        for (int dt = 0; dt < 4; ++dt) o[a][dt] = (f32x4){0.f, 0.f, 0.f, 0.f};
    const bf16_t* vt_base = VT + ((size_t)(b * 8 + h) * 64 + fr) * T;
#pragma unroll 1
    for (int g = 0; g < 2; ++g) {
        f32x4 s[2][8];
#pragma unroll
        for (int kt = 0; kt < 8; ++kt) { const LAS bf16_t* kp = Kc + (g * 128 + kt * 16 + fr) * NA_KLD + 8 * fq;
            const bf16x8 k0 = *(const LAS bf16x8*)kp, k1 = *(const LAS bf16x8*)(kp + 32);
#pragma unroll
            for (int a = 0; a < 2; ++a) { f32x4 acc = {0.f, 0.f, 0.f, 0.f};
                acc = __builtin_amdgcn_mfma_f32_16x16x32_bf16(k0, q[a][0], acc, 0, 0, 0);
                s[a][kt] = __builtin_amdgcn_mfma_f32_16x16x32_bf16(k1, q[a][1], acc, 0, 0, 0); } }
#pragma unroll
        for (int a = 0; a < 2; ++a) na_softmax_n<8>(s[a], m_run[a], l_run[a], o[a]);
#pragma unroll
        for (int k2 = 0; k2 < 4; ++k2) { const bf16x8 pb0 = na_pack2(s[0][2 * k2], s[0][2 * k2 + 1]), pb1 = na_pack2(s[1][2 * k2], s[1][2 * k2 + 1]);
            const LAS bf16_t* vp = VTc + fr * NA_VLD + g * 128 + k2 * 32 + 4 * fq;
#pragma unroll
            for (int dt = 0; dt < 4; ++dt) { const u32x2 lo = *(const LAS u32x2*)(vp + dt * 16 * NA_VLD), hi = *(const LAS u32x2*)(vp + dt * 16 * NA_VLD + 16);
                u32x4 vw; vw.x = lo.x; vw.y = lo.y; vw.z = hi.x; vw.w = hi.y; const bf16x8 vf = __builtin_bit_cast(bf16x8, vw);
                o[0][dt] = __builtin_amdgcn_mfma_f32_16x16x32_bf16(vf, pb0, o[0][dt], 0, 0, 0);
                o[1][dt] = __builtin_amdgcn_mfma_f32_16x16x32_bf16(vf, pb1, o[1][dt], 0, 0, 0); } }
    }
#pragma unroll 1
    for (int wg = 0; wg < 3; ++wg) {
        f32x4 s[2][6];
#pragma unroll
        for (int kt = 0; kt < 6; ++kt) { const int rr = 3 * wg + (kt >> 1), nt = kt & 1, kru = rs0 + rr, kr = min(kru, 255);
            const bf16_t* kp = K + ((size_t)b * T + kr * 64 + cb + 16 * nt + fr) * 512 + h * 64 + 8 * fq;
            const bf16x8 k0 = *(const bf16x8*)kp, k1 = *(const bf16x8*)(kp + 32);
#pragma unroll
            for (int a = 0; a < 2; ++a) { const int rsa = a ? rs1 : rs0;
                f32x4 acc = {0.f, 0.f, 0.f, 0.f};
                acc = __builtin_amdgcn_mfma_f32_16x16x32_bf16(k0, q[a][0], acc, 0, 0, 0);
                acc = __builtin_amdgcn_mfma_f32_16x16x32_bf16(k1, q[a][1], acc, 0, 0, 0);
                const bool rv = (kru >= rsa) && (kru < rsa + 8);
                const int di = min(max(kru - (i0 + a) + 7, 0), 14);
#pragma unroll
                for (int e = 0; e < 4; ++e) { const int kc = cb + 16 * nt + 4 * fq + e; const bool valid = rv && (kc >= cs) && (kc < cs + 16);
                    const int dj = min(max(kc - c + 15, 0), 30);
                    const float bias = rpb[di * 31 + dj];
                    acc[e] = (acc[e] + bias) + (valid ? 0.0f : -INFINITY); }
                s[a][kt] = acc; } }
#pragma unroll
        for (int a = 0; a < 2; ++a) na_softmax_n<6>(s[a], m_run[a], l_run[a], o[a]);
#pragma unroll
        for (int k2 = 0; k2 < 3; ++k2) { const bf16x8 pb0 = na_pack2(s[0][2 * k2], s[0][2 * k2 + 1]), pb1 = na_pack2(s[1][2 * k2], s[1][2 * k2 + 1]);
            const int kr = min(rs0 + 3 * wg + k2, 255);
            const bf16_t* vp = vt_base + (size_t)kr * 64 + cb + 4 * fq;
#pragma unroll
            for (int dt = 0; dt < 4; ++dt) { const u32x2 lo = *(const u32x2*)(vp + (size_t)dt * 16 * T), hi = *(const u32x2*)(vp + (size_t)dt * 16 * T + 16);
                u32x4 vw; vw.x = lo.x; vw.y = lo.y; vw.z = hi.x; vw.w = hi.y; const bf16x8 vf = __builtin_bit_cast(bf16x8, vw);
                o[0][dt] = __builtin_amdgcn_mfma_f32_16x16x32_bf16(vf, pb0, o[0][dt], 0, 0, 0);
                o[1][dt] = __builtin_amdgcn_mfma_f32_16x16x32_bf16(vf, pb1, o[1][dt], 0, 0, 0); } }
    }
#pragma unroll
    for (int a = 0; a < 2; ++a) { const float inv = 1.0f / l_run[a];
        bf16_t* op = MIX + (qrow0 + a * 64) * 1024 + h * 64 + 4 * fq;
#pragma unroll
        for (int dt = 0; dt < 4; ++dt) { const f32x4 y = o[a][dt] * inv; u32x2 w; w.x = pk2(y[0], y[1]); w.y = pk2(y[2], y[3]); *(u32x2*)(op + 16 * dt) = w; } }
}
template <int NTL>
__device__ __forceinline__ void na_expsum(f32x4 (&s)[NTL], float& l_part) {
#pragma unroll
    for (int kt = 0; kt < NTL; ++kt)
#pragma unroll
        for (int e = 0; e < 4; ++e) { const float pv = __builtin_amdgcn_exp2f(s[kt][e] * 1.44269504f - 14.4269504f); l_part += pv; s[kt][e] = pv; }
}
template <int NR>
__device__ __forceinline__ void na_taskN(const Params& p, int b, int h, int ig, int j, int lane, const LAS bf16_t* Kc, const LAS bf16_t* VTc, const LAS float* rpb) {
    constexpr int NWG = NR + 7;
    const int fr = lane & 15, fq = lane >> 4;
    const bf16_t* Q = (const bf16_t*)(p.ws + OFF_Q); const bf16_t* K = (const bf16_t*)(p.ws + OFF_K);
    const bf16_t* VT = (const bf16_t*)(p.ws + OFF_VT);
    bf16_t* MIX = (bf16_t*)(p.ws + OFF_MIX);
    const int i0 = NR * ig;
    const int rs0 = min(max(i0 - 4, 0), 248);
    const int cb = (j == 0) ? 0 : (j == 1) ? 8 : (j == 2) ? 24 : 32;
    const int c = 16 * j + fr, cs = min(max(c - 8, 0), 48);
    const size_t qrow0 = (size_t)b * T + i0 * 64 + 16 * j + fr;
    bf16x8 q[NR][2];
#pragma unroll
    for (int a = 0; a < NR; ++a) { const bf16_t* qp = Q + (qrow0 + a * 64) * 512 + h * 64 + 8 * fq; q[a][0] = *(const bf16x8*)qp; q[a][1] = *(const bf16x8*)(qp + 32); }
    float l_run[NR];
    f32x4 o[NR][4];
#pragma unroll
    for (int a = 0; a < NR; ++a) { l_run[a] = 0.f;
#pragma unroll
        for (int dt = 0; dt < 4; ++dt) o[a][dt] = (f32x4){0.f, 0.f, 0.f, 0.f}; }
    const bf16_t* vt_base = VT + ((size_t)(b * 8 + h) * 64 + fr) * T;
#pragma unroll 1
    for (int g = 0; g < 4; ++g) {
        f32x4 s[NR][4];
#pragma unroll
        for (int kt = 0; kt < 4; ++kt) { const LAS bf16_t* kp = Kc + (g * 64 + kt * 16 + fr) * NA_KLD + 8 * fq;
            const bf16x8 k0 = *(const LAS bf16x8*)kp, k1 = *(const LAS bf16x8*)(kp + 32);
#pragma unroll
            for (int a = 0; a < NR; ++a) { f32x4 acc = {0.f, 0.f, 0.f, 0.f};
                acc = __builtin_amdgcn_mfma_f32_16x16x32_bf16(k0, q[a][0], acc, 0, 0, 0);
                s[a][kt] = __builtin_amdgcn_mfma_f32_16x16x32_bf16(k1, q[a][1], acc, 0, 0, 0); } }
#pragma unroll
        for (int a = 0; a < NR; ++a) na_expsum<4>(s[a], l_run[a]);
#pragma unroll
        for (int k2 = 0; k2 < 2; ++k2) { bf16x8 pb[NR];
#pragma unroll
            for (int a = 0; a < NR; ++a) pb[a] = na_pack2(s[a][2 * k2], s[a][2 * k2 + 1]);
            const LAS bf16_t* vp = VTc + fr * NA_VLD + g * 64 + k2 * 32 + 4 * fq;
#pragma unroll
            for (int dt = 0; dt < 4; ++dt) { const u32x2 lo = *(const LAS u32x2*)(vp + dt * 16 * NA_VLD), hi = *(const LAS u32x2*)(vp + dt * 16 * NA_VLD + 16);
                u32x4 vw; vw.x = lo.x; vw.y = lo.y; vw.z = hi.x; vw.w = hi.y; const bf16x8 vf = __builtin_bit_cast(bf16x8, vw);
#pragma unroll
                for (int a = 0; a < NR; ++a) o[a][dt] = __builtin_amdgcn_mfma_f32_16x16x32_bf16(vf, pb[a], o[a][dt], 0, 0, 0); } }
    }
#pragma unroll 1
    for (int wg = 0; wg < NWG; ++wg) {
        f32x4 s[NR][2];
        const int kru = rs0 + wg, kr = min(kru, 255);
        bf16x8 kf[2][2];
#pragma unroll
        for (int nt = 0; nt < 2; ++nt) { const bf16_t* kp = K + ((size_t)b * T + kr * 64 + cb + 16 * nt + fr) * 512 + h * 64 + 8 * fq;
            kf[nt][0] = *(const bf16x8*)kp; kf[nt][1] = *(const bf16x8*)(kp + 32); }
        bool rv[NR];
#pragma unroll
        for (int a = 0; a < NR; ++a) { const int rsa = min(max(i0 + a - 4, 0), 248); rv[a] = (kru >= rsa) && (kru < rsa + 8);
            if (rv[a]) {
                const int di = min(max(kru - (i0 + a) + 7, 0), 14);
#pragma unroll
                for (int nt = 0; nt < 2; ++nt) { f32x4 acc = {0.f, 0.f, 0.f, 0.f};
                    acc = __builtin_amdgcn_mfma_f32_16x16x32_bf16(kf[nt][0], q[a][0], acc, 0, 0, 0);
                    acc = __builtin_amdgcn_mfma_f32_16x16x32_bf16(kf[nt][1], q[a][1], acc, 0, 0, 0);
#pragma unroll
                    for (int e = 0; e < 4; ++e) { const int kc = cb + 16 * nt + 4 * fq + e; const bool valid = (kc >= cs) && (kc < cs + 16);
                        const int dj = min(max(kc - c + 15, 0), 30);
                        const float bias = rpb[di * 31 + dj];
                        acc[e] = (acc[e] + bias) + (valid ? 0.0f : -INFINITY); }
                    s[a][nt] = acc; }
                na_expsum<2>(s[a], l_run[a]);
            } else { s[a][0] = (f32x4){0.f, 0.f, 0.f, 0.f}; s[a][1] = (f32x4){0.f, 0.f, 0.f, 0.f}; } }
        bf16x8 pb[NR];
#pragma unroll
        for (int a = 0; a < NR; ++a) pb[a] = na_pack2(s[a][0], s[a][1]);
        const bf16_t* vp = vt_base + (size_t)kr * 64 + cb + 4 * fq;
#pragma unroll
        for (int dt = 0; dt < 4; ++dt) { const u32x2 lo = *(const u32x2*)(vp + (size_t)dt * 16 * T), hi = *(const u32x2*)(vp + (size_t)dt * 16 * T + 16);
            u32x4 vw; vw.x = lo.x; vw.y = lo.y; vw.z = hi.x; vw.w = hi.y; const bf16x8 vf = __builtin_bit_cast(bf16x8, vw);
#pragma unroll
            for (int a = 0; a < NR; ++a) if (rv[a]) o[a][dt] = __builtin_amdgcn_mfma_f32_16x16x32_bf16(vf, pb[a], o[a][dt], 0, 0, 0); }
    }
#pragma unroll
    for (int a = 0; a < NR; ++a) { float lt = l_run[a]; lt += __shfl_xor(lt, 16); lt += __shfl_xor(lt, 32); const float inv = 1.0f / lt;
        bf16_t* op = MIX + (qrow0 + a * 64) * 1024 + h * 64 + 4 * fq;
#pragma unroll
        for (int dt = 0; dt < 4; ++dt) { const f32x4 y = o[a][dt] * inv; u32x2 w; w.x = pk2(y[0], y[1]); w.y = pk2(y[2], y[3]); *(u32x2*)(op + 16 * dt) = w; } }
}
__device__ __forceinline__ void phase_na(const Params& p, LAS unsigned char* lds, int blk, int nblk) {
    const int tid = threadIdx.x, lane = tid & 63, wave = tid >> 6;
    const int bh = blk & 15, sub = blk >> 4, nsub = (nblk - bh + 15) >> 4, b = bh >> 3, h = bh & 7;
    LAS bf16_t* Kc = (LAS bf16_t*)lds; LAS bf16_t* VTc = Kc + 256 * NA_KLD;
    const bf16_t* K = (const bf16_t*)(p.ws + OFF_K); const bf16_t* VTC = (const bf16_t*)(p.ws + OFF_VTC);
    for (int idx = tid; idx < 256 * 8; idx += 512) { const int l = idx >> 3, c8 = idx & 7;
        *(LAS u32x4*)(Kc + l * NA_KLD + 8 * c8) = *(const u32x4*)(K + ((size_t)MT + b * LC + l) * 512 + h * 64 + 8 * c8); }
    for (int idx = tid; idx < 64 * 32; idx += 512) { const int dd = idx >> 5, c8 = idx & 31;
        *(LAS u32x4*)(VTc + dd * NA_VLD + 8 * c8) = *(const u32x4*)(VTC + ((size_t)(b * 8 + h) * 64 + dd) * LC + 8 * c8); }
    LAS float* rpbl = (LAS float*)(VTc + 64 * NA_VLD);
    for (int idx = tid; idx < 15 * 31; idx += 512) rpbl[idx] = p.in[11][h * 15 * 31 + idx];
    __syncthreads();
    for (int wt = sub * 8 + wave; wt < 256; wt += nsub * 8) na_taskN<4>(p, b, h, wt >> 2, wt & 3, lane, Kc, VTc, rpbl);
}

typedef float f32x16 __attribute__((ext_vector_type(16)));
typedef float f32x2 __attribute__((ext_vector_type(2)));
constexpr int SC = 2;
constexpr int CL = 260;
__device__ __forceinline__ void chunk_pos(int b, int d, int q, int i, int& row, bool& hasp, bool& hasn, int& t) {
    const int s = q * CL + i;
    if (s < LC) { const int l = d ? (LC - 1 - s) : s; row = MT + b * LC + l; hasp = l > 0; hasn = l < LC - 1; t = -1; }
    else { const int off = s - LC; t = d ? (T - 1 - off) : off; row = b * T + t; hasp = t > 0; hasn = t < T - 1; }
}
__device__ __forceinline__ void prep_consts(const Params& p, int h, int lane, LAS float* cst) {
    const int hc = h * 64 + lane;
    cst[lane] = p.in[12][hc]; cst[64 + lane] = p.in[13][hc]; cst[128 + lane] = p.in[12][512 + hc]; cst[192 + lane] = p.in[13][512 + hc];
    cst[256 + lane] = p.in[12][1024 + hc]; cst[320 + lane] = p.in[13][1024 + hc];
    cst[384 + lane] = p.in[19][hc]; cst[448 + lane] = p.in[20][hc]; cst[512 + lane] = p.in[21][hc];
}
typedef unsigned short us2 __attribute__((ext_vector_type(2)));
struct RawTok { us2 rk, vd, pa, pb, nn, vn_ar; };
__device__ __forceinline__ RawTok prep_load(const bf16_t* PR, const bf16_t* DEC, const bf16_t* AR, int row, bool hp, bool hn, int hc, int dcol) {
    const bf16_t* pr = PR + (size_t)row * RWP;
    const bf16_t* prp = hp ? pr - RWP : pr; const bf16_t* prn = hn ? pr + RWP : pr;
    RawTok x;
    x.rk = (us2){pr[hc], pr[512 + hc]}; x.vd = (us2){pr[1024 + hc], (DEC + (size_t)row * 1024)[dcol]};
    x.pa = (us2){prp[hc], prp[512 + hc]}; x.pb = (us2){prp[1024 + hc], prn[hc]};
    x.nn = (us2){prn[512 + hc], prn[1024 + hc]}; x.vn_ar = (us2){(AR + (size_t)row * 1024)[dcol], (unsigned short)0};
    return x;
}
__device__ __forceinline__ void prep_compute(const RawTok& x, bool hp, bool hn, const LAS float* cst, LAS float* o, int lane) {
    const float mp_ = hp ? 1.0f : 0.0f, mn_ = hn ? 1.0f : 0.0f;
    const float rc = bf2f(x.rk[0]), kc = bf2f(x.rk[1]), vc = bf2f(x.vd[0]);
    const float rp = mp_ * bf2f(x.pa[0]), kp = mp_ * bf2f(x.pa[1]), vp = mp_ * bf2f(x.pb[0]);
    const float rn = mn_ * bf2f(x.pb[1]), kn = mn_ * bf2f(x.nn[0]), vn = mn_ * bf2f(x.nn[1]);
    const float r = rc + cst[lane] * (rp - rc) + cst[64 + lane] * (rn - rc);
    const float k = kc + cst[128 + lane] * (kp - kc) + cst[192 + lane] * (kn - kc);
    const float v = vc + cst[256 + lane] * (vp - vc) + cst[320 + lane] * (vn - vc);
    const float w = __expf(bf2f(x.vd[1]));
    const float a = bf2f(x.vn_ar[0]);
    const float kkr = k * cst[384 + lane];
    const float ss = wave_sum(kkr * kkr);
    const float kk = kkr * __builtin_amdgcn_rsqf(fmaxf(ss, 1e-24f));
    const float kd = k * (1.0f + (a - 1.0f) * cst[448 + lane]);
    o[lane] = w; o[64 + lane] = -kk; o[128 + lane] = kk * a; o[192 + lane] = kd; o[256 + lane] = r; o[320 + lane] = v;
}
#define LO2(x) ((f32x2){(x)[0], (x)[1]})
#define HI2(x) ((f32x2){(x)[2], (x)[3]})
template <int MODE>
__device__ __forceinline__ float rec_step(f32x2 (&s)[32], f32x2 (&pm)[32], const LAS float* o, int lane, float& zout) {
    constexpr int GA = 2;
    constexpr int GU = 1;
    const float vv = o[320 + lane];
    f32x2 sacc0 = {0.f, 0.f}, sacc1 = {0.f, 0.f}, pacc0 = {0.f, 0.f}, pacc1 = {0.f, 0.f};
    f32x4 abuf[2][GA];
#pragma unroll
    for (int i = 0; i < GA; ++i) abuf[0][i] = *(const LAS f32x4*)(o + 64 + 4 * i);
    f32x4 wb[2][GU], bb[2][GU], kb[2][GU], rb[2][GU];
#pragma unroll
    for (int gg = 0; gg < 16 / GA; ++gg) {
        if (gg < 16 / GA - 1) {
#pragma unroll
            for (int i = 0; i < GA; ++i) abuf[(gg + 1) & 1][i] = *(const LAS f32x4*)(o + 64 + 4 * GA * (gg + 1) + 4 * i);
        } else {
#pragma unroll
            for (int i = 0; i < GU; ++i) { wb[0][i] = *(const LAS f32x4*)(o + 4 * i); bb[0][i] = *(const LAS f32x4*)(o + 128 + 4 * i); kb[0][i] = *(const LAS f32x4*)(o + 192 + 4 * i);
                if (MODE != 0) rb[0][i] = *(const LAS f32x4*)(o + 256 + 4 * i); }
        }
        ;
#pragma unroll
        for (int i = 0; i < GA; ++i) { const int g = GA * gg + i; const f32x4 a4 = abuf[gg & 1][i];
            sacc0 += s[2 * g] * LO2(a4); sacc1 += s[2 * g + 1] * HI2(a4);
            if (MODE != 1) { pacc0 += pm[2 * g] * LO2(a4); pacc1 += pm[2 * g + 1] * HI2(a4); } }
        ;
    }
    const f32x2 sacc = sacc0 + sacc1, pacc = pacc0 + pacc1;
    const float sa = sacc.x + sacc.y, pa = pacc.x + pacc.y;
    const f32x2 sa2 = {sa, sa}, pa2 = {pa, pa}, vv2 = {vv, vv};
    f32x2 yacc0 = {0.f, 0.f}, yacc1 = {0.f, 0.f}, zacc0 = {0.f, 0.f}, zacc1 = {0.f, 0.f};
#pragma unroll
    for (int gg = 0; gg < 16 / GU; ++gg) {
        if (gg < 16 / GU - 1) {
#pragma unroll
            for (int i = 0; i < GU; ++i) { const int g = GU * (gg + 1) + i; wb[(gg + 1) & 1][i] = *(const LAS f32x4*)(o + 4 * g); bb[(gg + 1) & 1][i] = *(const LAS f32x4*)(o + 128 + 4 * g);
                kb[(gg + 1) & 1][i] = *(const LAS f32x4*)(o + 192 + 4 * g); if (MODE != 0) rb[(gg + 1) & 1][i] = *(const LAS f32x4*)(o + 256 + 4 * g); }
        }
        ;
#pragma unroll
        for (int i = 0; i < GU; ++i) { const int g = GU * gg + i; const f32x4 w4 = wb[gg & 1][i], b4 = bb[gg & 1][i], k4 = kb[gg & 1][i];
            s[2 * g] = s[2 * g] * LO2(w4) + sa2 * LO2(b4) + vv2 * LO2(k4);
            s[2 * g + 1] = s[2 * g + 1] * HI2(w4) + sa2 * HI2(b4) + vv2 * HI2(k4);
            if (MODE != 1) { pm[2 * g] = pm[2 * g] * LO2(w4) + pa2 * LO2(b4); pm[2 * g + 1] = pm[2 * g + 1] * HI2(w4) + pa2 * HI2(b4); }
            if (MODE != 0) { const f32x4 r4 = rb[gg & 1][i]; yacc0 += s[2 * g] * LO2(r4); yacc1 += s[2 * g + 1] * HI2(r4);
                if (MODE == 2) { zacc0 += pm[2 * g] * LO2(r4); zacc1 += pm[2 * g + 1] * HI2(r4); } } }
        ;
    }
    const f32x2 yacc = yacc0 + yacc1, zacc = zacc0 + zacc1;
    zout = zacc.x + zacc.y;
    return yacc.x + yacc.y;
}
template <bool DO_PREP = true, bool DO_REC = true, bool DUMMY = false>
__device__ __forceinline__ void phase_pass1(const Params& p, LAS unsigned char* lds) {
    const int lane = threadIdx.x & 63, wave = __builtin_amdgcn_readfirstlane(threadIdx.x >> 6);
    const bf16_t* PR = (const bf16_t*)(p.ws + OFF_PR); const bf16_t* DEC = (const bf16_t*)(p.ws + OFF_DEC); const bf16_t* AR = (const bf16_t*)(p.ws + OFF_AR);
    LAS float* stg = (LAS float*)lds + wave * (SC * 384);
    LAS float* cst = (LAS float*)lds + 8 * (SC * 384) + wave * 576;
    for (int tk = blockIdx.x; tk < 256; tk += gridDim.x) {
        const int b = tk >> 7, d = (tk >> 6) & 1, q = tk & 63, h = wave, ch = (b * 8 + h) * 2 + d;
        prep_consts(p, h, lane, cst);
        const int hc = h * 64 + lane, dcol = d * 512 + hc;
        bf16_t* YL = (bf16_t*)p.out + (size_t)d * MT * 512;
        bf16_t* ZZ = (bf16_t*)(p.ws + OFF_Q) + (size_t)d * MT * 512;
        f32x2 s[32], pm[32];
#pragma unroll
        for (int i = 0; i < 32; i += 2) { const f32x4 x = *(const f32x4*)((const float*)(p.ws + OFF_IDENT) + lane * 64 + 2 * i);
            s[i] = (f32x2){0.f, 0.f}; s[i + 1] = (f32x2){0.f, 0.f}; pm[i] = (f32x2){x[0], x[1]}; pm[i + 1] = (f32x2){x[2], x[3]}; }
        RawTok raw[SC];
#pragma unroll
        for (int j = 0; j < SC; ++j) { int row, t; bool hp_, hn_; chunk_pos(b, d, q, j, row, hp_, hn_, t); raw[j] = prep_load(PR, DEC, AR, row, hp_, hn_, hc, dcol); }
#pragma unroll 1
        for (int it = 0; it < CL / SC; ++it) {
            int row0 = 0, t0 = 0;
            { int hr_, ht_; bool x1, x2; chunk_pos(b, d, q, it * SC, hr_, x1, x2, ht_); row0 = hr_; t0 = ht_; }
            if (DO_PREP) {
#pragma unroll
                for (int j = 0; j < SC; ++j) { int row, t; bool hp_, hn_; chunk_pos(b, d, q, it * SC + j, row, hp_, hn_, t); prep_compute(raw[j], hp_, hn_, cst, stg + j * 384, lane); asm volatile("" ::: "memory"); }
                const int itn = min(it + 1, CL / SC - 1);
#pragma unroll
                for (int j = 0; j < SC; ++j) { int row, t; bool hp_, hn_; chunk_pos(b, d, q, itn * SC + j, row, hp_, hn_, t); raw[j] = prep_load(PR, DEC, AR, row, hp_, hn_, hc, dcol); }
            }
            if (DO_REC) {
                const bool latent = t0 >= 0 && !DUMMY;
                int rowc = row0; const int rstep = d ? -1 : 1;
#pragma unroll 1
                for (int st = 0; st < SC; ++st) { float z; const float y = rec_step<2>(s, pm, stg + st * 384, lane, z);
                    if (latent) { (YL + (size_t)rowc * 512)[hc] = f2bf(y); (ZZ + (size_t)rowc * 512)[hc] = f2bf(z); } rowc += rstep; }
            }
        }
        float* hp = p.out + (DUMMY ? 0 : (size_t)MT * 512) + ((size_t)(ch * 64 + q) * 2) * 4096 + lane * 64;
        if (!DUMMY) {
#pragma unroll
        for (int i = 0; i < 32; i += 2) { *(f32x4*)(hp + 2 * i) = (f32x4){s[i].x, s[i].y, s[i + 1].x, s[i + 1].y}; *(f32x4*)(hp + 4096 + 2 * i) = (f32x4){pm[i].x, pm[i].y, pm[i + 1].x, pm[i + 1].y}; }
        }
    }
}
__device__ __forceinline__ void phase_pass2(const Params& p, LAS unsigned char* lds, int ch, int mt) {
    constexpr int LDP = 68;
    LAS float* Sl = (LAS float*)lds; LAS float* Pl = Sl + 16 * LDP;
    const int tid = threadIdx.x, lane = tid & 63, w = tid >> 6, fr = lane & 15, fq = lane >> 4;
    const float* HP = p.out + (size_t)MT * 512 + (size_t)ch * 64 * 8192;
    float* SST = (float*)(p.ws + OFF_SST) + (size_t)ch * 65 * 4096;
    for (int idx = tid; idx < 16 * LDP; idx += 512) Sl[idx] = 0.f;
    for (int idx = tid; idx < 1024; idx += 512) SST[mt * 1024 + idx] = 0.f;
    const int pidx = tid * 8, pj = pidx >> 6, pk = pidx & 63;
    f32x4 px0 = *(const f32x4*)(HP + 4096 + pidx), px1 = *(const f32x4*)(HP + 4096 + pidx + 4);
    f32x4 hx = {0.f, 0.f, 0.f, 0.f};
    if (w < 4) {
#pragma unroll
        for (int e = 0; e < 4; ++e) hx[e] = HP[(16 * mt + 4 * fq + e) * 64 + 16 * w + fr];
    }
#pragma unroll 1
    for (int q = 0; q < 63; ++q) {
        *(LAS f32x4*)(Pl + pj * LDP + pk) = px0; *(LAS f32x4*)(Pl + pj * LDP + pk + 4) = px1;
        f32x4 acc = hx;
        const float* Hn = HP + (size_t)min(q + 1, 62) * 8192;
        px0 = *(const f32x4*)(Hn + 4096 + pidx); px1 = *(const f32x4*)(Hn + 4096 + pidx + 4);
        if (w < 4) {
#pragma unroll
            for (int e = 0; e < 4; ++e) hx[e] = Hn[(16 * mt + 4 * fq + e) * 64 + 16 * w + fr];
        }
        __syncthreads();
        if (w < 4) {
#pragma unroll
            for (int ks = 0; ks < 16; ++ks) {
                const float a = Sl[fr * LDP + 4 * ks + fq];
                const float b0 = Pl[(4 * ks + fq) * LDP + 16 * w + fr];
                acc = __builtin_amdgcn_mfma_f32_16x16x4f32(a, b0, acc, 0, 0, 0);
            }
        }
        __syncthreads();
        if (w < 4) {
#pragma unroll
            for (int e = 0; e < 4; ++e) { const int vl = 4 * fq + e, k = 16 * w + fr; Sl[vl * LDP + k] = acc[e]; SST[(size_t)(q + 1) * 4096 + (16 * mt + vl) * 64 + k] = acc[e]; }
        }
    }
}
struct FinRaw { us2 z, yl, gv, rk, pa, pb, nn, aa; };
__device__ __forceinline__ FinRaw fin_load(const bf16_t* PR, const bf16_t* AR, const bf16_t* MIX, const bf16_t* YL0, const bf16_t* Z0, int b, int t, int c) {
    const int row = b * T + t;
    const bf16_t* pr = PR + (size_t)row * RWP; const bf16_t* prp = t > 0 ? pr - RWP : pr; const bf16_t* prn = t < T - 1 ? pr + RWP : pr;
    const bf16_t* z0 = Z0 + (size_t)row * 512; const bf16_t* z1 = z0 + (size_t)MT * 512;
    const bf16_t* y0 = YL0 + (size_t)row * 512; const bf16_t* y1 = y0 + (size_t)MT * 512;
    const bf16_t* ar = AR + (size_t)row * 1024;
    FinRaw x;
    x.z = (us2){z0[c], z1[c]}; x.yl = (us2){y0[c], y1[c]}; x.gv = (us2){(MIX + (size_t)row * 1024 + 512)[c], pr[1024 + c]};
    x.rk = (us2){pr[c], pr[512 + c]}; x.pa = (us2){prp[c], prp[512 + c]}; x.pb = (us2){prp[1024 + c], prn[c]};
    x.nn = (us2){prn[512 + c], prn[1024 + c]}; x.aa = (us2){ar[c], ar[512 + c]};
    return x;
}
__device__ __forceinline__ void phase_fixfinish(const Params& p, LAS unsigned char* lds) {
    const int tid = threadIdx.x, lane = tid & 63, wave = __builtin_amdgcn_readfirstlane(tid >> 6);
    const bf16_t* PR = (const bf16_t*)(p.ws + OFF_PR); const bf16_t* AR = (const bf16_t*)(p.ws + OFF_AR);
    bf16_t* MIX = (bf16_t*)(p.ws + OFF_MIX);
    const float* mup = p.in[12]; const float* mun = p.in[13];
    const int h = wave, c = h * 64 + lane;
    const float lng = p.in[22][c], lnb = p.in[23][c];
    const float mpv = mup[1024 + c], mnv = mun[1024 + c], mpr = mup[c], mnr = mun[c], mpk = mup[512 + c], mnk = mun[512 + c], kac = p.in[20][c], rkc = p.in[21][c];
    const bf16_t* YL0 = (const bf16_t*)p.out; const bf16_t* Z0 = (const bf16_t*)(p.ws + OFF_Q);
    const float* SSTb = (const float*)(p.ws + OFF_SST);
    LAS float* zb = (LAS float*)lds + wave * 128;
    constexpr int NT = 2;
    for (int tk = blockIdx.x; tk < 256; tk += gridDim.x) {
        const int b = tk >> 7, m = tk & 127;
        const float* S0base = SSTb + (size_t)((b * 8 + h) * 2 + 0) * 65 * 4096 + lane * 64;
        const float* S1base = SSTb + (size_t)((b * 8 + h) * 2 + 1) * 65 * 4096 + lane * 64;
        f32x2 s0[32], s1[32]; int q0c = -1, q1c = -1;
        FinRaw fr[NT];
#pragma unroll
        for (int j = 0; j < NT; ++j) fr[j] = fin_load(PR, AR, MIX, YL0, Z0, b, m * 128 + j, c);
#pragma unroll 1
        for (int tl0 = 0; tl0 < 128; tl0 += NT) {
            FinRaw cur[NT];
#pragma unroll
            for (int j = 0; j < NT; ++j) cur[j] = fr[j];
            const int tn0 = m * 128 + min(tl0 + NT, 128 - NT);
#pragma unroll
            for (int j = 0; j < NT; ++j) fr[j] = fin_load(PR, AR, MIX, YL0, Z0, b, tn0 + j, c);
#pragma unroll
            for (int j = 0; j < NT; ++j) {
                const int t = m * 128 + tl0 + j, row = b * T + t;
                const int q0 = (LC + t) / CL, q1 = (LC + T - 1 - t) / CL;
                if (q0 != q0c) { q0c = q0; const float* sp = S0base + (size_t)q0 * 4096;
#pragma unroll
                    for (int i = 0; i < 32; i += 2) { const f32x4 x = *(const f32x4*)(sp + 2 * i); s0[i] = (f32x2){x[0], x[1]}; s0[i + 1] = (f32x2){x[2], x[3]}; } }
                if (q1 != q1c) { q1c = q1; const float* sp = S1base + (size_t)q1 * 4096;
#pragma unroll
                    for (int i = 0; i < 32; i += 2) { const f32x4 x = *(const f32x4*)(sp + 2 * i); s1[i] = (f32x2){x[0], x[1]}; s1[i + 1] = (f32x2){x[2], x[3]}; } }
                const FinRaw& x = cur[j];
                zb[lane] = bf2f(x.z[0]); zb[64 + lane] = bf2f(x.z[1]);
                float w = bf2f(x.yl[0]) + bf2f(x.yl[1]);
                const float gte = bf2f(x.gv[0]);
                const float mp_ = t > 0 ? 1.0f : 0.0f, mn_ = t < T - 1 ? 1.0f : 0.0f;
                const float vc = bf2f(x.gv[1]), rc = bf2f(x.rk[0]), kc = bf2f(x.rk[1]);
                const float rp = mp_ * bf2f(x.pa[0]), kp = mp_ * bf2f(x.pa[1]), vp = mp_ * bf2f(x.pb[0]);
                const float rn = mn_ * bf2f(x.pb[1]), kn = mn_ * bf2f(x.nn[0]), vn = mn_ * bf2f(x.nn[1]);
                const float a0 = bf2f(x.aa[0]), a1 = bf2f(x.aa[1]);
                f32x2 acc0 = {0.f, 0.f}, acc1 = {0.f, 0.f};
#pragma unroll
                for (int g = 0; g < 16; ++g) { const f32x4 za = *(const LAS f32x4*)(zb + 4 * g), zc = *(const LAS f32x4*)(zb + 64 + 4 * g);
                    acc0 += s0[2 * g] * LO2(za); acc0 += s0[2 * g + 1] * HI2(za); acc1 += s1[2 * g] * LO2(zc); acc1 += s1[2 * g + 1] * HI2(zc); }
                const f32x2 acc = acc0 + acc1; w += acc.x + acc.y;
                const float mu = wave_sum(w) * (1.0f / 64.0f);
                const float dv = w - mu;
                const float var = wave_sum(dv * dv) * (1.0f / 64.0f);
                float y = dv * rsqrtf(var + 64e-5f) * lng + lnb;
                const float vs = vc + mpv * (vp - vc) + mnv * (vn - vc);
                const float rs = rc + mpr * (rp - rc) + mnr * (rn - rc);
                const float ks = kc + mpk * (kp - kc) + mnk * (kn - kc);
                const float bon = wave_sum(rs * ks * rkc * (2.0f + (a0 + a1 - 2.0f) * kac));
                y = (y + bon * vs) * gte;
                MIX[(size_t)row * 1024 + 512 + c] = f2bf(y);
            }
        }
    }
}

__global__ void __launch_bounds__(512) mega(Params p) {
    extern __shared__ __attribute__((aligned(16))) unsigned char shm[];
    LAS unsigned char* lds = (LAS unsigned char*)shm;
    cg::grid_group grid = cg::this_grid();
    __shared__ unsigned xb_words[4];
    if (threadIdx.x < 4) xb_words[threadIdx.x] = 0u;
    __syncthreads();
    const XcdBarrier xb = xcd_barrier_post((unsigned*)(p.ws + OFF_BAR), (volatile LAS unsigned*)xb_words);
    const float* mod = (const float*)(p.ws + OFF_MOD);
#ifndef PHMASK
#define PHMASK 0x1fff
#endif
#ifndef REPMASK
#define REPMASK 0
#endif
#define HAS(x) ((PHMASK >> (x)) & 1)
#define RUN(k) (HAS(k) && p.ph_lo <= (k) && (k) < p.ph_hi)
#define SYNC(k) do { if (p.ph_lo <= (k) && (k) + 1 < p.ph_hi) { if ((k) == 0) grid.sync(); else xcd_barrier(xb); } } while (0)
#define PHASE(k, ...) do { if (RUN(k)) { __VA_ARGS__; if ((REPMASK >> (k)) & 1) { xcd_barrier(xb); __VA_ARGS__; } } SYNC(k); } while (0)
#define GEMM_PH_W(EPI, Aoff, Boff, M_, N_, K_, LD_, THR_, KOFF_, ...) { int kk_ = (K_); asm volatile("" : "+s"(kk_)); pg8::Gemm g{(const bf16_t*)(p.ws + (Aoff)), (const bf16_t*)(p.ws + (Boff)), (M_), (N_), kk_, (LD_), (THR_), (KOFF_)}; \
        pg8::StaticOrder S; S.init((M_), (N_), (int)gridDim.x, (int)blockIdx.x); EPI E{__VA_ARGS__}; pg8::gemm_phase<EPI, pg8::StaticOrder, false>(lds, g, S, E, nullptr); }
#define GEMM_PH(EPI, Aoff, Boff, M_, N_, K_, ...) { int kk_ = (K_); asm volatile("" : "+s"(kk_)); pg8::Gemm g{(const bf16_t*)(p.ws + (Aoff)), (const bf16_t*)(p.ws + (Boff)), (M_), (N_), kk_}; \
        pg8::StaticOrder S; S.init((M_), (N_), (int)gridDim.x, (int)blockIdx.x); EPI E{__VA_ARGS__}; pg8::gemm_phase<EPI, pg8::StaticOrder, false>(lds, g, S, E, nullptr); }
    PHASE(0, phase0(p, lds));
    PHASE(1, phase_norm(p, 0));
    PHASE(2, GEMM_PH(EpiIn, OFF_U, OFF_WIN, MA, INPP, 1024, (bf16_t*)(p.ws + OFF_Q), (bf16_t*)(p.ws + OFF_K), (bf16_t*)(p.ws + OFF_VT), (bf16_t*)(p.ws + OFF_VTC), (bf16_t*)(p.ws + OFF_PR), p.in[9], p.in[10]));
    PHASE(3, phase_shiftprep(p); phase_na(p, lds, (int)blockIdx.x, (int)gridDim.x));
    PHASE(4, GEMM_PH_W(EpiLora, OFF_LA, OFF_LORAB, MA, 2560, 256, 384, 8, 128, (bf16_t*)(p.ws + OFF_DEC), (bf16_t*)(p.ws + OFF_AR), (bf16_t*)(p.ws + OFF_MIX), p.in[14], p.in[16]));
    PHASE(6, phase_pass1(p, lds));
    PHASE(7, if ((int)gridDim.x > NCHAIN * 4 && (int)blockIdx.x >= NCHAIN * 4) weight_transposes(p, lds, W_EARLY, W_ALL, ((int)blockIdx.x - NCHAIN * 4) * 8 + (int)(threadIdx.x >> 6), ((int)gridDim.x - NCHAIN * 4) * 8);
             else { for (int it_ = blockIdx.x; it_ < NCHAIN * 4; it_ += ((int)gridDim.x > NCHAIN * 4 ? NCHAIN * 4 : (int)gridDim.x)) phase_pass2(p, lds, it_ >> 2, it_ & 3);
                    if ((int)gridDim.x <= NCHAIN * 4) weight_transposes(p, lds, W_EARLY, W_ALL, (int)blockIdx.x * 8 + (int)(threadIdx.x >> 6), (int)gridDim.x * 8); });
    PHASE(8, phase_fixfinish(p, lds));
    PHASE(9, GEMM_PH(EpiRes, OFF_MIX, OFF_WOUT, MT, 1024, 1024, p.in[0], p.out, mod + 2 * 1024));
    PHASE(10, phase_norm(p, 1));
    PHASE(11, GEMM_PH(EpiGlu, OFF_U, OFF_WF1, MT, 2 * DFF, 1024, (bf16_t*)(p.ws + OFF_ACT)));
    PHASE(12, GEMM_PH(EpiRes, OFF_ACT, OFF_WF2, MT, 1024, DFF, p.out, p.out, mod + 5 * 1024));
}

extern "C" void kernel_launch(void* const* d_in, const int* in_sizes, int n_in, void* d_out, int out_size, void* d_ws, size_t ws_size, hipStream_t stream) {
    static int grid = 0;
    if (!grid) {
        int dev = 0, cus = 0, per_cu = 0;
        (void)hipGetDevice(&dev);
        (void)hipDeviceGetAttribute(&cus, hipDeviceAttributeMultiprocessorCount, dev);
        (void)hipFuncSetAttribute((const void*)mega, hipFuncAttributeMaxDynamicSharedMemorySize, LDS_BYTES);
        if (hipOccupancyMaxActiveBlocksPerMultiprocessor(&per_cu, (const void*)mega, 512, LDS_BYTES) != hipSuccess || per_cu < 1) { (void)hipGetLastError(); per_cu = 1; }
        grid = cus * per_cu;
        if (ws_size < OFF_END) fprintf(stderr, "kernel_launch: workspace too small: %zu < %zu\n", ws_size, (size_t)OFF_END);
    }
    Params p{};
    for (int i = 0; i < 27; ++i) p.in[i] = (const float*)d_in[i];
    p.out = (float*)d_out; p.ws = (unsigned char*)d_ws; p.ph_lo = 0; p.ph_hi = 13;
    (void)hipMemsetAsync((unsigned char*)d_ws + OFF_BAR, 0, 16384, stream);
    void* args[] = {&p};
    hipError_t e = hipLaunchCooperativeKernel((const void*)mega, dim3(grid), dim3(512), args, LDS_BYTES, stream);
    if (e != hipSuccess) fprintf(stderr, "cooperative launch failed: %s (grid %d)\n", hipGetErrorString(e), grid);
}
```

```cpp
#include <hip/hip_runtime.h>
#include <hip/hip_cooperative_groups.h>
#include <cstdio>
namespace cg = cooperative_groups;
namespace pg8 {
#define PG8_LAS __attribute__((address_space(3)))
typedef unsigned short bf16_t;
typedef short bf16x8 __attribute__((ext_vector_type(8)));
typedef float f32x4 __attribute__((ext_vector_type(4)));
typedef unsigned u32x4 __attribute__((ext_vector_type(4)));
constexpr int BM = 256, BK = 64, HALF = 128, HTB = HALF * BK * 2  , STAGE_BYTES = 8 * HTB, NXCD = 8, WGM = 8;

__host__ __device__ __forceinline__ int lds_byte(int r, int c) { const int st = (r >> 4) * 2 + (c >> 5), rr = r & 15, cc = c & 31, ob = rr * 64 + cc * 2; return st * 1024 + (ob ^ (((ob >> 9) & 1) << 5)); }
__host__ __device__ __forceinline__ void stage_rc(int b, int& R, int& C) { const int st = b / 1024, sb = b % 1024, swz = sb ^ (((sb >> 9) & 1) << 5); R = (st >> 1) * 16 + swz / 64; C = (st & 1) * 32 + (swz % 64) / 2; }
__host__ __device__ __forceinline__ int perm32(int rho) { const int n = rho >> 4, i = rho & 15; return 8 * (i >> 2) + 4 * n + (i & 3); }

struct Unit { int pm, pn; };
struct Gemm { const bf16_t* A; const bf16_t* Bt; int M, N, K; int ld = 0, pn_thr = 1 << 30, koff = 0; };

struct StaticOrder {
    int nM, nN, nwg, G, c;
    __host__ __device__ void init(int M, int N, int G_, int c_) { nM = M / BM; nN = N / BM; nwg = nM * nN; G = G_; c = c_; }
    __host__ __device__ bool next(int i, Unit& u) const {
        const long L = (long)i * G + c; if (L >= nwg) return false;
        int wgid = (int)L; { const int q = nwg / NXCD, r = nwg % NXCD, xcd = wgid % NXCD, off = wgid / NXCD; wgid = (xcd < r ? xcd * (q + 1) : r * (q + 1) + (xcd - r) * q) + off; }
        const int nig = WGM * nN, gid = wgid / nig, fm = gid * WGM, gsz = (nM - fm) < WGM ? (nM - fm) : WGM;
        u.pm = fm + ((wgid % nig) % gsz); u.pn = (wgid % nig) / gsz; return true;
    }
    __device__ __forceinline__ void a_ready(const Unit&) const {}
    __device__ __forceinline__ void done(const Unit&) const {}
};
__device__ __forceinline__ unsigned cvt_pk_bf16(float lo, float hi) { unsigned r; asm volatile("v_cvt_pk_bf16_f32 %0, %1, %2" : "=v"(r) : "v"(lo), "v"(hi)); return r; }
typedef float f32x2 __attribute__((ext_vector_type(2)));
template <class Epi, class Sched, bool STAMP = false>
__device__ __forceinline__ void gemm_phase(PG8_LAS unsigned char* lds, const Gemm g, const Sched& S, const Epi& E, unsigned long long* stamps) {
    const int tid = threadIdx.x, wid = __builtin_amdgcn_readfirstlane(tid >> 6), lane = tid & 63, wr = wid >> 2, wc = wid & 3, fr = lane & 15, fq = lane >> 4;
    const int K = g.ld ? g.ld : g.K, nt = g.K / BK;
    int ts_lo = 0, ts_hi = 0, nts = 0; const unsigned long long rt_entry = STAMP ? (unsigned long long)wall_clock64() : 0ull;
#define PG8_STAMP() do { if (STAMP && wid == 0 && nts < 64) { const unsigned long long _c = (unsigned long long)clock64(); \
        ts_lo = (lane == nts) ? (int)(unsigned)_c : ts_lo; ts_hi = (lane == nts) ? (int)(unsigned)(_c >> 32) : ts_hi; ++nts; } } while (0)
    PG8_STAMP();
    unsigned voffA[2], voffB[2];
#pragma unroll
    for (int i = 0; i < 2; ++i) { int R, C; stage_rc(tid * 16 + i * 8192, R, C); const int Rb = Epi::PERM ? ((R & ~31) + perm32(R & 31)) : R;
        voffA[i] = (unsigned)(R * K + C) * 2u; voffB[i] = (unsigned)(Rb * K + C) * 2u; }
    const size_t kstep = (size_t)(BK * 2);
    const size_t hstep = (size_t)HALF * K * 2;
    const size_t tstep = 2 * hstep;
    const unsigned ldsw = (unsigned)wid * 1024u;
    const int aoff = lds_byte(wr * 64 + fr, fq * 8), boff = lds_byte(wc * 32 + fr, fq * 8);
#define PG8_SA(b, h) (((b) * 2 + (h)) * HTB)
#define PG8_SB(b, h) ((4 + (b) * 2 + (h)) * HTB)
#define PG8_STAGE(bufoff, gbase, voff) do { _Pragma("unroll") for (int _i = 0; _i < 2; ++_i) \
        __builtin_amdgcn_global_load_lds((const unsigned*)((const char*)(gbase) + (voff)[_i]), (PG8_LAS unsigned*)(lds + (bufoff) + ldsw + _i * 8192), 16, 0, 0); } while (0)
#define PG8_LDA(dst, b, h) do { _Pragma("unroll") for (int m = 0; m < 4; ++m) _Pragma("unroll") for (int k = 0; k < 2; ++k) dst[m][k] = *(const PG8_LAS bf16x8*)(lds + PG8_SA(b, h) + aoff + m * 2048 + k * 1024); } while (0)
#define PG8_LDB(dst, b, h) do { _Pragma("unroll") for (int n = 0; n < 2; ++n) _Pragma("unroll") for (int k = 0; k < 2; ++k) dst[n][k] = *(const PG8_LAS bf16x8*)(lds + PG8_SB(b, h) + boff + n * 2048 + k * 1024); } while (0)
#define PG8_MMA(ai, bj, At, Bt) do { __builtin_amdgcn_s_setprio(1); _Pragma("unroll") for (int m = 0; m < 4; ++m) _Pragma("unroll") for (int n = 0; n < 2; ++n) _Pragma("unroll") for (int k = 0; k < 2; ++k) \
        acc[ai][bj][m][n] = __builtin_amdgcn_mfma_f32_16x16x32_bf16(Bt[n][k], At[m][k], acc[ai][bj][m][n], 0, 0, 0); __builtin_amdgcn_s_setprio(0); } while (0)
#define PG8_WAIT_V(n) asm volatile("s_waitcnt vmcnt(" #n ")" ::: "memory")
#define PG8_WAIT_L(n) asm volatile("s_waitcnt lgkmcnt(" #n ")" ::: "memory")
#define PG8_BAR __builtin_amdgcn_s_barrier()
#define PG8_SCHED __builtin_amdgcn_sched_barrier(0)
    Unit cur, nxt; int ui = 0;
    if (!S.next(0, cur)) return;
    f32x4 acc[2][2][4][2];
#pragma unroll
    for (int a = 0; a < 2; ++a)
#pragma unroll
        for (int b = 0; b < 2; ++b)
#pragma unroll
            for (int m = 0; m < 4; ++m)
#pragma unroll
                for (int n = 0; n < 2; ++n) acc[a][b][m][n] = (f32x4){0.f, 0.f, 0.f, 0.f};
    bf16x8 At[4][2], B0[2][2], B1[2][2];
    const char* cA = (const char*)g.A + (size_t)cur.pm * tstep + (cur.pn >= g.pn_thr ? g.koff * 2 : 0); const char* cB = (const char*)g.Bt + (size_t)cur.pn * tstep + (cur.pn >= g.pn_thr ? g.koff * 2 : 0);
    S.a_ready(cur);
    PG8_STAGE(PG8_SB(0, 0), cB, voffB); PG8_STAGE(PG8_SA(0, 0), cA, voffA); PG8_STAGE(PG8_SB(0, 1), cB + hstep, voffB); PG8_STAGE(PG8_SA(0, 1), cA + hstep, voffA);
    if (wr == 1) PG8_BAR;
    PG8_WAIT_V(4); PG8_BAR;
    PG8_STAGE(PG8_SB(1, 0), cB + kstep, voffB); PG8_STAGE(PG8_SA(1, 0), cA + kstep, voffA); PG8_STAGE(PG8_SB(1, 1), cB + hstep + kstep, voffB);
    PG8_WAIT_V(6); PG8_BAR;
    PG8_STAMP();
    for (;;) {
        const bool has_next = S.next(ui + 1, nxt);
        const int nko = (has_next && nxt.pn >= g.pn_thr) ? g.koff * 2 : 0;
        const char* nA = has_next ? (const char*)g.A + (size_t)nxt.pm * tstep + nko : cA; const char* nB = has_next ? (const char*)g.Bt + (size_t)nxt.pn * tstep + nko : cB;
        for (int t = 0; t < nt; t += 2) {
            const bool last = (t == nt - 2);
            const char* a1 = cA + (size_t)(t + 1) * kstep;
            const char* a2 = last ? nA : cA + (size_t)(t + 2) * kstep; const char* b2 = last ? nB : cB + (size_t)(t + 2) * kstep;
            const char* a3 = a2 + kstep; const char* b3 = b2 + kstep;
            if (last && has_next) S.a_ready(nxt);
            PG8_LDB(B0, 0, 0); PG8_SCHED; PG8_LDA(At, 0, 0); PG8_STAGE(PG8_SA(1, 1), a1 + hstep, voffA);
            PG8_WAIT_L(8); PG8_BAR; PG8_WAIT_L(0); PG8_MMA(0, 0, At, B0); PG8_BAR; PG8_SCHED;
            PG8_LDB(B1, 0, 1); PG8_STAGE(PG8_SB(0, 0), b2, voffB);
            PG8_BAR; PG8_WAIT_L(0); PG8_MMA(0, 1, At, B1); PG8_BAR;
            PG8_LDA(At, 0, 1); PG8_STAGE(PG8_SA(0, 0), a2, voffA);
            PG8_BAR; PG8_WAIT_L(0); PG8_MMA(1, 0, At, B0); PG8_BAR; PG8_SCHED;
            PG8_STAGE(PG8_SB(0, 1), b2 + hstep, voffB);
            PG8_WAIT_V(6); PG8_BAR; PG8_MMA(1, 1, At, B1); PG8_BAR;
            PG8_LDB(B0, 1, 0); PG8_SCHED; PG8_LDA(At, 1, 0); PG8_STAGE(PG8_SA(0, 1), a2 + hstep, voffA);
            PG8_WAIT_L(8); PG8_BAR; PG8_WAIT_L(0); PG8_MMA(0, 0, At, B0); PG8_BAR; PG8_SCHED;
            PG8_LDB(B1, 1, 1); PG8_STAGE(PG8_SB(1, 0), b3, voffB);
            PG8_BAR; PG8_WAIT_L(0); PG8_MMA(0, 1, At, B1); PG8_BAR;
            PG8_LDA(At, 1, 1); PG8_STAGE(PG8_SA(1, 0), a3, voffA);
            PG8_BAR; PG8_WAIT_L(0); PG8_MMA(1, 0, At, B0); PG8_BAR; PG8_SCHED;
            PG8_STAGE(PG8_SB(1, 1), b3 + hstep, voffB);
            PG8_WAIT_V(6); PG8_BAR; PG8_MMA(1, 1, At, B1); PG8_BAR;
        }
        PG8_STAMP();
        if constexpr (!Epi::AFTER_DRAIN) { E(acc, cur, wr, wc, fr, fq); S.done(cur); }
        PG8_STAMP();
        if (!has_next) break;
#pragma unroll
        for (int a = 0; a < 2; ++a)
#pragma unroll
            for (int b = 0; b < 2; ++b)
#pragma unroll
                for (int m = 0; m < 4; ++m)
#pragma unroll
                    for (int n = 0; n < 2; ++n) acc[a][b][m][n] = (f32x4){0.f, 0.f, 0.f, 0.f};
        cur = nxt; cA = nA; cB = nB; ++ui;
    }
    PG8_WAIT_V(0);
    if (wr == 0) PG8_BAR;
    PG8_BAR;
    if constexpr (Epi::AFTER_DRAIN) { E.fused(acc, cur, wr, wc, fr, fq, lds, wid, lane); S.done(cur); }
    PG8_STAMP();
    if (STAMP && wid == 0) { stamps[lane] = lane < nts ? (((unsigned long long)(unsigned)ts_hi << 32) | (unsigned)ts_lo) : 0ull;
        if (lane == 62) stamps[62] = rt_entry; if (lane == 63) stamps[63] = (unsigned long long)wall_clock64(); }
#undef PG8_STAMP
#undef PG8_SA
#undef PG8_SB
#undef PG8_STAGE
#undef PG8_LDA
#undef PG8_LDB
#undef PG8_MMA
#undef PG8_WAIT_V
#undef PG8_WAIT_L
#undef PG8_BAR
#undef PG8_SCHED
}
}
using pg8::bf16_t; using pg8::bf16x8; using pg8::f32x4; using pg8::u32x4; using pg8::Unit;
typedef unsigned u32x2 __attribute__((ext_vector_type(2)));
typedef short s16x4 __attribute__((ext_vector_type(4)));
#define LAS __attribute__((address_space(3)))

constexpr int D = 1024, NB = 2, T = 16384, LC = 256, MT = NB * T, MC = NB * LC, MA = MT + MC;
constexpr int RWP = 1856, INP = 3392, INPP = 3584, DFF = 2816;
constexpr int LDS_BYTES = 131072;
constexpr int NCHAIN = 32;

constexpr size_t OFF_MOD = 0;
constexpr size_t OFF_WIN = 131072;
constexpr size_t OFF_WOUT = OFF_WIN + (size_t)INPP * 1024 * 2;
constexpr size_t OFF_WF1 = OFF_WOUT + (size_t)1024 * 1024 * 2;
constexpr size_t OFF_WF2 = OFF_WF1 + (size_t)5632 * 1024 * 2;
constexpr size_t OFF_LORAB = OFF_WF2 + (size_t)1024 * 2816 * 2;
constexpr size_t OFF_MIX = OFF_LORAB + (size_t)2560 * 384 * 2;
constexpr size_t OFF_U = OFF_MIX + (size_t)MT * 1024 * 2;
constexpr size_t OFF_Q = OFF_U + (size_t)MA * 1024 * 2;
constexpr size_t OFF_K = OFF_Q + (size_t)MA * 512 * 2;
constexpr size_t OFF_VT = OFF_K + (size_t)MA * 512 * 2;
constexpr size_t OFF_VTC = OFF_VT + (size_t)NB * 8 * 64 * T * 2;
constexpr size_t OFF_PR = OFF_VTC + (size_t)NB * 8 * 64 * LC * 2;
constexpr size_t OFF_DEC = OFF_PR + (size_t)MA * RWP * 2;
constexpr size_t OFF_AR = OFF_DEC + (size_t)MA * 1024 * 2;
constexpr size_t OFF_BON = OFF_AR + (size_t)MA * 1024 * 2;
constexpr size_t OFF_LA = OFF_U;
constexpr size_t OFF_SST = OFF_U + (size_t)32 * 1024 * 1024;
constexpr size_t OFF_IDENT = OFF_BON + (size_t)NCHAIN * T * 4;
constexpr size_t OFF_BAR = OFF_IDENT + 16384;
constexpr size_t OFF_END = OFF_BAR + 16384;
constexpr size_t OFF_ACT = OFF_Q;
static_assert(OFF_ACT + (size_t)MT * DFF * 2 <= OFF_DEC, "ACT alias overflow");
static_assert(OFF_END <= (size_t)536870912, "workspace");

struct Params {
    const float* in[27];
    float* out; unsigned char* ws;
    int ph_lo, ph_hi;
};

__device__ __forceinline__ float bf2f(bf16_t v) { return __uint_as_float(((unsigned)v) << 16); }
typedef __bf16 hwbf16x2 __attribute__((ext_vector_type(2)));
typedef float cvf32x2 __attribute__((ext_vector_type(2)));
__device__ __forceinline__ unsigned pk2(float lo, float hi) { const hwbf16x2 r = __builtin_convertvector((cvf32x2){lo, hi}, hwbf16x2); return __builtin_bit_cast(unsigned, r); }
__device__ __forceinline__ bf16_t f2bf(float f) { return (bf16_t)(pk2(f, 0.0f) & 0xffffu); }
__device__ __forceinline__ float dpp_f(float v, int ctrl_quad) { return v; }
#define DPPF(v, ctrl) __builtin_bit_cast(float, __builtin_amdgcn_update_dpp(0, __builtin_bit_cast(int, (v)), (ctrl), 0xf, 0xf, true))
__device__ __forceinline__ float wave_sum(float v) {
    v += DPPF(v, 0xB1);
    v += DPPF(v, 0x4E);
    v += DPPF(v, 0x141);
    v += DPPF(v, 0x140);
    const float s0 = __builtin_bit_cast(float, __builtin_amdgcn_readlane(__builtin_bit_cast(int, v), 0)), s1 = __builtin_bit_cast(float, __builtin_amdgcn_readlane(__builtin_bit_cast(int, v), 16));
    const float s2 = __builtin_bit_cast(float, __builtin_amdgcn_readlane(__builtin_bit_cast(int, v), 32)), s3 = __builtin_bit_cast(float, __builtin_amdgcn_readlane(__builtin_bit_cast(int, v), 48));
    return (s0 + s1) + (s2 + s3);
}
__device__ __forceinline__ float silu_f(float x) { return x * __builtin_amdgcn_rcpf(1.0f + __expf(-x)); }
__device__ __forceinline__ float sigmoid_f(float x) { return __builtin_amdgcn_rcpf(1.0f + __expf(-x)); }

struct EpiIn {
    static constexpr bool PERM = false, AFTER_DRAIN = false;
    bf16_t *Q, *K, *VT, *VTC, *PR; const float *qg, *kg;
    __device__ __forceinline__ void operator()(const f32x4 (&acc)[2][2][4][2], const Unit& u, int wr, int wc, int fr, int fq) const {
        const int c0 = u.pn * 256 + wc * 64;
        const int row0 = u.pm * 256 + wr * 64 + fr;
        if (c0 < 1024) {
            const bool isq = c0 < 512; const float* g = isq ? qg : kg; bf16_t* dst = isq ? Q : K; const int cc = c0 & 511; const float sc = isq ? 0.125f : 1.0f;
            f32x4 gv[2][2];
#pragma unroll
            for (int bj = 0; bj < 2; ++bj)
#pragma unroll
                for (int n = 0; n < 2; ++n) gv[bj][n] = *(const f32x4*)(g + 32 * bj + 8 * fq + 4 * n) * sc;
#pragma unroll
            for (int ai = 0; ai < 2; ++ai)
#pragma unroll
                for (int m = 0; m < 4; ++m) {
                    float ss = 0.f;
#pragma unroll
                    for (int bj = 0; bj < 2; ++bj)
#pragma unroll
                        for (int n = 0; n < 2; ++n) { const f32x4 x = acc[ai][bj][m][n]; ss += (x[0] * x[0] + x[1] * x[1]) + (x[2] * x[2] + x[3] * x[3]); }
                    ss += __shfl_xor(ss, 16); ss += __shfl_xor(ss, 32);
                    const float rstd = rsqrtf(ss * (1.0f / 64.0f) + 1e-6f);
                    bf16_t* rowp = dst + (size_t)(row0 + ai * 128 + m * 16) * 512 + cc + 8 * fq;
#pragma unroll
                    for (int bj = 0; bj < 2; ++bj) { const f32x4 y0 = acc[ai][bj][m][0] * rstd * gv[bj][0], y1 = acc[ai][bj][m][1] * rstd * gv[bj][1];
                        u32x4 w; w.x = pk2(y0[0], y0[1]); w.y = pk2(y0[2], y0[3]); w.z = pk2(y1[0], y1[1]); w.w = pk2(y1[2], y1[3]); *(u32x4*)(rowp + 32 * bj) = w; }
                }
        } else if (c0 < 1536) {
            const int h = (c0 - 1024) >> 6;
#pragma unroll
            for (int ai = 0; ai < 2; ++ai)
#pragma unroll
                for (int m = 0; m < 4; ++m) {
                    const int r = row0 + ai * 128 + m * 16;
                    bf16_t* base; size_t stride;
                    if (r < MT) { const int b = r / T, t = r % T; base = VT + ((size_t)(b * 8 + h) * 64) * T + t; stride = T; }
                    else { const int rc = r - MT, b = rc / LC, l = rc % LC; base = VTC + ((size_t)(b * 8 + h) * 64) * LC + l; stride = LC; }
#pragma unroll
                    for (int bj = 0; bj < 2; ++bj)
#pragma unroll
                        for (int n = 0; n < 2; ++n)
#pragma unroll
                            for (int e = 0; e < 4; ++e) base[(size_t)(32 * bj + 8 * fq + 4 * n + e) * stride] = f2bf(acc[ai][bj][m][n][e]);
                }
        } else {
            const int cr = c0 - 1536;
            if (cr >= RWP) return;
#pragma unroll
            for (int ai = 0; ai < 2; ++ai)
#pragma unroll
                for (int m = 0; m < 4; ++m) {
                    bf16_t* rowp = PR + (size_t)(row0 + ai * 128 + m * 16) * RWP + cr + 8 * fq;
#pragma unroll
                    for (int bj = 0; bj < 2; ++bj) { const f32x4 y0 = acc[ai][bj][m][0], y1 = acc[ai][bj][m][1];
                        u32x4 w; w.x = pk2(y0[0], y0[1]); w.y = pk2(y0[2], y0[3]); w.z = pk2(y1[0], y1[1]); w.w = pk2(y1[2], y1[3]); *(u32x4*)(rowp + 32 * bj) = w; }
                }
        }
    }
};
struct EpiRes {
    static constexpr bool PERM = false, AFTER_DRAIN = false;
    const float* base; float* out; const float* gate;
    __device__ __forceinline__ void operator()(const f32x4 (&acc)[2][2][4][2], const Unit& u, int wr, int wc, int fr, int fq) const {
        const int c0 = u.pn * 256 + wc * 64 + 4 * fq;
        const int row0 = u.pm * 256 + wr * 64 + fr;
#pragma unroll
        for (int ai = 0; ai < 2; ++ai)
#pragma unroll
            for (int m = 0; m < 4; ++m) {
                const int r = row0 + ai * 128 + m * 16; const int b = r / T;
#pragma unroll
                for (int bj = 0; bj < 2; ++bj)
#pragma unroll
                    for (int n = 0; n < 2; ++n) { const int c = c0 + 32 * bj + 16 * n;
                        const f32x4 gt = *(const f32x4*)(gate + (size_t)b * 6144 + c);
                        const f32x4 bs = *(const f32x4*)(base + (size_t)r * 1024 + c);
                        *(f32x4*)(out + (size_t)r * 1024 + c) = bs + gt * acc[ai][bj][m][n]; }
            }
    }
};
struct EpiGlu {
    static constexpr bool PERM = false, AFTER_DRAIN = false;
    bf16_t* ACT;
    __device__ __forceinline__ void operator()(const f32x4 (&acc)[2][2][4][2], const Unit& u, int wr, int wc, int fr, int fq) const {
        const int g0 = u.pn * 128 + wc * 32 + 8 * fq;
        const int row0 = u.pm * 256 + wr * 64 + fr;
#pragma unroll
        for (int ai = 0; ai < 2; ++ai)
#pragma unroll
            for (int m = 0; m < 4; ++m) {
                bf16_t* rowp = ACT + (size_t)(row0 + ai * 128 + m * 16) * DFF + g0;
                const f32x4 ga0 = acc[ai][0][m][0], up0 = acc[ai][1][m][0], ga1 = acc[ai][0][m][1], up1 = acc[ai][1][m][1];
                u32x4 w; w.x = pk2(silu_f(ga0[0]) * up0[0], silu_f(ga0[1]) * up0[1]); w.y = pk2(silu_f(ga0[2]) * up0[2], silu_f(ga0[3]) * up0[3]);
                w.z = pk2(silu_f(ga1[0]) * up1[0], silu_f(ga1[1]) * up1[1]); w.w = pk2(silu_f(ga1[2]) * up1[2], silu_f(ga1[3]) * up1[3]);
                *(u32x4*)rowp = w;
            }
    }
};

__device__ __forceinline__ void transpose_item(const float* Wk0, int K, int Nsrc, int src_col0, bf16_t* WT, int dest_row0, int k0, LAS float* scr, int lane, bool perm = false) {
    const int c = lane & 7;
    if (src_col0 < 0) {
#pragma unroll
        for (int j = 0; j < 4; ++j) { const int n = (lane >> 3) + 8 * j; *(u32x4*)(WT + (size_t)(dest_row0 + n) * K + k0 + 8 * c) = (u32x4){0u, 0u, 0u, 0u}; }
        return;
    }
#pragma unroll 8
    for (int i = 0; i < 32; ++i) { const int kk = 2 * i + (lane >> 5); scr[kk * 33 + (lane & 31)] = Wk0[(size_t)kk * Nsrc + src_col0 + (lane & 31)]; }
    asm volatile("s_waitcnt lgkmcnt(0)" ::: "memory");
#pragma unroll
    for (int j = 0; j < 4; ++j) { const int n = (lane >> 3) + 8 * j; const LAS float* s = scr + (8 * c) * 33 + (perm ? pg8::perm32(n) : n);
        u32x4 o; o.x = pk2(s[0 * 33], s[1 * 33]); o.y = pk2(s[2 * 33], s[3 * 33]); o.z = pk2(s[4 * 33], s[5 * 33]); o.w = pk2(s[6 * 33], s[7 * 33]);
        *(u32x4*)(WT + (size_t)(dest_row0 + n) * K + k0 + 8 * c) = o; }
    asm volatile("s_waitcnt lgkmcnt(0)" ::: "memory");
}
constexpr int W_EARLY = 80 * 6 + (INPP / 32) * 16, W_ALL = W_EARLY + 32 * 16 + (5632 / 32) * 16 + 32 * 44;
__device__ __forceinline__ void weight_transposes(const Params& p, LAS unsigned char* lds, int it_lo, int it_hi, int gw, int NGW) {
    const int lane = threadIdx.x & 63, wave = threadIdx.x >> 6;
    LAS float* scr = (LAS float*)(lds + 32768 + wave * 8704);
    constexpr int I_IN = (INPP / 32) * 16, I_OUT = 32 * 16, I_F1 = (5632 / 32) * 16, I_F2 = 32 * 44, I_LO = 80 * 6;
    for (int it = it_lo + gw; it < it_hi; it += NGW) {
        int r = it;
        if (r < I_LO) { const int gd = r / 6, kc = r % 6, t0 = gd * 32, pn = t0 >> 8, bj = (t0 >> 7) & 1, wc = (t0 >> 5) & 3, a0 = pn * 256 + wc * 64 + bj * 32;
            const int grp = a0 >> 9, hc0 = a0 & 511;
            const float* W = nullptr;
            if (grp < 2) { if (kc == grp) W = p.in[15] + (size_t)grp * 64 * 512; }
            else if (grp < 4) { if (kc == 2) W = p.in[17] + (size_t)(grp & 1) * 64 * 512; }
            else { if (kc == 3 || kc == 4) W = p.in[18] + (size_t)(kc - 3) * 64 * 512; }
            transpose_item(W ? W : p.in[15], 384, 512, W ? hc0 : -1, (bf16_t*)(p.ws + OFF_LORAB), t0, kc * 64, scr, lane, true); continue; }
        r -= I_LO;
        if (r < I_IN) { const int gd = r >> 4, kc = r & 15, t0 = gd * 32, pn = t0 >> 8, bj = (t0 >> 7) & 1, wc = (t0 >> 5) & 3, a0 = pn * 256 + wc * 64 + bj * 32;
            transpose_item(p.in[8] + (size_t)kc * 64 * INP, 1024, INP, a0 < INP ? a0 : -1, (bf16_t*)(p.ws + OFF_WIN), t0, kc * 64, scr, lane, true); continue; }
        r -= I_IN;
        if (r < I_OUT) { const int gd = r >> 4, kc = r & 15, t0 = gd * 32, pn = t0 >> 8, bj = (t0 >> 7) & 1, wc = (t0 >> 5) & 3, a0 = pn * 256 + wc * 64 + bj * 32;
            transpose_item(p.in[24] + (size_t)kc * 64 * 1024, 1024, 1024, a0, (bf16_t*)(p.ws + OFF_WOUT), t0, kc * 64, scr, lane); continue; }
        r -= I_OUT;
        if (r < I_F1) { const int gd = r >> 4, kc = r & 15, t0 = gd * 32, pn = t0 >> 8, bj = (t0 >> 7) & 1, wc = (t0 >> 5) & 3, src = pn * 128 + wc * 32 + bj * DFF;
            transpose_item(p.in[25] + (size_t)kc * 64 * 2 * DFF, 1024, 2 * DFF, src, (bf16_t*)(p.ws + OFF_WF1), t0, kc * 64, scr, lane, true); continue; }
        r -= I_F1;
        { const int gd = r / 44, kc = r % 44, t0 = gd * 32, pn = t0 >> 8, bj = (t0 >> 7) & 1, wc = (t0 >> 5) & 3, a0 = pn * 256 + wc * 64 + bj * 32;
            transpose_item(p.in[26] + (size_t)kc * 64 * 1024, DFF, 1024, a0, (bf16_t*)(p.ws + OFF_WF2), t0, kc * 64, scr, lane); }
    }
}


__device__ __forceinline__ void phase0(const Params& p, LAS unsigned char* lds) {
    const int tid = threadIdx.x, lane = tid & 63, wave = tid >> 6;
    const float* c = p.in[1]; const float* cctx = p.in[3]; const float* w_ada = p.in[6]; const float* b_ada = p.in[7];
    float* mod = (float*)(p.ws + OFF_MOD);
    LAS float* red = (LAS float*)lds;
    for (int cb = blockIdx.x; cb < 256; cb += gridDim.x) {
        const int ks = tid / 6, cgp = tid % 6, col = cb * 24 + cgp * 4;
        if (ks < 84) {
            f32x4 a0 = {0.f, 0.f, 0.f, 0.f}, a1 = a0, a2 = a0;
            for (int k = ks; k < 1024; k += 84) {
                const f32x4 w = *(const f32x4*)(w_ada + (size_t)k * 6144 + col);
                a0 += w * silu_f(c[k]); a1 += w * silu_f(c[1024 + k]); a2 += w * silu_f(cctx[k]);
            }
#pragma unroll
            for (int e = 0; e < 4; ++e) { red[ks * 72 + cgp * 4 + e] = a0[e]; red[ks * 72 + 24 + cgp * 4 + e] = a1[e]; red[ks * 72 + 48 + cgp * 4 + e] = a2[e]; }
        }
        __syncthreads();
        if (tid < 72) { float s = 0.f; for (int k = 0; k < 84; ++k) s += red[k * 72 + tid];
            const int r = tid / 24, cc = cb * 24 + tid % 24; mod[r * 6144 + cc] = s + b_ada[cc]; }
        __syncthreads();
    }
    { float* ident = (float*)(p.ws + OFF_IDENT); for (int idx = blockIdx.x * 512 + tid; idx < 4096; idx += gridDim.x * 512) ident[idx] = ((idx >> 6) == (idx & 63)) ? 1.0f : 0.0f; }
    weight_transposes(p, lds, 0, W_EARLY, blockIdx.x * 8 + wave, gridDim.x * 8);
}

__device__ __forceinline__ void phase_norm(const Params& p, int which) {
    const int lane = threadIdx.x & 63, wave = threadIdx.x >> 6;
    const float* mod = (const float*)(p.ws + OFF_MOD);
    const float* g = which ? p.in[5] : p.in[4];
    bf16_t* U = (bf16_t*)(p.ws + OFF_U);
    const int nrows = which ? MT : MA, shoff = which ? 3 * 1024 : 0, scoff = which ? 4 * 1024 : 1024;
    for (int row = blockIdx.x * 8 + wave; row < nrows; row += gridDim.x * 8) {
        const float* src; int mrow;
        if (which) { src = p.out + (size_t)row * 1024; mrow = row / T; }
        else if (row < MT) { src = p.in[0] + (size_t)row * 1024; mrow = row / T; }
        else { src = p.in[2] + (size_t)(row - MT) * 1024; mrow = 2; }
        f32x4 v[4]; float ss = 0.f;
#pragma unroll
        for (int j = 0; j < 4; ++j) { v[j] = ((const f32x4*)src)[lane + 64 * j]; ss += (v[j][0] * v[j][0] + v[j][1] * v[j][1]) + (v[j][2] * v[j][2] + v[j][3] * v[j][3]); }
        const float rstd = rsqrtf(wave_sum(ss) * (1.0f / 1024.0f) + 1e-6f);
#pragma unroll
        for (int j = 0; j < 4; ++j) { const int col = 4 * (lane + 64 * j);
            const f32x4 gg = *(const f32x4*)(g + col), sc = *(const f32x4*)(mod + mrow * 6144 + scoff + col), sh = *(const f32x4*)(mod + mrow * 6144 + shoff + col);
            const f32x4 y = v[j] * rstd * gg * (sc + 1.0f) + sh;
            u32x2 w; w.x = pk2(y[0], y[1]); w.y = pk2(y[2], y[3]); *(u32x2*)(U + (size_t)row * 1024 + col) = w; }
    }
}

__device__ __forceinline__ void phase_shiftprep(const Params& p) {
    const int lane = threadIdx.x & 63, wave = threadIdx.x >> 6;
    const bf16_t* PR = (const bf16_t*)(p.ws + OFF_PR); bf16_t* LA = (bf16_t*)(p.ws + OFF_LA);
    float mp[5], mn[5];
#pragma unroll
    for (int j = 0; j < 5; ++j) { mp[j] = p.in[12][1536 + lane + 64 * j]; mn[j] = p.in[13][1536 + lane + 64 * j]; }
    constexpr int NRW = 4;
    const int stride = gridDim.x * 8;
    for (int row0 = blockIdx.x * 8 + wave; row0 < MA; row0 += NRW * stride) {
        unsigned short pc[NRW][5], pp[NRW][5], pn[NRW][5]; float mpf[NRW], mnf[NRW]; bool ok[NRW];
#pragma unroll
        for (int u = 0; u < NRW; ++u) { const int rw = row0 + u * stride; ok[u] = rw < MA; const int row = ok[u] ? rw : row0;
            bool hp_, hn_;
            if (row < MT) { const int t = row % T; hp_ = t > 0; hn_ = t < T - 1; } else { const int l = (row - MT) % LC; hp_ = l > 0; hn_ = l < LC - 1; }
            const bf16_t* pr = PR + (size_t)row * RWP + 1536; const bf16_t* prp = hp_ ? pr - RWP : pr; const bf16_t* prn = hn_ ? pr + RWP : pr;
            mpf[u] = hp_ ? 1.0f : 0.0f; mnf[u] = hn_ ? 1.0f : 0.0f;
#pragma unroll
            for (int j = 0; j < 5; ++j) { const int col = lane + 64 * j; pc[u][j] = pr[col]; pp[u][j] = prp[col]; pn[u][j] = prn[col]; } }
#pragma unroll
        for (int u = 0; u < NRW; ++u) { if (!ok[u]) continue; const int row = row0 + u * stride;
#pragma unroll
            for (int j = 0; j < 5; ++j) { const int col = lane + 64 * j;
                const float c_ = bf2f(pc[u][j]), p_ = mpf[u] * bf2f(pp[u][j]), n_ = mnf[u] * bf2f(pn[u][j]);
                float v = c_ + mp[j] * (p_ - c_) + mn[j] * (n_ - c_);
                if (j < 2) v = 1.0f - 2.0f / (1.0f + __expf(2.0f * v));
                else if (j >= 3) v = sigmoid_f(v);
                LA[(size_t)row * 384 + col] = f2bf(v); }
            LA[(size_t)row * 384 + 320 + lane] = 0; }
    }
}
struct EpiLora {
    static constexpr bool PERM = false, AFTER_DRAIN = false;
    bf16_t *DEC, *AR, *MIXG; const float *w0, *a0;
    __device__ __forceinline__ void operator()(const f32x4 (&acc)[2][2][4][2], const Unit& u, int wr, int wc, int fr, int fq) const {
        const int ac = u.pn * 256 + wc * 64, grp = ac >> 9, hc0 = (ac & 511) + 8 * fq, d = grp & 1;
        const int row0 = u.pm * 256 + wr * 64 + fr;
        if (grp == 4) {
#pragma unroll
            for (int ai = 0; ai < 2; ++ai)
#pragma unroll
                for (int m = 0; m < 4; ++m) { const int r = row0 + ai * 128 + m * 16; if (r >= MT) continue;
                    bf16_t* rowp = MIXG + (size_t)r * 1024 + 512 + hc0;
#pragma unroll
                    for (int bj = 0; bj < 2; ++bj) { const f32x4 y0 = acc[ai][bj][m][0], y1 = acc[ai][bj][m][1]; u32x4 w; w.x = pk2(y0[0], y0[1]); w.y = pk2(y0[2], y0[3]); w.z = pk2(y1[0], y1[1]); w.w = pk2(y1[2], y1[3]); *(u32x4*)(rowp + 32 * bj) = w; } }
            return;
        }
        const bool isw = grp < 2;
        const float* bias = (isw ? w0 : a0) + d * 512 + hc0;
        bf16_t* dst = (isw ? DEC : AR) + d * 512 + hc0;
        f32x4 bv[2][2];
#pragma unroll
        for (int bj = 0; bj < 2; ++bj)
#pragma unroll
            for (int n = 0; n < 2; ++n) bv[bj][n] = *(const f32x4*)(bias + 32 * bj + 4 * n);
#pragma unroll
        for (int ai = 0; ai < 2; ++ai)
#pragma unroll
            for (int m = 0; m < 4; ++m) {
                bf16_t* rowp = dst + (size_t)(row0 + ai * 128 + m * 16) * 1024;
#pragma unroll
                for (int bj = 0; bj < 2; ++bj) { u32x4 w;
#pragma unroll
                    for (int n = 0; n < 2; ++n) { const f32x4 x = acc[ai][bj][m][n] + bv[bj][n]; f32x4 y;
#pragma unroll
                        for (int e = 0; e < 4; ++e) {
                            if (isw) y[e] = -0.60653066f * sigmoid_f(x[e]);
                            else y[e] = sigmoid_f(x[e]); }
                        if (n == 0) { w.x = pk2(y[0], y[1]); w.y = pk2(y[2], y[3]); } else { w.z = pk2(y[0], y[1]); w.w = pk2(y[2], y[3]); } }
                    *(u32x4*)(rowp + 32 * bj) = w;
                    asm volatile("" ::: "memory"); }
            }
    }
};
#define XB_TMO      128
#define XB_XCNT(j)  (256  + 64 * (j))
#define XB_XSUB(j)  (1280 + 64 * (j))
#define XB_XGEN(j)  (2304 + 64 * (j))
#define XB_TOP      3328
#define XB_TOPGEN   3392
#define XCD_BAR_WORDS 3456
#define XB_SPIN_CAP (1u << 18)

__device__ __forceinline__ unsigned xb_ld(unsigned* p)              { return __hip_atomic_load(p, __ATOMIC_RELAXED, __HIP_MEMORY_SCOPE_AGENT); }
__device__ __forceinline__ unsigned xb_add(unsigned* p, unsigned v) { return __hip_atomic_fetch_add(p, v, __ATOMIC_RELAXED, __HIP_MEMORY_SCOPE_AGENT); }
__device__ __forceinline__ unsigned xb_xcc_id() { return (unsigned)__builtin_amdgcn_s_getreg((3 << 11) | 20) & 0xFu; }
#define XB_SPIN(cond, bar) do { unsigned _sp = 0; while (cond) { __builtin_amdgcn_s_sleep(1); \
    if ((++_sp & 255u) == 0u) { if (xb_ld(&(bar)[XB_TMO])) break; if (_sp > XB_SPIN_CAP) { atomicAdd(&(bar)[XB_TMO], 1u); break; } } } } while (0)

struct XcdBarrier {
    unsigned* bar; unsigned x;
    volatile LAS unsigned* st;
};

__device__ __forceinline__ XcdBarrier xcd_barrier_post(unsigned* bar, volatile LAS unsigned* st) {
    XcdBarrier b; b.bar = bar; b.x = xb_xcc_id(); b.st = st;
    if (threadIdx.x == 0) (void)xb_add(&bar[XB_XCNT(b.x)], 1u);
    return b;
}
__device__ __forceinline__ void xcd_barrier_complete(unsigned* bar, unsigned x, unsigned& nloc, unsigned& nx) {
    const unsigned G = gridDim.x * gridDim.y * gridDim.z;
    unsigned sum, cnt, mine, sp = 0u;
    for (;;) {
        sum = 0u; cnt = 0u; mine = 0u;
#pragma unroll
        for (unsigned j = 0; j < 16; ++j) { const unsigned c = xb_ld(&bar[XB_XCNT(j)]); sum += c; cnt += (c > 0u) ? 1u : 0u; mine = (j == x) ? c : mine; }
        if (sum == G) break;
        __builtin_amdgcn_s_sleep(1);
        if ((++sp & 255u) == 0u) { if (xb_ld(&bar[XB_TMO])) break; if (sp > XB_SPIN_CAP) { atomicAdd(&bar[XB_TMO], 1u); break; } }
    }
    nloc = mine > 0u ? mine : 1u; nx = cnt > 0u ? cnt : 1u;
}

__device__ __forceinline__ void xcd_barrier(const XcdBarrier& b) {
    asm volatile("s_waitcnt vmcnt(0)" ::: "memory");
    __syncthreads();
    if (threadIdx.x == 0) {
        unsigned* bar = b.bar;
        __builtin_amdgcn_s_waitcnt(0);
        unsigned nloc = b.st[0], nx = b.st[1];
        if (nloc == 0u) { xcd_barrier_complete(bar, b.x, nloc, nx); b.st[0] = nloc; b.st[1] = nx; }
        const unsigned old = xb_add(&bar[XB_XSUB(b.x)], 1u);
        const unsigned gen = old / nloc;
        if (old + 1u == (gen + 1u) * nloc) {
            __builtin_amdgcn_fence(__ATOMIC_RELEASE, "agent");
            asm volatile("s_waitcnt vmcnt(0)" ::: "memory");
            const unsigned og = xb_add(&bar[XB_TOP], 1u);
            const unsigned tg = og / nx;
            if (og + 1u == (tg + 1u) * nx) xb_add(&bar[XB_TOPGEN], 1u);
            else XB_SPIN(xb_ld(&bar[XB_TOPGEN]) == tg, bar);
            __builtin_amdgcn_fence(__ATOMIC_ACQUIRE, "agent");
            xb_add(&bar[XB_XGEN(b.x)], 1u);
            asm volatile("s_waitcnt vmcnt(0)" ::: "memory");
        } else {
            XB_SPIN(xb_ld(&bar[XB_XGEN(b.x)]) == gen, bar);
            __builtin_amdgcn_fence(__ATOMIC_ACQUIRE, "agent");
            asm volatile("s_waitcnt vmcnt(0)" ::: "memory");
        }
    }
    __syncthreads();
}
constexpr int NA_KLD = 72, NA_VLD = 264;
__device__ __forceinline__ void na_task(const Params& p, int b, int h, int i, int j, int lane, const LAS bf16_t* Kc, const LAS bf16_t* VTc, const LAS float* rpb) {
    const int fr = lane & 15, fq = lane >> 4;
    const bf16_t* Q = (const bf16_t*)(p.ws + OFF_Q); const bf16_t* K = (const bf16_t*)(p.ws + OFF_K);
    const bf16_t* VT = (const bf16_t*)(p.ws + OFF_VT);
    bf16_t* MIX = (bf16_t*)(p.ws + OFF_MIX);
    const size_t qrow = (size_t)b * T + i * 64 + 16 * j + fr;
    const bf16_t* qp = Q + qrow * 512 + h * 64 + 8 * fq;
    const bf16x8 q0 = *(const bf16x8*)qp, q1 = *(const bf16x8*)(qp + 32);
    const int rs = min(max(i - 4, 0), 248);
    const int cb = (j == 0) ? 0 : (j == 1) ? 8 : (j == 2) ? 24 : 32;
    const int c = 16 * j + fr, cs = min(max(c - 8, 0), 48);
    float m_run = -INFINITY, l_run = 0.f;
    f32x4 o[4];
#pragma unroll
    for (int dt = 0; dt < 4; ++dt) o[dt] = (f32x4){0.f, 0.f, 0.f, 0.f};
    const bf16_t* vt_base = VT + ((size_t)(b * 8 + h) * 64 + fr) * T;
#pragma unroll
    for (int half = 0; half < 2; ++half) {
    const bool win = half == 0;
#pragma unroll 1
    for (int grp = 2 * half; grp < 2 * half + 2; ++grp) {
        f32x4 s[8];
#pragma unroll
        for (int kt = 0; kt < 8; ++kt) {
            int rr = 0, nt = 0; bf16x8 k0, k1;
            if (win) { rr = grp * 4 + (kt >> 1); nt = kt & 1; const size_t krow = (size_t)b * T + (rs + rr) * 64 + cb + 16 * nt + fr;
                const bf16_t* kp = K + krow * 512 + h * 64 + 8 * fq; k0 = *(const bf16x8*)kp; k1 = *(const bf16x8*)(kp + 32); }
            else { const LAS bf16_t* kp = Kc + ((grp - 2) * 128 + kt * 16 + fr) * NA_KLD + 8 * fq; k0 = *(const LAS bf16x8*)kp; k1 = *(const LAS bf16x8*)(kp + 32); }
            f32x4 a = {0.f, 0.f, 0.f, 0.f};
            a = __builtin_amdgcn_mfma_f32_16x16x32_bf16(k0, q0, a, 0, 0, 0);
            a = __builtin_amdgcn_mfma_f32_16x16x32_bf16(k1, q1, a, 0, 0, 0);
            if (win) {
                const int di = rs + rr - i + 7;
#pragma unroll
                for (int e = 0; e < 4; ++e) { const int kc = cb + 16 * nt + 4 * fq + e; const bool valid = (kc >= cs) && (kc < cs + 16);
                    const int dj = min(max(kc - c + 15, 0), 30);
                    const float bias = rpb[di * 31 + dj];
                    a[e] = valid ? a[e] + bias : -INFINITY; }
            }
            s[kt] = a;
        }
        float gmax = -INFINITY;
#pragma unroll
        for (int kt = 0; kt < 8; ++kt)
#pragma unroll
            for (int e = 0; e < 4; ++e) gmax = fmaxf(gmax, s[kt][e]);
        gmax = fmaxf(gmax, __shfl_xor(gmax, 16)); gmax = fmaxf(gmax, __shfl_xor(gmax, 32));
        const float m_new = fmaxf(m_run, gmax);
        const float alpha = __expf(m_run - m_new);
        float psum = 0.f;
#pragma unroll
        for (int kt = 0; kt < 8; ++kt)
#pragma unroll
            for (int e = 0; e < 4; ++e) { const float pv = __expf(s[kt][e] - m_new); psum += pv; s[kt][e] = pv; }
        psum += __shfl_xor(psum, 16); psum += __shfl_xor(psum, 32);
        l_run = l_run * alpha + psum; m_run = m_new;
#pragma unroll
        for (int dt = 0; dt < 4; ++dt) o[dt] *= alpha;
#pragma unroll
        for (int k2 = 0; k2 < 4; ++k2) {
            u32x4 pw; pw.x = pk2(s[2 * k2][0], s[2 * k2][1]); pw.y = pk2(s[2 * k2][2], s[2 * k2][3]); pw.z = pk2(s[2 * k2 + 1][0], s[2 * k2 + 1][1]); pw.w = pk2(s[2 * k2 + 1][2], s[2 * k2 + 1][3]);
            const bf16x8 pb = __builtin_bit_cast(bf16x8, pw);
            if (win) {
                const bf16_t* vp = vt_base + (size_t)(rs + grp * 4 + k2) * 64 + cb + 4 * fq; const size_t dstride = (size_t)16 * T;
#pragma unroll
                for (int dt = 0; dt < 4; ++dt) {
                    const u32x2 lo = *(const u32x2*)(vp + dt * dstride), hi = *(const u32x2*)(vp + dt * dstride + 16);
                    u32x4 vw; vw.x = lo.x; vw.y = lo.y; vw.z = hi.x; vw.w = hi.y;
                    o[dt] = __builtin_amdgcn_mfma_f32_16x16x32_bf16(__builtin_bit_cast(bf16x8, vw), pb, o[dt], 0, 0, 0);
                }
            } else {
                const LAS bf16_t* vp = VTc + fr * NA_VLD + (grp - 2) * 128 + k2 * 32 + 4 * fq;
#pragma unroll
                for (int dt = 0; dt < 4; ++dt) {
                    const u32x2 lo = *(const LAS u32x2*)(vp + dt * 16 * NA_VLD), hi = *(const LAS u32x2*)(vp + dt * 16 * NA_VLD + 16);
                    u32x4 vw; vw.x = lo.x; vw.y = lo.y; vw.z = hi.x; vw.w = hi.y;
                    o[dt] = __builtin_amdgcn_mfma_f32_16x16x32_bf16(__builtin_bit_cast(bf16x8, vw), pb, o[dt], 0, 0, 0);
                }
            }
        }
    }
    }
    const float inv = 1.0f / l_run;
    bf16_t* op = MIX + qrow * 1024 + h * 64 + 4 * fq;
#pragma unroll
    for (int dt = 0; dt < 4; ++dt) { const f32x4 y = o[dt] * inv; u32x2 w; w.x = pk2(y[0], y[1]); w.y = pk2(y[2], y[3]); *(u32x2*)(op + 16 * dt) = w; }
}
template <int NTL>
__device__ __forceinline__ void na_softmax_n(f32x4 (&s)[NTL], float& m_run, float& l_run, f32x4 (&o)[4]) {
    float gmax = -INFINITY;
#pragma unroll
    for (int kt = 0; kt < NTL; ++kt)
#pragma unroll
        for (int e = 0; e < 4; ++e) gmax = fmaxf(gmax, s[kt][e]);
    gmax = fmaxf(gmax, __shfl_xor(gmax, 16)); gmax = fmaxf(gmax, __shfl_xor(gmax, 32));
    const float m_new = fmaxf(m_run, gmax);
    const float alpha = __expf(m_run - m_new);
    float psum = 0.f;
#pragma unroll
    for (int kt = 0; kt < NTL; ++kt)
#pragma unroll
        for (int e = 0; e < 4; ++e) { const float pv = __expf(s[kt][e] - m_new); psum += pv; s[kt][e] = pv; }
    psum += __shfl_xor(psum, 16); psum += __shfl_xor(psum, 32);
    l_run = l_run * alpha + psum; m_run = m_new;
#pragma unroll
    for (int dt = 0; dt < 4; ++dt) o[dt] *= alpha;
}
__device__ __forceinline__ bf16x8 na_pack2(const f32x4& x, const f32x4& y) {
    u32x4 pw; pw.x = pk2(x[0], x[1]); pw.y = pk2(x[2], x[3]); pw.z = pk2(y[0], y[1]); pw.w = pk2(y[2], y[3]); return __builtin_bit_cast(bf16x8, pw);
}
__device__ __forceinline__ void na_task2(const Params& p, int b, int h, int ip, int j, int lane, const LAS bf16_t* Kc, const LAS bf16_t* VTc, const LAS float* rpb) {
    const int fr = lane & 15, fq = lane >> 4;
    const bf16_t* Q = (const bf16_t*)(p.ws + OFF_Q); const bf16_t* K = (const bf16_t*)(p.ws + OFF_K);
    const bf16_t* VT = (const bf16_t*)(p.ws + OFF_VT);
    bf16_t* MIX = (bf16_t*)(p.ws + OFF_MIX);
    const int i0 = 2 * ip;
    const int rs0 = min(max(i0 - 4, 0), 248), rs1 = min(max(i0 - 3, 0), 248);
    const int cb = (j == 0) ? 0 : (j == 1) ? 8 : (j == 2) ? 24 : 32;
    const int c = 16 * j + fr, cs = min(max(c - 8, 0), 48);
    const size_t qrow0 = (size_t)b * T + i0 * 64 + 16 * j + fr;
    bf16x8 q[2][2];
#pragma unroll
    for (int a = 0; a < 2; ++a) { const bf16_t* qp = Q + (qrow0 + a * 64) * 512 + h * 64 + 8 * fq; q[a][0] = *(const bf16x8*)qp; q[a][1] = *(const bf16x8*)(qp + 32); }
    float m_run[2] = {-INFINITY, -INFINITY}, l_run[2] = {0.f, 0.f};
    f32x4 o[2][4];
#pragma unroll
    for (int a = 0; a < 2; ++a)
#pragma unroll
        for (int dt = 0; dt < 4; ++dt) o[a][dt] = (f32x4){0.f, 0.f, 0.f, 0.f};
    const bf16_t* vt_base = VT + ((size_t)(b * 8 + h) * 64 + fr) * T;
#pragma unroll 1
    for (int g = 0; g < 2; ++g) {
        f32x4 s[2][8];
#pragma unroll
        for (int kt = 0; kt < 8; ++kt) { const LAS bf16_t* kp = Kc + (g * 128 + kt * 16 + fr) * NA_KLD + 8 * fq;
            const bf16x8 k0 = *(const LAS bf16x8*)kp, k1 = *(const LAS bf16x8*)(kp + 32);
#pragma unroll
            for (int a = 0; a < 2; ++a) { f32x4 acc = {0.f, 0.f, 0.f, 0.f};
                acc = __builtin_amdgcn_mfma_f32_16x16x32_bf16(k0, q[a][0], acc, 0, 0, 0);
                s[a][kt] = __builtin_amdgcn_mfma_f32_16x16x32_bf16(k1, q[a][1], acc, 0, 0, 0); } }
#pragma unroll
        for (int a = 0; a < 2; ++a) na_softmax_n<8>(s[a], m_run[a], l_run[a], o[a]);
#pragma unroll
        for (int k2 = 0; k2 < 4; ++k2) { const bf16x8 pb0 = na_pack2(s[0][2 * k2], s[0][2 * k2 + 1]), pb1 = na_pack2(s[1][2 * k2], s[1][2 * k2 + 1]);
            const LAS bf16_t* vp = VTc + fr * NA_VLD + g * 128 + k2 * 32 + 4 * fq;
#pragma unroll
            for (int dt = 0; dt < 4; ++dt) { const u32x2 lo = *(const LAS u32x2*)(vp + dt * 16 * NA_VLD), hi = *(const LAS u32x2*)(vp + dt * 16 * NA_VLD + 16);
                u32x4 vw; vw.x = lo.x; vw.y = lo.y; vw.z = hi.x; vw.w = hi.y; const bf16x8 vf = __builtin_bit_cast(bf16x8, vw);
                o[0][dt] = __builtin_amdgcn_mfma_f32_16x16x32_bf16(vf, pb0, o[0][dt], 0, 0, 0);
                o[1][dt] = __builtin_amdgcn_mfma_f32_16x16x32_bf16(vf, pb1, o[1][dt], 0, 0, 0); } }
    }
#pragma unroll 1
    for (int wg = 0; wg < 3; ++wg) {
        f32x4 s[2][6];
#pragma unroll
        for (int kt = 0; kt < 6; ++kt) { const int rr = 3 * wg + (kt >> 1), nt = kt & 1, kru = rs0 + rr, kr = min(kru, 255);
            const bf16_t* kp = K + ((size_t)b * T + kr * 64 + cb + 16 * nt + fr) * 512 + h * 64 + 8 * fq;
            const bf16x8 k0 = *(const bf16x8*)kp, k1 = *(const bf16x8*)(kp + 32);
#pragma unroll
            for (int a = 0; a < 2; ++a) { const int rsa = a ? rs1 : rs0;
                f32x4 acc = {0.f, 0.f, 0.f, 0.f};
                acc = __builtin_amdgcn_mfma_f32_16x16x32_bf16(k0, q[a][0], acc, 0, 0, 0);
                acc = __builtin_amdgcn_mfma_f32_16x16x32_bf16(k1, q[a][1], acc, 0, 0, 0);
                const bool rv = (kru >= rsa) && (kru < rsa + 8);
                const int di = min(max(kru - (i0 + a) + 7, 0), 14);
#pragma unroll
                for (int e = 0; e < 4; ++e) { const int kc = cb + 16 * nt + 4 * fq + e; const bool valid = rv && (kc >= cs) && (kc < cs + 16);
                    const int dj = min(max(kc - c + 15, 0), 30);
                    const float bias = rpb[di * 31 + dj];
                    acc[e] = (acc[e] + bias) + (valid ? 0.0f : -INFINITY); }
                s[a][kt] = acc; } }
#pragma unroll
        for (int a = 0; a < 2; ++a) na_softmax_n<6>(s[a], m_run[a], l_run[a], o[a]);
#pragma unroll
        for (int k2 = 0; k2 < 3; ++k2) { const bf16x8 pb0 = na_pack2(s[0][2 * k2], s[0][2 * k2 + 1]), pb1 = na_pack2(s[1][2 * k2], s[1][2 * k2 + 1]);
            const int kr = min(rs0 + 3 * wg + k2, 255);
            const bf16_t* vp = vt_base + (size_t)kr * 64 + cb + 4 * fq;
#pragma unroll
            for (int dt = 0; dt < 4; ++dt) { const u32x2 lo = *(const u32x2*)(vp + (size_t)dt * 16 * T), hi = *(const u32x2*)(vp + (size_t)dt * 16 * T + 16);
                u32x4 vw; vw.x = lo.x; vw.y = lo.y; vw.z = hi.x; vw.w = hi.y; const bf16x8 vf = __builtin_bit_cast(bf16x8, vw);
                o[0][dt] = __builtin_amdgcn_mfma_f32_16x16x32_bf16(vf, pb0, o[0][dt], 0, 0, 0);
                o[1][dt] = __builtin_amdgcn_mfma_f32_16x16x32_bf16(vf, pb1, o[1][dt], 0, 0, 0); } }
    }
#pragma unroll
    for (int a = 0; a < 2; ++a) { const float inv = 1.0f / l_run[a];
        bf16_t* op = MIX + (qrow0 + a * 64) * 1024 + h * 64 + 4 * fq;
#pragma unroll
        for (int dt = 0; dt < 4; ++dt) { const f32x4 y = o[a][dt] * inv; u32x2 w; w.x = pk2(y[0], y[1]); w.y = pk2(y[2], y[3]); *(u32x2*)(op + 16 * dt) = w; } }
}
template <int NTL>
__device__ __forceinline__ void na_expsum(f32x4 (&s)[NTL], float& l_part) {
#pragma unroll
    for (int kt = 0; kt < NTL; ++kt)
#pragma unroll
        for (int e = 0; e < 4; ++e) { const float pv = __builtin_amdgcn_exp2f(s[kt][e] * 1.44269504f - 14.4269504f); l_part += pv; s[kt][e] = pv; }
}
template <int NR>
__device__ __forceinline__ void na_taskN(const Params& p, int b, int h, int ig, int j, int lane, const LAS bf16_t* Kc, const LAS bf16_t* VTc, const LAS float* rpb) {
    constexpr int NWG = NR + 7;
    const int fr = lane & 15, fq = lane >> 4;
    const bf16_t* Q = (const bf16_t*)(p.ws + OFF_Q); const bf16_t* K = (const bf16_t*)(p.ws + OFF_K);
    const bf16_t* VT = (const bf16_t*)(p.ws + OFF_VT);
    bf16_t* MIX = (bf16_t*)(p.ws + OFF_MIX);
    const int i0 = NR * ig;
    const int rs0 = min(max(i0 - 4, 0), 248);
    const int cb = (j == 0) ? 0 : (j == 1) ? 8 : (j == 2) ? 24 : 32;
    const int c = 16 * j + fr, cs = min(max(c - 8, 0), 48);
    const size_t qrow0 = (size_t)b * T + i0 * 64 + 16 * j + fr;
    bf16x8 q[NR][2];
#pragma unroll
    for (int a = 0; a < NR; ++a) { const bf16_t* qp = Q + (qrow0 + a * 64) * 512 + h * 64 + 8 * fq; q[a][0] = *(const bf16x8*)qp; q[a][1] = *(const bf16x8*)(qp + 32); }
    float l_run[NR];
    f32x4 o[NR][4];
#pragma unroll
    for (int a = 0; a < NR; ++a) { l_run[a] = 0.f;
#pragma unroll
        for (int dt = 0; dt < 4; ++dt) o[a][dt] = (f32x4){0.f, 0.f, 0.f, 0.f}; }
    const bf16_t* vt_base = VT + ((size_t)(b * 8 + h) * 64 + fr) * T;
#pragma unroll 1
    for (int g = 0; g < 8; ++g) {
        f32x4 s[NR][2];
#pragma unroll
        for (int kt = 0; kt < 2; ++kt) { const LAS bf16_t* kp = Kc + (g * 32 + kt * 16 + fr) * NA_KLD + 8 * fq;
            const bf16x8 k0 = *(const LAS bf16x8*)kp, k1 = *(const LAS bf16x8*)(kp + 32);
#pragma unroll
            for (int a = 0; a < NR; ++a) { f32x4 acc = {0.f, 0.f, 0.f, 0.f};
                acc = __builtin_amdgcn_mfma_f32_16x16x32_bf16(k0, q[a][0], acc, 0, 0, 0);
                s[a][kt] = __builtin_amdgcn_mfma_f32_16x16x32_bf16(k1, q[a][1], acc, 0, 0, 0); } }
#pragma unroll
        for (int a = 0; a < NR; ++a) na_expsum<2>(s[a], l_run[a]);
#pragma unroll
        for (int k2 = 0; k2 < 1; ++k2) { bf16x8 pb[NR];
#pragma unroll
            for (int a = 0; a < NR; ++a) pb[a] = na_pack2(s[a][2 * k2], s[a][2 * k2 + 1]);
            const LAS bf16_t* vp = VTc + fr * NA_VLD + g * 32 + k2 * 32 + 4 * fq;
#pragma unroll
            for (int dt = 0; dt < 4; ++dt) { const u32x2 lo = *(const LAS u32x2*)(vp + dt * 16 * NA_VLD), hi = *(const LAS u32x2*)(vp + dt * 16 * NA_VLD + 16);
                u32x4 vw; vw.x = lo.x; vw.y = lo.y; vw.z = hi.x; vw.w = hi.y; const bf16x8 vf = __builtin_bit_cast(bf16x8, vw);
#pragma unroll
                for (int a = 0; a < NR; ++a) o[a][dt] = __builtin_amdgcn_mfma_f32_16x16x32_bf16(vf, pb[a], o[a][dt], 0, 0, 0); } }
    }
#pragma unroll 1
    for (int wg = 0; wg < NWG; ++wg) {
        f32x4 s[NR][2];
        const int kru = rs0 + wg, kr = min(kru, 255);
        bf16x8 kf[2][2];
#pragma unroll
        for (int nt = 0; nt < 2; ++nt) { const bf16_t* kp = K + ((size_t)b * T + kr * 64 + cb + 16 * nt + fr) * 512 + h * 64 + 8 * fq;
            kf[nt][0] = *(const bf16x8*)kp; kf[nt][1] = *(const bf16x8*)(kp + 32); }
        bool rv[NR];
#pragma unroll
        for (int a = 0; a < NR; ++a) { const int rsa = min(max(i0 + a - 4, 0), 248); rv[a] = (kru >= rsa) && (kru < rsa + 8);
            if (rv[a]) {
                const int di = min(max(kru - (i0 + a) + 7, 0), 14);
#pragma unroll
                for (int nt = 0; nt < 2; ++nt) { f32x4 acc = {0.f, 0.f, 0.f, 0.f};
                    acc = __builtin_amdgcn_mfma_f32_16x16x32_bf16(kf[nt][0], q[a][0], acc, 0, 0, 0);
                    acc = __builtin_amdgcn_mfma_f32_16x16x32_bf16(kf[nt][1], q[a][1], acc, 0, 0, 0);
#pragma unroll
                    for (int e = 0; e < 4; ++e) { const int kc = cb + 16 * nt + 4 * fq + e; const bool valid = (kc >= cs) && (kc < cs + 16);
                        const int dj = min(max(kc - c + 15, 0), 30);
                        const float bias = rpb[di * 31 + dj];
                        acc[e] = (acc[e] + bias) + (valid ? 0.0f : -INFINITY); }
                    s[a][nt] = acc; }
                na_expsum<2>(s[a], l_run[a]);
            } else { s[a][0] = (f32x4){0.f, 0.f, 0.f, 0.f}; s[a][1] = (f32x4){0.f, 0.f, 0.f, 0.f}; } }
        bf16x8 pb[NR];
#pragma unroll
        for (int a = 0; a < NR; ++a) pb[a] = na_pack2(s[a][0], s[a][1]);
        const bf16_t* vp = vt_base + (size_t)kr * 64 + cb + 4 * fq;
#pragma unroll
        for (int dt = 0; dt < 4; ++dt) { const u32x2 lo = *(const u32x2*)(vp + (size_t)dt * 16 * T), hi = *(const u32x2*)(vp + (size_t)dt * 16 * T + 16);
            u32x4 vw; vw.x = lo.x; vw.y = lo.y; vw.z = hi.x; vw.w = hi.y; const bf16x8 vf = __builtin_bit_cast(bf16x8, vw);
#pragma unroll
            for (int a = 0; a < NR; ++a) if (rv[a]) o[a][dt] = __builtin_amdgcn_mfma_f32_16x16x32_bf16(vf, pb[a], o[a][dt], 0, 0, 0); }
    }
#pragma unroll
    for (int a = 0; a < NR; ++a) { float lt = l_run[a]; lt += __shfl_xor(lt, 16); lt += __shfl_xor(lt, 32); const float inv = 1.0f / lt;
        bf16_t* op = MIX + (qrow0 + a * 64) * 1024 + h * 64 + 4 * fq;
#pragma unroll
        for (int dt = 0; dt < 4; ++dt) { const f32x4 y = o[a][dt] * inv; u32x2 w; w.x = pk2(y[0], y[1]); w.y = pk2(y[2], y[3]); *(u32x2*)(op + 16 * dt) = w; } }
}
__device__ __forceinline__ void phase_na(const Params& p, LAS unsigned char* lds, int blk, int nblk) {
    const int tid = threadIdx.x, lane = tid & 63, wave = tid >> 6;
    const int bh = blk & 15, sub = blk >> 4, nsub = (nblk - bh + 15) >> 4, b = bh >> 3, h = bh & 7;
    LAS bf16_t* Kc = (LAS bf16_t*)lds; LAS bf16_t* VTc = Kc + 256 * NA_KLD;
    const bf16_t* K = (const bf16_t*)(p.ws + OFF_K); const bf16_t* VTC = (const bf16_t*)(p.ws + OFF_VTC);
    for (int idx = tid; idx < 256 * 8; idx += 512) { const int l = idx >> 3, c8 = idx & 7;
        *(LAS u32x4*)(Kc + l * NA_KLD + 8 * c8) = *(const u32x4*)(K + ((size_t)MT + b * LC + l) * 512 + h * 64 + 8 * c8); }
    for (int idx = tid; idx < 64 * 32; idx += 512) { const int dd = idx >> 5, c8 = idx & 31;
        *(LAS u32x4*)(VTc + dd * NA_VLD + 8 * c8) = *(const u32x4*)(VTC + ((size_t)(b * 8 + h) * 64 + dd) * LC + 8 * c8); }
    LAS float* rpbl = (LAS float*)(VTc + 64 * NA_VLD);
    for (int idx = tid; idx < 15 * 31; idx += 512) rpbl[idx] = p.in[11][h * 15 * 31 + idx];
    __syncthreads();
    for (int wt = sub * 8 + wave; wt < 256; wt += nsub * 8) na_taskN<4>(p, b, h, wt >> 2, wt & 3, lane, Kc, VTc, rpbl);
}

typedef float f32x16 __attribute__((ext_vector_type(16)));
typedef float f32x2 __attribute__((ext_vector_type(2)));
constexpr int SC = 2;
constexpr int CL = 260;
__device__ __forceinline__ void chunk_pos(int b, int d, int q, int i, int& row, bool& hasp, bool& hasn, int& t) {
    const int s = q * CL + i;
    if (s < LC) { const int l = d ? (LC - 1 - s) : s; row = MT + b * LC + l; hasp = l > 0; hasn = l < LC - 1; t = -1; }
    else { const int off = s - LC; t = d ? (T - 1 - off) : off; row = b * T + t; hasp = t > 0; hasn = t < T - 1; }
}
__device__ __forceinline__ void prep_consts(const Params& p, int h, int lane, LAS float* cst) {
    const int hc = h * 64 + lane;
    cst[lane] = p.in[12][hc]; cst[64 + lane] = p.in[13][hc]; cst[128 + lane] = p.in[12][512 + hc]; cst[192 + lane] = p.in[13][512 + hc];
    cst[256 + lane] = p.in[12][1024 + hc]; cst[320 + lane] = p.in[13][1024 + hc];
    cst[384 + lane] = p.in[19][hc]; cst[448 + lane] = p.in[20][hc]; cst[512 + lane] = p.in[21][hc];
}
typedef unsigned short us2 __attribute__((ext_vector_type(2)));
struct RawTok { us2 rk, vd, pa, pb, nn, vn_ar; };
__device__ __forceinline__ RawTok prep_load(const bf16_t* PR, const bf16_t* DEC, const bf16_t* AR, int row, bool hp, bool hn, int hc, int dcol) {
    const bf16_t* pr = PR + (size_t)row * RWP;
    const bf16_t* prp = hp ? pr - RWP : pr; const bf16_t* prn = hn ? pr + RWP : pr;
    RawTok x;
    x.rk = (us2){pr[hc], pr[512 + hc]}; x.vd = (us2){pr[1024 + hc], (DEC + (size_t)row * 1024)[dcol]};
    x.pa = (us2){prp[hc], prp[512 + hc]}; x.pb = (us2){prp[1024 + hc], prn[hc]};
    x.nn = (us2){prn[512 + hc], prn[1024 + hc]}; x.vn_ar = (us2){(AR + (size_t)row * 1024)[dcol], (unsigned short)0};
    return x;
}
__device__ __forceinline__ void prep_compute(const RawTok& x, bool hp, bool hn, const LAS float* cst, LAS float* o, int lane) {
    const float mp_ = hp ? 1.0f : 0.0f, mn_ = hn ? 1.0f : 0.0f;
    const float rc = bf2f(x.rk[0]), kc = bf2f(x.rk[1]), vc = bf2f(x.vd[0]);
    const float rp = mp_ * bf2f(x.pa[0]), kp = mp_ * bf2f(x.pa[1]), vp = mp_ * bf2f(x.pb[0]);
    const float rn = mn_ * bf2f(x.pb[1]), kn = mn_ * bf2f(x.nn[0]), vn = mn_ * bf2f(x.nn[1]);
    const float r = rc + cst[lane] * (rp - rc) + cst[64 + lane] * (rn - rc);
    const float k = kc + cst[128 + lane] * (kp - kc) + cst[192 + lane] * (kn - kc);
    const float v = vc + cst[256 + lane] * (vp - vc) + cst[320 + lane] * (vn - vc);
    const float w = __expf(bf2f(x.vd[1]));
    const float a = bf2f(x.vn_ar[0]);
    const float kkr = k * cst[384 + lane];
    const float ss = wave_sum(kkr * kkr);
    const float kk = kkr * __builtin_amdgcn_rsqf(fmaxf(ss, 1e-24f));
    const float kd = k * (1.0f + (a - 1.0f) * cst[448 + lane]);
    o[lane] = w; o[64 + lane] = -kk; o[128 + lane] = kk * a; o[192 + lane] = kd; o[256 + lane] = r; o[320 + lane] = v;
}
#define LO2(x) ((f32x2){(x)[0], (x)[1]})
#define HI2(x) ((f32x2){(x)[2], (x)[3]})
template <int MODE>
__device__ __forceinline__ float rec_step(f32x2 (&s)[32], f32x2 (&pm)[32], const LAS float* o, int lane, float& zout) {
    constexpr int GA = 2;
    constexpr int GU = 1;
    const float vv = o[320 + lane];
    f32x2 sacc0 = {0.f, 0.f}, sacc1 = {0.f, 0.f}, pacc0 = {0.f, 0.f}, pacc1 = {0.f, 0.f};
    f32x4 abuf[2][GA];
#pragma unroll
    for (int i = 0; i < GA; ++i) abuf[0][i] = *(const LAS f32x4*)(o + 64 + 4 * i);
    f32x4 wb[2][GU], bb[2][GU], kb[2][GU], rb[2][GU];
#pragma unroll
    for (int gg = 0; gg < 16 / GA; ++gg) {
        if (gg < 16 / GA - 1) {
#pragma unroll
            for (int i = 0; i < GA; ++i) abuf[(gg + 1) & 1][i] = *(const LAS f32x4*)(o + 64 + 4 * GA * (gg + 1) + 4 * i);
        } else {
#pragma unroll
            for (int i = 0; i < GU; ++i) { wb[0][i] = *(const LAS f32x4*)(o + 4 * i); bb[0][i] = *(const LAS f32x4*)(o + 128 + 4 * i); kb[0][i] = *(const LAS f32x4*)(o + 192 + 4 * i);
                if (MODE != 0) rb[0][i] = *(const LAS f32x4*)(o + 256 + 4 * i); }
        }
        ;
#pragma unroll
        for (int i = 0; i < GA; ++i) { const int g = GA * gg + i; const f32x4 a4 = abuf[gg & 1][i];
            sacc0 += s[2 * g] * LO2(a4); sacc1 += s[2 * g + 1] * HI2(a4);
            if (MODE != 1) { pacc0 += pm[2 * g] * LO2(a4); pacc1 += pm[2 * g + 1] * HI2(a4); } }
        ;
    }
    const f32x2 sacc = sacc0 + sacc1, pacc = pacc0 + pacc1;
    const float sa = sacc.x + sacc.y, pa = pacc.x + pacc.y;
    const f32x2 sa2 = {sa, sa}, pa2 = {pa, pa}, vv2 = {vv, vv};
    f32x2 yacc0 = {0.f, 0.f}, yacc1 = {0.f, 0.f}, zacc0 = {0.f, 0.f}, zacc1 = {0.f, 0.f};
#pragma unroll
    for (int gg = 0; gg < 16 / GU; ++gg) {
        if (gg < 16 / GU - 1) {
#pragma unroll
            for (int i = 0; i < GU; ++i) { const int g = GU * (gg + 1) + i; wb[(gg + 1) & 1][i] = *(const LAS f32x4*)(o + 4 * g); bb[(gg + 1) & 1][i] = *(const LAS f32x4*)(o + 128 + 4 * g);
                kb[(gg + 1) & 1][i] = *(const LAS f32x4*)(o + 192 + 4 * g); if (MODE != 0) rb[(gg + 1) & 1][i] = *(const LAS f32x4*)(o + 256 + 4 * g); }
        }
        ;
#pragma unroll
        for (int i = 0; i < GU; ++i) { const int g = GU * gg + i; const f32x4 w4 = wb[gg & 1][i], b4 = bb[gg & 1][i], k4 = kb[gg & 1][i];
            s[2 * g] = s[2 * g] * LO2(w4) + sa2 * LO2(b4) + vv2 * LO2(k4);
            s[2 * g + 1] = s[2 * g + 1] * HI2(w4) + sa2 * HI2(b4) + vv2 * HI2(k4);
            if (MODE != 1) { pm[2 * g] = pm[2 * g] * LO2(w4) + pa2 * LO2(b4); pm[2 * g + 1] = pm[2 * g + 1] * HI2(w4) + pa2 * HI2(b4); }
            if (MODE != 0) { const f32x4 r4 = rb[gg & 1][i]; yacc0 += s[2 * g] * LO2(r4); yacc1 += s[2 * g + 1] * HI2(r4);
                if (MODE == 2) { zacc0 += pm[2 * g] * LO2(r4); zacc1 += pm[2 * g + 1] * HI2(r4); } } }
        ;
    }
    const f32x2 yacc = yacc0 + yacc1, zacc = zacc0 + zacc1;
    zout = zacc.x + zacc.y;
    return yacc.x + yacc.y;
}
template <bool DO_PREP = true, bool DO_REC = true, bool DUMMY = false>
__device__ __forceinline__ void phase_pass1(const Params& p, LAS unsigned char* lds) {
    const int lane = threadIdx.x & 63, wave = __builtin_amdgcn_readfirstlane(threadIdx.x >> 6);
    const bf16_t* PR = (const bf16_t*)(p.ws + OFF_PR); const bf16_t* DEC = (const bf16_t*)(p.ws + OFF_DEC); const bf16_t* AR = (const bf16_t*)(p.ws + OFF_AR);
    LAS float* stg = (LAS float*)lds + wave * (SC * 384);
    LAS float* cst = (LAS float*)lds + 8 * (SC * 384) + wave * 576;
    for (int tk = blockIdx.x; tk < 256; tk += gridDim.x) {
        const int b = tk >> 7, d = (tk >> 6) & 1, q = tk & 63, h = wave, ch = (b * 8 + h) * 2 + d;
        prep_consts(p, h, lane, cst);
        const int hc = h * 64 + lane, dcol = d * 512 + hc;
        bf16_t* YL = (bf16_t*)p.out + (size_t)d * MT * 512;
        bf16_t* ZZ = (bf16_t*)(p.ws + OFF_Q) + (size_t)d * MT * 512;
        f32x2 s[32], pm[32];
#pragma unroll
        for (int i = 0; i < 32; i += 2) { const f32x4 x = *(const f32x4*)((const float*)(p.ws + OFF_IDENT) + lane * 64 + 2 * i);
            s[i] = (f32x2){0.f, 0.f}; s[i + 1] = (f32x2){0.f, 0.f}; pm[i] = (f32x2){x[0], x[1]}; pm[i + 1] = (f32x2){x[2], x[3]}; }
        RawTok raw[SC];
#pragma unroll
        for (int j = 0; j < SC; ++j) { int row, t; bool hp_, hn_; chunk_pos(b, d, q, j, row, hp_, hn_, t); raw[j] = prep_load(PR, DEC, AR, row, hp_, hn_, hc, dcol); }
#pragma unroll 1
        for (int it = 0; it < CL / SC; ++it) {
            int row0 = 0, t0 = 0;
            { int hr_, ht_; bool x1, x2; chunk_pos(b, d, q, it * SC, hr_, x1, x2, ht_); row0 = hr_; t0 = ht_; }
            if (DO_PREP) {
#pragma unroll
                for (int j = 0; j < SC; ++j) { int row, t; bool hp_, hn_; chunk_pos(b, d, q, it * SC + j, row, hp_, hn_, t); prep_compute(raw[j], hp_, hn_, cst, stg + j * 384, lane); asm volatile("" ::: "memory"); }
                const int itn = min(it + 1, CL / SC - 1);
#pragma unroll
                for (int j = 0; j < SC; ++j) { int row, t; bool hp_, hn_; chunk_pos(b, d, q, itn * SC + j, row, hp_, hn_, t); raw[j] = prep_load(PR, DEC, AR, row, hp_, hn_, hc, dcol); }
            }
            if (DO_REC) {
                const bool latent = t0 >= 0 && !DUMMY;
                int rowc = row0; const int rstep = d ? -1 : 1;
#pragma unroll 1
                for (int st = 0; st < SC; ++st) { float z; const float y = rec_step<2>(s, pm, stg + st * 384, lane, z);
                    if (latent) { (YL + (size_t)rowc * 512)[hc] = f2bf(y); (ZZ + (size_t)rowc * 512)[hc] = f2bf(z); } rowc += rstep; }
            }
        }
        float* hp = p.out + (DUMMY ? 0 : (size_t)MT * 512) + ((size_t)(ch * 64 + q) * 2) * 4096 + lane * 64;
        if (!DUMMY) {
#pragma unroll
        for (int i = 0; i < 32; i += 2) { *(f32x4*)(hp + 2 * i) = (f32x4){s[i].x, s[i].y, s[i + 1].x, s[i + 1].y}; *(f32x4*)(hp + 4096 + 2 * i) = (f32x4){pm[i].x, pm[i].y, pm[i + 1].x, pm[i + 1].y}; }
        }
    }
}
__device__ __forceinline__ void phase_pass2(const Params& p, LAS unsigned char* lds, int ch, int mt) {
    constexpr int LDP = 68;
    LAS float* Sl = (LAS float*)lds; LAS float* Pl = Sl + 16 * LDP;
    const int tid = threadIdx.x, lane = tid & 63, w = tid >> 6, fr = lane & 15, fq = lane >> 4;
    const float* HP = p.out + (size_t)MT * 512 + (size_t)ch * 64 * 8192;
    float* SST = (float*)(p.ws + OFF_SST) + (size_t)ch * 65 * 4096;
    for (int idx = tid; idx < 16 * LDP; idx += 512) Sl[idx] = 0.f;
    for (int idx = tid; idx < 1024; idx += 512) SST[mt * 1024 + idx] = 0.f;
    const int pidx = tid * 8, pj = pidx >> 6, pk = pidx & 63;
    f32x4 px0 = *(const f32x4*)(HP + 4096 + pidx), px1 = *(const f32x4*)(HP + 4096 + pidx + 4);
    f32x4 hx = {0.f, 0.f, 0.f, 0.f};
    if (w < 4) {
#pragma unroll
        for (int e = 0; e < 4; ++e) hx[e] = HP[(16 * mt + 4 * fq + e) * 64 + 16 * w + fr];
    }
#pragma unroll 1
    for (int q = 0; q < 63; ++q) {
        *(LAS f32x4*)(Pl + pj * LDP + pk) = px0; *(LAS f32x4*)(Pl + pj * LDP + pk + 4) = px1;
        f32x4 acc = hx;
        const float* Hn = HP + (size_t)min(q + 1, 62) * 8192;
        px0 = *(const f32x4*)(Hn + 4096 + pidx); px1 = *(const f32x4*)(Hn + 4096 + pidx + 4);
        if (w < 4) {
#pragma unroll
            for (int e = 0; e < 4; ++e) hx[e] = Hn[(16 * mt + 4 * fq + e) * 64 + 16 * w + fr];
        }
        __syncthreads();
        if (w < 4) {
#pragma unroll
            for (int ks = 0; ks < 16; ++ks) {
                const float a = Sl[fr * LDP + 4 * ks + fq];
                const float b0 = Pl[(4 * ks + fq) * LDP + 16 * w + fr];
                acc = __builtin_amdgcn_mfma_f32_16x16x4f32(a, b0, acc, 0, 0, 0);
            }
        }
        __syncthreads();
        if (w < 4) {
#pragma unroll
            for (int e = 0; e < 4; ++e) { const int vl = 4 * fq + e, k = 16 * w + fr; Sl[vl * LDP + k] = acc[e]; SST[(size_t)(q + 1) * 4096 + (16 * mt + vl) * 64 + k] = acc[e]; }
        }
    }
}
struct FinRaw { us2 z, yl, gv, rk, pa, pb, nn, aa; };
__device__ __forceinline__ FinRaw fin_load(const bf16_t* PR, const bf16_t* AR, const bf16_t* MIX, const bf16_t* YL0, const bf16_t* Z0, int b, int t, int c) {
    const int row = b * T + t;
    const bf16_t* pr = PR + (size_t)row * RWP; const bf16_t* prp = t > 0 ? pr - RWP : pr; const bf16_t* prn = t < T - 1 ? pr + RWP : pr;
    const bf16_t* z0 = Z0 + (size_t)row * 512; const bf16_t* z1 = z0 + (size_t)MT * 512;
    const bf16_t* y0 = YL0 + (size_t)row * 512; const bf16_t* y1 = y0 + (size_t)MT * 512;
    const bf16_t* ar = AR + (size_t)row * 1024;
    FinRaw x;
    x.z = (us2){z0[c], z1[c]}; x.yl = (us2){y0[c], y1[c]}; x.gv = (us2){(MIX + (size_t)row * 1024 + 512)[c], pr[1024 + c]};
    x.rk = (us2){pr[c], pr[512 + c]}; x.pa = (us2){prp[c], prp[512 + c]}; x.pb = (us2){prp[1024 + c], prn[c]};
    x.nn = (us2){prn[512 + c], prn[1024 + c]}; x.aa = (us2){ar[c], ar[512 + c]};
    return x;
}
__device__ __forceinline__ void phase_fixfinish(const Params& p, LAS unsigned char* lds) {
    const int tid = threadIdx.x, lane = tid & 63, wave = __builtin_amdgcn_readfirstlane(tid >> 6);
    const bf16_t* PR = (const bf16_t*)(p.ws + OFF_PR); const bf16_t* AR = (const bf16_t*)(p.ws + OFF_AR);
    bf16_t* MIX = (bf16_t*)(p.ws + OFF_MIX);
    const float* mup = p.in[12]; const float* mun = p.in[13];
    const int h = wave, c = h * 64 + lane;
    const float lng = p.in[22][c], lnb = p.in[23][c];
    const float mpv = mup[1024 + c], mnv = mun[1024 + c], mpr = mup[c], mnr = mun[c], mpk = mup[512 + c], mnk = mun[512 + c], kac = p.in[20][c], rkc = p.in[21][c];
    const bf16_t* YL0 = (const bf16_t*)p.out; const bf16_t* Z0 = (const bf16_t*)(p.ws + OFF_Q);
    const float* SSTb = (const float*)(p.ws + OFF_SST);
    LAS float* zb = (LAS float*)lds + wave * 128;
    constexpr int NT = 2;
    for (int tk = blockIdx.x; tk < 256; tk += gridDim.x) {
        const int b = tk >> 7, m = tk & 127;
        const float* S0base = SSTb + (size_t)((b * 8 + h) * 2 + 0) * 65 * 4096 + lane * 64;
        const float* S1base = SSTb + (size_t)((b * 8 + h) * 2 + 1) * 65 * 4096 + lane * 64;
        f32x2 s0[32], s1[32]; int q0c = -1, q1c = -1;
        FinRaw fr[NT];
#pragma unroll
        for (int j = 0; j < NT; ++j) fr[j] = fin_load(PR, AR, MIX, YL0, Z0, b, m * 128 + j, c);
#pragma unroll 1
        for (int tl0 = 0; tl0 < 128; tl0 += NT) {
            FinRaw cur[NT];
#pragma unroll
            for (int j = 0; j < NT; ++j) cur[j] = fr[j];
            const int tn0 = m * 128 + min(tl0 + NT, 128 - NT);
#pragma unroll
            for (int j = 0; j < NT; ++j) fr[j] = fin_load(PR, AR, MIX, YL0, Z0, b, tn0 + j, c);
#pragma unroll
            for (int j = 0; j < NT; ++j) {
                const int t = m * 128 + tl0 + j, row = b * T + t;
                const int q0 = (LC + t) / CL, q1 = (LC + T - 1 - t) / CL;
                if (q0 != q0c) { q0c = q0; const float* sp = S0base + (size_t)q0 * 4096;
#pragma unroll
                    for (int i = 0; i < 32; i += 2) { const f32x4 x = *(const f32x4*)(sp + 2 * i); s0[i] = (f32x2){x[0], x[1]}; s0[i + 1] = (f32x2){x[2], x[3]}; } }
                if (q1 != q1c) { q1c = q1; const float* sp = S1base + (size_t)q1 * 4096;
#pragma unroll
                    for (int i = 0; i < 32; i += 2) { const f32x4 x = *(const f32x4*)(sp + 2 * i); s1[i] = (f32x2){x[0], x[1]}; s1[i + 1] = (f32x2){x[2], x[3]}; } }
                const FinRaw& x = cur[j];
                zb[lane] = bf2f(x.z[0]); zb[64 + lane] = bf2f(x.z[1]);
                float w = bf2f(x.yl[0]) + bf2f(x.yl[1]);
                const float gte = bf2f(x.gv[0]);
                const float mp_ = t > 0 ? 1.0f : 0.0f, mn_ = t < T - 1 ? 1.0f : 0.0f;
                const float vc = bf2f(x.gv[1]), rc = bf2f(x.rk[0]), kc = bf2f(x.rk[1]);
                const float rp = mp_ * bf2f(x.pa[0]), kp = mp_ * bf2f(x.pa[1]), vp = mp_ * bf2f(x.pb[0]);
                const float rn = mn_ * bf2f(x.pb[1]), kn = mn_ * bf2f(x.nn[0]), vn = mn_ * bf2f(x.nn[1]);
                const float a0 = bf2f(x.aa[0]), a1 = bf2f(x.aa[1]);
                f32x2 acc0 = {0.f, 0.f}, acc1 = {0.f, 0.f};
#pragma unroll
                for (int g = 0; g < 16; ++g) { const f32x4 za = *(const LAS f32x4*)(zb + 4 * g), zc = *(const LAS f32x4*)(zb + 64 + 4 * g);
                    acc0 += s0[2 * g] * LO2(za); acc0 += s0[2 * g + 1] * HI2(za); acc1 += s1[2 * g] * LO2(zc); acc1 += s1[2 * g + 1] * HI2(zc); }
                const f32x2 acc = acc0 + acc1; w += acc.x + acc.y;
                const float mu = wave_sum(w) * (1.0f / 64.0f);
                const float dv = w - mu;
                const float var = wave_sum(dv * dv) * (1.0f / 64.0f);
                float y = dv * rsqrtf(var + 64e-5f) * lng + lnb;
                const float vs = vc + mpv * (vp - vc) + mnv * (vn - vc);
                const float rs = rc + mpr * (rp - rc) + mnr * (rn - rc);
                const float ks = kc + mpk * (kp - kc) + mnk * (kn - kc);
                const float bon = wave_sum(rs * ks * rkc * (2.0f + (a0 + a1 - 2.0f) * kac));
                y = (y + bon * vs) * gte;
                MIX[(size_t)row * 1024 + 512 + c] = f2bf(y);
            }
        }
    }
}

__global__ void __launch_bounds__(512) mega(Params p) {
    extern __shared__ __attribute__((aligned(16))) unsigned char shm[];
    LAS unsigned char* lds = (LAS unsigned char*)shm;
    cg::grid_group grid = cg::this_grid();
    __shared__ unsigned xb_words[4];
    if (threadIdx.x < 4) xb_words[threadIdx.x] = 0u;
    __syncthreads();
    if (blockIdx.x == 0) { unsigned* bw = (unsigned*)(p.ws + OFF_BAR); for (int i = threadIdx.x; i < XCD_BAR_WORDS; i += 512) bw[i] = 0u; }
    XcdBarrier xb; xb.bar = (unsigned*)(p.ws + OFF_BAR); xb.x = 0u; xb.st = (volatile LAS unsigned*)xb_words;
    const float* mod = (const float*)(p.ws + OFF_MOD);
#ifndef PHMASK
#define PHMASK 0x1fff
#endif
#ifndef REPMASK
#define REPMASK 0
#endif
#define HAS(x) ((PHMASK >> (x)) & 1)
#define RUN(k) (HAS(k) && p.ph_lo <= (k) && (k) < p.ph_hi)
#define SYNC(k) do { if (p.ph_lo <= (k) && (k) + 1 < p.ph_hi) { if ((k) == 0) grid.sync(); else xcd_barrier(xb); } } while (0)
#define PHASE(k, ...) do { if (RUN(k)) { __VA_ARGS__; if ((REPMASK >> (k)) & 1) { xcd_barrier(xb); __VA_ARGS__; } } SYNC(k); } while (0)
#define GEMM_PH_W(EPI, Aoff, Boff, M_, N_, K_, LD_, THR_, KOFF_, ...) { int kk_ = (K_); asm volatile("" : "+s"(kk_)); pg8::Gemm g{(const bf16_t*)(p.ws + (Aoff)), (const bf16_t*)(p.ws + (Boff)), (M_), (N_), kk_, (LD_), (THR_), (KOFF_)}; \
        pg8::StaticOrder S; S.init((M_), (N_), (int)gridDim.x, (int)blockIdx.x); EPI E{__VA_ARGS__}; pg8::gemm_phase<EPI, pg8::StaticOrder, false>(lds, g, S, E, nullptr); }
#define GEMM_PH(EPI, Aoff, Boff, M_, N_, K_, ...) { int kk_ = (K_); asm volatile("" : "+s"(kk_)); pg8::Gemm g{(const bf16_t*)(p.ws + (Aoff)), (const bf16_t*)(p.ws + (Boff)), (M_), (N_), kk_}; \
        pg8::StaticOrder S; S.init((M_), (N_), (int)gridDim.x, (int)blockIdx.x); EPI E{__VA_ARGS__}; pg8::gemm_phase<EPI, pg8::StaticOrder, false>(lds, g, S, E, nullptr); }
    PHASE(0, phase0(p, lds));
    xb = xcd_barrier_post((unsigned*)(p.ws + OFF_BAR), (volatile LAS unsigned*)xb_words);
    PHASE(1, phase_norm(p, 0));
    PHASE(2, GEMM_PH(EpiIn, OFF_U, OFF_WIN, MA, INPP, 1024, (bf16_t*)(p.ws + OFF_Q), (bf16_t*)(p.ws + OFF_K), (bf16_t*)(p.ws + OFF_VT), (bf16_t*)(p.ws + OFF_VTC), (bf16_t*)(p.ws + OFF_PR), p.in[9], p.in[10]));
    PHASE(3, phase_shiftprep(p); phase_na(p, lds, (int)blockIdx.x, (int)gridDim.x));
    PHASE(4, GEMM_PH_W(EpiLora, OFF_LA, OFF_LORAB, MA, 2560, 256, 384, 8, 128, (bf16_t*)(p.ws + OFF_DEC), (bf16_t*)(p.ws + OFF_AR), (bf16_t*)(p.ws + OFF_MIX), p.in[14], p.in[16]));
    PHASE(6, phase_pass1(p, lds));
    PHASE(7, if ((int)gridDim.x > NCHAIN * 4 && (int)blockIdx.x >= NCHAIN * 4) weight_transposes(p, lds, W_EARLY, W_ALL, ((int)blockIdx.x - NCHAIN * 4) * 8 + (int)(threadIdx.x >> 6), ((int)gridDim.x - NCHAIN * 4) * 8);
             else { for (int it_ = blockIdx.x; it_ < NCHAIN * 4; it_ += ((int)gridDim.x > NCHAIN * 4 ? NCHAIN * 4 : (int)gridDim.x)) phase_pass2(p, lds, it_ >> 2, it_ & 3);
                    if ((int)gridDim.x <= NCHAIN * 4) weight_transposes(p, lds, W_EARLY, W_ALL, (int)blockIdx.x * 8 + (int)(threadIdx.x >> 6), (int)gridDim.x * 8); });
    PHASE(8, phase_fixfinish(p, lds));
    PHASE(9, GEMM_PH(EpiRes, OFF_MIX, OFF_WOUT, MT, 1024, 1024, p.in[0], p.out, mod + 2 * 1024));
    PHASE(10, phase_norm(p, 1));
    PHASE(11, GEMM_PH(EpiGlu, OFF_U, OFF_WF1, MT, 2 * DFF, 1024, (bf16_t*)(p.ws + OFF_ACT)));
    PHASE(12, GEMM_PH(EpiRes, OFF_ACT, OFF_WF2, MT, 1024, DFF, p.out, p.out, mod + 5 * 1024));
}

extern "C" void kernel_launch(void* const* d_in, const int* in_sizes, int n_in, void* d_out, int out_size, void* d_ws, size_t ws_size, hipStream_t stream) {
    static int grid = 0;
    if (!grid) {
        int dev = 0, cus = 0, per_cu = 0;
        (void)hipGetDevice(&dev);
        (void)hipDeviceGetAttribute(&cus, hipDeviceAttributeMultiprocessorCount, dev);
        (void)hipFuncSetAttribute((const void*)mega, hipFuncAttributeMaxDynamicSharedMemorySize, LDS_BYTES);
        if (hipOccupancyMaxActiveBlocksPerMultiprocessor(&per_cu, (const void*)mega, 512, LDS_BYTES) != hipSuccess || per_cu < 1) { (void)hipGetLastError(); per_cu = 1; }
        grid = cus * per_cu;
        if (ws_size < OFF_END) fprintf(stderr, "kernel_launch: workspace too small: %zu < %zu\n", ws_size, (size_t)OFF_END);
    }
    Params p{};
    for (int i = 0; i < 27; ++i) p.in[i] = (const float*)d_in[i];
    p.out = (float*)d_out; p.ws = (unsigned char*)d_ws; p.ph_lo = 0; p.ph_hi = 13;
    void* args[] = {&p};
    hipError_t e = hipLaunchCooperativeKernel((const void*)mega, dim3(grid), dim3(512), args, LDS_BYTES, stream);
    if (e != hipSuccess) fprintf(stderr, "cooperative launch failed: %s (grid %d)\n", hipGetErrorString(e), grid);
}
```

```cpp
#include <hip/hip_runtime.h>
#include <hip/hip_cooperative_groups.h>
#include <cstdio>
namespace cg = cooperative_groups;
namespace pg8 {
#define PG8_LAS __attribute__((address_space(3)))
typedef unsigned short bf16_t;
typedef short bf16x8 __attribute__((ext_vector_type(8)));
typedef float f32x4 __attribute__((ext_vector_type(4)));
typedef unsigned u32x4 __attribute__((ext_vector_type(4)));
constexpr int BM = 256, BK = 64, HALF = 128, HTB = HALF * BK * 2  , STAGE_BYTES = 8 * HTB, NXCD = 8, WGM = 8;

__host__ __device__ __forceinline__ int lds_byte(int r, int c) { const int st = (r >> 4) * 2 + (c >> 5), rr = r & 15, cc = c & 31, ob = rr * 64 + cc * 2; return st * 1024 + (ob ^ (((ob >> 9) & 1) << 5)); }
__host__ __device__ __forceinline__ void stage_rc(int b, int& R, int& C) { const int st = b / 1024, sb = b % 1024, swz = sb ^ (((sb >> 9) & 1) << 5); R = (st >> 1) * 16 + swz / 64; C = (st & 1) * 32 + (swz % 64) / 2; }
__host__ __device__ __forceinline__ int perm32(int rho) { const int n = rho >> 4, i = rho & 15; return 8 * (i >> 2) + 4 * n + (i & 3); }

struct Unit { int pm, pn; };
struct Gemm { const bf16_t* A; const bf16_t* Bt; int M, N, K; int ld = 0, pn_thr = 1 << 30, koff = 0; };

struct StaticOrder {
    int nM, nN, nwg, G, c;
    __host__ __device__ void init(int M, int N, int G_, int c_) { nM = M / BM; nN = N / BM; nwg = nM * nN; G = G_; c = c_; }
    __host__ __device__ bool next(int i, Unit& u) const {
        const long L = (long)i * G + c; if (L >= nwg) return false;
        int wgid = (int)L; { const int q = nwg / NXCD, r = nwg % NXCD, xcd = wgid % NXCD, off = wgid / NXCD; wgid = (xcd < r ? xcd * (q + 1) : r * (q + 1) + (xcd - r) * q) + off; }
        const int nig = WGM * nN, gid = wgid / nig, fm = gid * WGM, gsz = (nM - fm) < WGM ? (nM - fm) : WGM;
        u.pm = fm + ((wgid % nig) % gsz); u.pn = (wgid % nig) / gsz; return true;
    }
    __device__ __forceinline__ void a_ready(const Unit&) const {}
    __device__ __forceinline__ void done(const Unit&) const {}
};
__device__ __forceinline__ unsigned cvt_pk_bf16(float lo, float hi) { unsigned r; asm volatile("v_cvt_pk_bf16_f32 %0, %1, %2" : "=v"(r) : "v"(lo), "v"(hi)); return r; }
typedef float f32x2 __attribute__((ext_vector_type(2)));
template <class Epi, class Sched, bool STAMP = false>
__device__ __forceinline__ void gemm_phase(PG8_LAS unsigned char* lds, const Gemm g, const Sched& S, const Epi& E, unsigned long long* stamps) {
    const int tid = threadIdx.x, wid = __builtin_amdgcn_readfirstlane(tid >> 6), lane = tid & 63, wr = wid >> 2, wc = wid & 3, fr = lane & 15, fq = lane >> 4;
    const int K = g.ld ? g.ld : g.K, nt = g.K / BK;
    int ts_lo = 0, ts_hi = 0, nts = 0; const unsigned long long rt_entry = STAMP ? (unsigned long long)wall_clock64() : 0ull;
#define PG8_STAMP() do { if (STAMP && wid == 0 && nts < 64) { const unsigned long long _c = (unsigned long long)clock64(); \
        ts_lo = (lane == nts) ? (int)(unsigned)_c : ts_lo; ts_hi = (lane == nts) ? (int)(unsigned)(_c >> 32) : ts_hi; ++nts; } } while (0)
    PG8_STAMP();
    unsigned voffA[2], voffB[2];
#pragma unroll
    for (int i = 0; i < 2; ++i) { int R, C; stage_rc(tid * 16 + i * 8192, R, C); const int Rb = Epi::PERM ? ((R & ~31) + perm32(R & 31)) : R;
        voffA[i] = (unsigned)(R * K + C) * 2u; voffB[i] = (unsigned)(Rb * K + C) * 2u; }
    const size_t kstep = (size_t)(BK * 2);
    const size_t hstep = (size_t)HALF * K * 2;
    const size_t tstep = 2 * hstep;
    const unsigned ldsw = (unsigned)wid * 1024u;
    const int aoff = lds_byte(wr * 64 + fr, fq * 8), boff = lds_byte(wc * 32 + fr, fq * 8);
#define PG8_SA(b, h) (((b) * 2 + (h)) * HTB)
#define PG8_SB(b, h) ((4 + (b) * 2 + (h)) * HTB)
#define PG8_STAGE(bufoff, gbase, voff) do { _Pragma("unroll") for (int _i = 0; _i < 2; ++_i) \
        __builtin_amdgcn_global_load_lds((const unsigned*)((const char*)(gbase) + (voff)[_i]), (PG8_LAS unsigned*)(lds + (bufoff) + ldsw + _i * 8192), 16, 0, 0); } while (0)
#define PG8_LDA(dst, b, h) do { _Pragma("unroll") for (int m = 0; m < 4; ++m) _Pragma("unroll") for (int k = 0; k < 2; ++k) dst[m][k] = *(const PG8_LAS bf16x8*)(lds + PG8_SA(b, h) + aoff + m * 2048 + k * 1024); } while (0)
#define PG8_LDB(dst, b, h) do { _Pragma("unroll") for (int n = 0; n < 2; ++n) _Pragma("unroll") for (int k = 0; k < 2; ++k) dst[n][k] = *(const PG8_LAS bf16x8*)(lds + PG8_SB(b, h) + boff + n * 2048 + k * 1024); } while (0)
#define PG8_MMA(ai, bj, At, Bt) do { __builtin_amdgcn_s_setprio(1); _Pragma("unroll") for (int m = 0; m < 4; ++m) _Pragma("unroll") for (int n = 0; n < 2; ++n) _Pragma("unroll") for (int k = 0; k < 2; ++k) \
        acc[ai][bj][m][n] = __builtin_amdgcn_mfma_f32_16x16x32_bf16(Bt[n][k], At[m][k], acc[ai][bj][m][n], 0, 0, 0); __builtin_amdgcn_s_setprio(0); } while (0)
#define PG8_WAIT_V(n) asm volatile("s_waitcnt vmcnt(" #n ")" ::: "memory")
#define PG8_WAIT_L(n) asm volatile("s_waitcnt lgkmcnt(" #n ")" ::: "memory")
#define PG8_BAR __builtin_amdgcn_s_barrier()
#define PG8_SCHED __builtin_amdgcn_sched_barrier(0)
    Unit cur, nxt; int ui = 0;
    if (!S.next(0, cur)) return;
    f32x4 acc[2][2][4][2];
#pragma unroll
    for (int a = 0; a < 2; ++a)
#pragma unroll
        for (int b = 0; b < 2; ++b)
#pragma unroll
            for (int m = 0; m < 4; ++m)
#pragma unroll
                for (int n = 0; n < 2; ++n) acc[a][b][m][n] = (f32x4){0.f, 0.f, 0.f, 0.f};
    bf16x8 At[4][2], B0[2][2], B1[2][2];
    const char* cA = (const char*)g.A + (size_t)cur.pm * tstep + (cur.pn >= g.pn_thr ? g.koff * 2 : 0); const char* cB = (const char*)g.Bt + (size_t)cur.pn * tstep + (cur.pn >= g.pn_thr ? g.koff * 2 : 0);
    S.a_ready(cur);
    PG8_STAGE(PG8_SB(0, 0), cB, voffB); PG8_STAGE(PG8_SA(0, 0), cA, voffA); PG8_STAGE(PG8_SB(0, 1), cB + hstep, voffB); PG8_STAGE(PG8_SA(0, 1), cA + hstep, voffA);
    if (wr == 1) PG8_BAR;
    PG8_WAIT_V(4); PG8_BAR;
    PG8_STAGE(PG8_SB(1, 0), cB + kstep, voffB); PG8_STAGE(PG8_SA(1, 0), cA + kstep, voffA); PG8_STAGE(PG8_SB(1, 1), cB + hstep + kstep, voffB);
    PG8_WAIT_V(6); PG8_BAR;
    PG8_STAMP();
    for (;;) {
        const bool has_next = S.next(ui + 1, nxt);
        const int nko = (has_next && nxt.pn >= g.pn_thr) ? g.koff * 2 : 0;
        const char* nA = has_next ? (const char*)g.A + (size_t)nxt.pm * tstep + nko : cA; const char* nB = has_next ? (const char*)g.Bt + (size_t)nxt.pn * tstep + nko : cB;
        for (int t = 0; t < nt; t += 2) {
            const bool last = (t == nt - 2);
            const char* a1 = cA + (size_t)(t + 1) * kstep;
            const char* a2 = last ? nA : cA + (size_t)(t + 2) * kstep; const char* b2 = last ? nB : cB + (size_t)(t + 2) * kstep;
            const char* a3 = a2 + kstep; const char* b3 = b2 + kstep;
            if (last && has_next) S.a_ready(nxt);
            PG8_LDB(B0, 0, 0); PG8_SCHED; PG8_LDA(At, 0, 0); PG8_STAGE(PG8_SA(1, 1), a1 + hstep, voffA);
            PG8_WAIT_L(8); PG8_BAR; PG8_WAIT_L(0); PG8_MMA(0, 0, At, B0); PG8_BAR; PG8_SCHED;
            PG8_LDB(B1, 0, 1); PG8_STAGE(PG8_SB(0, 0), b2, voffB);
            PG8_BAR; PG8_WAIT_L(0); PG8_MMA(0, 1, At, B1); PG8_BAR;
            PG8_LDA(At, 0, 1); PG8_STAGE(PG8_SA(0, 0), a2, voffA);
            PG8_BAR; PG8_WAIT_L(0); PG8_MMA(1, 0, At, B0); PG8_BAR; PG8_SCHED;
            PG8_STAGE(PG8_SB(0, 1), b2 + hstep, voffB);
            PG8_WAIT_V(6); PG8_BAR; PG8_MMA(1, 1, At, B1); PG8_BAR;
            PG8_LDB(B0, 1, 0); PG8_SCHED; PG8_LDA(At, 1, 0); PG8_STAGE(PG8_SA(0, 1), a2 + hstep, voffA);
            PG8_WAIT_L(8); PG8_BAR; PG8_WAIT_L(0); PG8_MMA(0, 0, At, B0); PG8_BAR; PG8_SCHED;
            PG8_LDB(B1, 1, 1); PG8_STAGE(PG8_SB(1, 0), b3, voffB);
            PG8_BAR; PG8_WAIT_L(0); PG8_MMA(0, 1, At, B1); PG8_BAR;
            PG8_LDA(At, 1, 1); PG8_STAGE(PG8_SA(1, 0), a3, voffA);
            PG8_BAR; PG8_WAIT_L(0); PG8_MMA(1, 0, At, B0); PG8_BAR; PG8_SCHED;
            PG8_STAGE(PG8_SB(1, 1), b3 + hstep, voffB);
            PG8_WAIT_V(6); PG8_BAR; PG8_MMA(1, 1, At, B1); PG8_BAR;
        }
        PG8_STAMP();
        if constexpr (!Epi::AFTER_DRAIN) { E(acc, cur, wr, wc, fr, fq); S.done(cur); }
        PG8_STAMP();
        if (!has_next) break;
#pragma unroll
        for (int a = 0; a < 2; ++a)
#pragma unroll
            for (int b = 0; b < 2; ++b)
#pragma unroll
                for (int m = 0; m < 4; ++m)
#pragma unroll
                    for (int n = 0; n < 2; ++n) acc[a][b][m][n] = (f32x4){0.f, 0.f, 0.f, 0.f};
        cur = nxt; cA = nA; cB = nB; ++ui;
    }
    PG8_WAIT_V(0);
    if (wr == 0) PG8_BAR;
    PG8_BAR;
    if constexpr (Epi::AFTER_DRAIN) { E.fused(acc, cur, wr, wc, fr, fq, lds, wid, lane); S.done(cur); }
    PG8_STAMP();
    if (STAMP && wid == 0) { stamps[lane] = lane < nts ? (((unsigned long long)(unsigned)ts_hi << 32) | (unsigned)ts_lo) : 0ull;
        if (lane == 62) stamps[62] = rt_entry; if (lane == 63) stamps[63] = (unsigned long long)wall_clock64(); }
#undef PG8_STAMP
#undef PG8_SA
#undef PG8_SB
#undef PG8_STAGE
#undef PG8_LDA
#undef PG8_LDB
#undef PG8_MMA
#undef PG8_WAIT_V
#undef PG8_WAIT_L
#undef PG8_BAR
#undef PG8_SCHED
}
}
using pg8::bf16_t; using pg8::bf16x8; using pg8::f32x4; using pg8::u32x4; using pg8::Unit;
typedef unsigned u32x2 __attribute__((ext_vector_type(2)));
typedef short s16x4 __attribute__((ext_vector_type(4)));
#define LAS __attribute__((address_space(3)))

constexpr int D = 1024, NB = 2, T = 16384, LC = 256, MT = NB * T, MC = NB * LC, MA = MT + MC;
constexpr int RWP = 1856, INP = 3392, INPP = 3584, DFF = 2816;
constexpr int LDS_BYTES = 131072;
constexpr int NCHAIN = 32;

constexpr size_t OFF_MOD = 0;
constexpr size_t OFF_WIN = 131072;
constexpr size_t OFF_WOUT = OFF_WIN + (size_t)INPP * 1024 * 2;
constexpr size_t OFF_WF1 = OFF_WOUT + (size_t)1024 * 1024 * 2;
constexpr size_t OFF_WF2 = OFF_WF1 + (size_t)5632 * 1024 * 2;
constexpr size_t OFF_LORAB = OFF_WF2 + (size_t)1024 * 2816 * 2;
constexpr size_t OFF_MIX = OFF_LORAB + (size_t)2560 * 384 * 2;
constexpr size_t OFF_U = OFF_MIX + (size_t)MT * 1024 * 2;
constexpr size_t OFF_Q = OFF_U + (size_t)MA * 1024 * 2;
constexpr size_t OFF_K = OFF_Q + (size_t)MA * 512 * 2;
constexpr size_t OFF_VT = OFF_K + (size_t)MA * 512 * 2;
constexpr size_t OFF_VTC = OFF_VT + (size_t)NB * 8 * 64 * T * 2;
constexpr size_t OFF_PR = OFF_VTC + (size_t)NB * 8 * 64 * LC * 2;
constexpr size_t OFF_DEC = OFF_PR + (size_t)MA * RWP * 2;
constexpr size_t OFF_AR = OFF_DEC + (size_t)MA * 1024 * 2;
constexpr size_t OFF_BON = OFF_AR + (size_t)MA * 1024 * 2;
constexpr size_t OFF_LA = OFF_U;
constexpr size_t OFF_SST = OFF_U + (size_t)32 * 1024 * 1024;
constexpr size_t OFF_IDENT = OFF_BON + (size_t)NCHAIN * T * 4;
constexpr size_t OFF_BAR = OFF_IDENT + 16384;
constexpr size_t OFF_END = OFF_BAR + 16384;
constexpr size_t OFF_ACT = OFF_Q;
static_assert(OFF_ACT + (size_t)MT * DFF * 2 <= OFF_DEC, "ACT alias overflow");
static_assert(OFF_END <= (size_t)536870912, "workspace");

struct Params {
    const float* in[27];
    float* out; unsigned char* ws;
    int ph_lo, ph_hi;
};

__device__ __forceinline__ float bf2f(bf16_t v) { return __uint_as_float(((unsigned)v) << 16); }
typedef __bf16 hwbf16x2 __attribute__((ext_vector_type(2)));
typedef float cvf32x2 __attribute__((ext_vector_type(2)));
__device__ __forceinline__ unsigned pk2(float lo, float hi) { const hwbf16x2 r = __builtin_convertvector((cvf32x2){lo, hi}, hwbf16x2); return __builtin_bit_cast(unsigned, r); }
__device__ __forceinline__ bf16_t f2bf(float f) { return (bf16_t)(pk2(f, 0.0f) & 0xffffu); }
__device__ __forceinline__ float dpp_f(float v, int ctrl_quad) { return v; }
#define DPPF(v, ctrl) __builtin_bit_cast(float, __builtin_amdgcn_update_dpp(0, __builtin_bit_cast(int, (v)), (ctrl), 0xf, 0xf, true))
__device__ __forceinline__ float wave_sum(float v) {
    v += DPPF(v, 0xB1);
    v += DPPF(v, 0x4E);
    v += DPPF(v, 0x141);
    v += DPPF(v, 0x140);
    const float s0 = __builtin_bit_cast(float, __builtin_amdgcn_readlane(__builtin_bit_cast(int, v), 0)), s1 = __builtin_bit_cast(float, __builtin_amdgcn_readlane(__builtin_bit_cast(int, v), 16));
    const float s2 = __builtin_bit_cast(float, __builtin_amdgcn_readlane(__builtin_bit_cast(int, v), 32)), s3 = __builtin_bit_cast(float, __builtin_amdgcn_readlane(__builtin_bit_cast(int, v), 48));
    return (s0 + s1) + (s2 + s3);
}
__device__ __forceinline__ float silu_f(float x) { return x * __builtin_amdgcn_rcpf(1.0f + __expf(-x)); }
__device__ __forceinline__ float sigmoid_f(float x) { return __builtin_amdgcn_rcpf(1.0f + __expf(-x)); }

struct EpiIn {
    static constexpr bool PERM = false, AFTER_DRAIN = false;
    bf16_t *Q, *K, *VT, *VTC, *PR; const float *qg, *kg;
    __device__ __forceinline__ void operator()(const f32x4 (&acc)[2][2][4][2], const Unit& u, int wr, int wc, int fr, int fq) const {
        const int c0 = u.pn * 256 + wc * 64;
        const int row0 = u.pm * 256 + wr * 64 + fr;
        if (c0 < 1024) {
            const bool isq = c0 < 512; const float* g = isq ? qg : kg; bf16_t* dst = isq ? Q : K; const int cc = c0 & 511; const float sc = isq ? 0.125f : 1.0f;
            f32x4 gv[2][2];
#pragma unroll
            for (int bj = 0; bj < 2; ++bj)
#pragma unroll
                for (int n = 0; n < 2; ++n) gv[bj][n] = *(const f32x4*)(g + 32 * bj + 8 * fq + 4 * n) * sc;
#pragma unroll
            for (int ai = 0; ai < 2; ++ai)
#pragma unroll
                for (int m = 0; m < 4; ++m) {
                    float ss = 0.f;
#pragma unroll
                    for (int bj = 0; bj < 2; ++bj)
#pragma unroll
                        for (int n = 0; n < 2; ++n) { const f32x4 x = acc[ai][bj][m][n]; ss += (x[0] * x[0] + x[1] * x[1]) + (x[2] * x[2] + x[3] * x[3]); }
                    ss += __shfl_xor(ss, 16); ss += __shfl_xor(ss, 32);
                    const float rstd = rsqrtf(ss * (1.0f / 64.0f) + 1e-6f);
                    bf16_t* rowp = dst + (size_t)(row0 + ai * 128 + m * 16) * 512 + cc + 8 * fq;
#pragma unroll
                    for (int bj = 0; bj < 2; ++bj) { const f32x4 y0 = acc[ai][bj][m][0] * rstd * gv[bj][0], y1 = acc[ai][bj][m][1] * rstd * gv[bj][1];
                        u32x4 w; w.x = pk2(y0[0], y0[1]); w.y = pk2(y0[2], y0[3]); w.z = pk2(y1[0], y1[1]); w.w = pk2(y1[2], y1[3]); *(u32x4*)(rowp + 32 * bj) = w; }
                }
        } else if (c0 < 1536) {
            const int h = (c0 - 1024) >> 6;
#pragma unroll
            for (int ai = 0; ai < 2; ++ai)
#pragma unroll
                for (int m = 0; m < 4; ++m) {
                    const int r = row0 + ai * 128 + m * 16;
                    bf16_t* base; size_t stride;
                    if (r < MT) { const int b = r / T, t = r % T; base = VT + ((size_t)(b * 8 + h) * 64) * T + t; stride = T; }
                    else { const int rc = r - MT, b = rc / LC, l = rc % LC; base = VTC + ((size_t)(b * 8 + h) * 64) * LC + l; stride = LC; }
#pragma unroll
                    for (int bj = 0; bj < 2; ++bj)
#pragma unroll
                        for (int n = 0; n < 2; ++n)
#pragma unroll
                            for (int e = 0; e < 4; ++e) base[(size_t)(32 * bj + 8 * fq + 4 * n + e) * stride] = f2bf(acc[ai][bj][m][n][e]);
                }
        } else {
            const int cr = c0 - 1536;
            if (cr >= RWP) return;
#pragma unroll
            for (int ai = 0; ai < 2; ++ai)
#pragma unroll
                for (int m = 0; m < 4; ++m) {
                    bf16_t* rowp = PR + (size_t)(row0 + ai * 128 + m * 16) * RWP + cr + 8 * fq;
#pragma unroll
                    for (int bj = 0; bj < 2; ++bj) { const f32x4 y0 = acc[ai][bj][m][0], y1 = acc[ai][bj][m][1];
                        u32x4 w; w.x = pk2(y0[0], y0[1]); w.y = pk2(y0[2], y0[3]); w.z = pk2(y1[0], y1[1]); w.w = pk2(y1[2], y1[3]); *(u32x4*)(rowp + 32 * bj) = w; }
                }
        }
    }
};
struct EpiRes {
    static constexpr bool PERM = false, AFTER_DRAIN = false;
    const float* base; float* out; const float* gate;
    __device__ __forceinline__ void operator()(const f32x4 (&acc)[2][2][4][2], const Unit& u, int wr, int wc, int fr, int fq) const {
        const int c0 = u.pn * 256 + wc * 64 + 4 * fq;
        const int row0 = u.pm * 256 + wr * 64 + fr;
#pragma unroll
        for (int ai = 0; ai < 2; ++ai)
#pragma unroll
            for (int m = 0; m < 4; ++m) {
                const int r = row0 + ai * 128 + m * 16; const int b = r / T;
#pragma unroll
                for (int bj = 0; bj < 2; ++bj)
#pragma unroll
                    for (int n = 0; n < 2; ++n) { const int c = c0 + 32 * bj + 16 * n;
                        const f32x4 gt = *(const f32x4*)(gate + (size_t)b * 6144 + c);
                        const f32x4 bs = *(const f32x4*)(base + (size_t)r * 1024 + c);
                        *(f32x4*)(out + (size_t)r * 1024 + c) = bs + gt * acc[ai][bj][m][n]; }
            }
    }
};
struct EpiGlu {
    static constexpr bool PERM = false, AFTER_DRAIN = false;
    bf16_t* ACT;
    __device__ __forceinline__ void operator()(const f32x4 (&acc)[2][2][4][2], const Unit& u, int wr, int wc, int fr, int fq) const {
        const int g0 = u.pn * 128 + wc * 32 + 8 * fq;
        const int row0 = u.pm * 256 + wr * 64 + fr;
#pragma unroll
        for (int ai = 0; ai < 2; ++ai)
#pragma unroll
            for (int m = 0; m < 4; ++m) {
                bf16_t* rowp = ACT + (size_t)(row0 + ai * 128 + m * 16) * DFF + g0;
                const f32x4 ga0 = acc[ai][0][m][0], up0 = acc[ai][1][m][0], ga1 = acc[ai][0][m][1], up1 = acc[ai][1][m][1];
                u32x4 w; w.x = pk2(silu_f(ga0[0]) * up0[0], silu_f(ga0[1]) * up0[1]); w.y = pk2(silu_f(ga0[2]) * up0[2], silu_f(ga0[3]) * up0[3]);
                w.z = pk2(silu_f(ga1[0]) * up1[0], silu_f(ga1[1]) * up1[1]); w.w = pk2(silu_f(ga1[2]) * up1[2], silu_f(ga1[3]) * up1[3]);
                *(u32x4*)rowp = w;
            }
    }
};

__device__ __forceinline__ void transpose_item(const float* Wk0, int K, int Nsrc, int src_col0, bf16_t* WT, int dest_row0, int k0, LAS float* scr, int lane, bool perm = false) {
    const int c = lane & 7;
    if (src_col0 < 0) {
#pragma unroll
        for (int j = 0; j < 4; ++j) { const int n = (lane >> 3) + 8 * j; *(u32x4*)(WT + (size_t)(dest_row0 + n) * K + k0 + 8 * c) = (u32x4){0u, 0u, 0u, 0u}; }
        return;
    }
#pragma unroll 8
    for (int i = 0; i < 32; ++i) { const int kk = 2 * i + (lane >> 5); scr[kk * 33 + (lane & 31)] = Wk0[(size_t)kk * Nsrc + src_col0 + (lane & 31)]; }
    asm volatile("s_waitcnt lgkmcnt(0)" ::: "memory");
#pragma unroll
    for (int j = 0; j < 4; ++j) { const int n = (lane >> 3) + 8 * j; const LAS float* s = scr + (8 * c) * 33 + (perm ? pg8::perm32(n) : n);
        u32x4 o; o.x = pk2(s[0 * 33], s[1 * 33]); o.y = pk2(s[2 * 33], s[3 * 33]); o.z = pk2(s[4 * 33], s[5 * 33]); o.w = pk2(s[6 * 33], s[7 * 33]);
        *(u32x4*)(WT + (size_t)(dest_row0 + n) * K + k0 + 8 * c) = o; }
    asm volatile("s_waitcnt lgkmcnt(0)" ::: "memory");
}
constexpr int W_EARLY = 80 * 6 + (INPP / 32) * 16, W_ALL = W_EARLY + 32 * 16 + (5632 / 32) * 16 + 32 * 44;
__device__ __forceinline__ void weight_transposes(const Params& p, LAS unsigned char* lds, int it_lo, int it_hi, int gw, int NGW) {
    const int lane = threadIdx.x & 63, wave = threadIdx.x >> 6;
    LAS float* scr = (LAS float*)(lds + 32768 + wave * 8704);
    constexpr int I_IN = (INPP / 32) * 16, I_OUT = 32 * 16, I_F1 = (5632 / 32) * 16, I_F2 = 32 * 44, I_LO = 80 * 6;
    for (int it = it_lo + gw; it < it_hi; it += NGW) {
        int r = it;
        if (r < I_LO) { const int gd = r / 6, kc = r % 6, t0 = gd * 32, pn = t0 >> 8, bj = (t0 >> 7) & 1, wc = (t0 >> 5) & 3, a0 = pn * 256 + wc * 64 + bj * 32;
            const int grp = a0 >> 9, hc0 = a0 & 511;
            const float* W = nullptr;
            if (grp < 2) { if (kc == grp) W = p.in[15] + (size_t)grp * 64 * 512; }
            else if (grp < 4) { if (kc == 2) W = p.in[17] + (size_t)(grp & 1) * 64 * 512; }
            else { if (kc == 3 || kc == 4) W = p.in[18] + (size_t)(kc - 3) * 64 * 512; }
            transpose_item(W ? W : p.in[15], 384, 512, W ? hc0 : -1, (bf16_t*)(p.ws + OFF_LORAB), t0, kc * 64, scr, lane, true); continue; }
        r -= I_LO;
        if (r < I_IN) { const int gd = r >> 4, kc = r & 15, t0 = gd * 32, pn = t0 >> 8, bj = (t0 >> 7) & 1, wc = (t0 >> 5) & 3, a0 = pn * 256 + wc * 64 + bj * 32;
            transpose_item(p.in[8] + (size_t)kc * 64 * INP, 1024, INP, a0 < INP ? a0 : -1, (bf16_t*)(p.ws + OFF_WIN), t0, kc * 64, scr, lane, true); continue; }
        r -= I_IN;
        if (r < I_OUT) { const int gd = r >> 4, kc = r & 15, t0 = gd * 32, pn = t0 >> 8, bj = (t0 >> 7) & 1, wc = (t0 >> 5) & 3, a0 = pn * 256 + wc * 64 + bj * 32;
            transpose_item(p.in[24] + (size_t)kc * 64 * 1024, 1024, 1024, a0, (bf16_t*)(p.ws + OFF_WOUT), t0, kc * 64, scr, lane); continue; }
        r -= I_OUT;
        if (r < I_F1) { const int gd = r >> 4, kc = r & 15, t0 = gd * 32, pn = t0 >> 8, bj = (t0 >> 7) & 1, wc = (t0 >> 5) & 3, src = pn * 128 + wc * 32 + bj * DFF;
            transpose_item(p.in[25] + (size_t)kc * 64 * 2 * DFF, 1024, 2 * DFF, src, (bf16_t*)(p.ws + OFF_WF1), t0, kc * 64, scr, lane, true); continue; }
        r -= I_F1;
        { const int gd = r / 44, kc = r % 44, t0 = gd * 32, pn = t0 >> 8, bj = (t0 >> 7) & 1, wc = (t0 >> 5) & 3, a0 = pn * 256 + wc * 64 + bj * 32;
            transpose_item(p.in[26] + (size_t)kc * 64 * 1024, DFF, 1024, a0, (bf16_t*)(p.ws + OFF_WF2), t0, kc * 64, scr, lane); }
    }
}


__device__ __forceinline__ void phase0(const Params& p, LAS unsigned char* lds) {
    const int tid = threadIdx.x, lane = tid & 63, wave = tid >> 6;
    const float* c = p.in[1]; const float* cctx = p.in[3]; const float* w_ada = p.in[6]; const float* b_ada = p.in[7];
    float* mod = (float*)(p.ws + OFF_MOD);
    LAS float* red = (LAS float*)lds;
    for (int cb = blockIdx.x; cb < 256; cb += gridDim.x) {
        const int ks = tid / 6, cgp = tid % 6, col = cb * 24 + cgp * 4;
        if (ks < 84) {
            f32x4 a0 = {0.f, 0.f, 0.f, 0.f}, a1 = a0, a2 = a0;
            for (int k = ks; k < 1024; k += 84) {
                const f32x4 w = *(const f32x4*)(w_ada + (size_t)k * 6144 + col);
                a0 += w * silu_f(c[k]); a1 += w * silu_f(c[1024 + k]); a2 += w * silu_f(cctx[k]);
            }
#pragma unroll
            for (int e = 0; e < 4; ++e) { red[ks * 72 + cgp * 4 + e] = a0[e]; red[ks * 72 + 24 + cgp * 4 + e] = a1[e]; red[ks * 72 + 48 + cgp * 4 + e] = a2[e]; }
        }
        __syncthreads();
        if (tid < 72) { float s = 0.f; for (int k = 0; k < 84; ++k) s += red[k * 72 + tid];
            const int r = tid / 24, cc = cb * 24 + tid % 24; mod[r * 6144 + cc] = s + b_ada[cc]; }
        __syncthreads();
    }
    { float* ident = (float*)(p.ws + OFF_IDENT); for (int idx = blockIdx.x * 512 + tid; idx < 4096; idx += gridDim.x * 512) ident[idx] = ((idx >> 6) == (idx & 63)) ? 1.0f : 0.0f; }
    weight_transposes(p, lds, 0, W_EARLY, blockIdx.x * 8 + wave, gridDim.x * 8);
}

__device__ __forceinline__ void phase_norm(const Params& p, int which) {
    const int lane = threadIdx.x & 63, wave = threadIdx.x >> 6;
    const float* mod = (const float*)(p.ws + OFF_MOD);
    const float* g = which ? p.in[5] : p.in[4];
    bf16_t* U = (bf16_t*)(p.ws + OFF_U);
    const int nrows = which ? MT : MA, shoff = which ? 3 * 1024 : 0, scoff = which ? 4 * 1024 : 1024;
    for (int row = blockIdx.x * 8 + wave; row < nrows; row += gridDim.x * 8) {
        const float* src; int mrow;
        if (which) { src = p.out + (size_t)row * 1024; mrow = row / T; }
        else if (row < MT) { src = p.in[0] + (size_t)row * 1024; mrow = row / T; }
        else { src = p.in[2] + (size_t)(row - MT) * 1024; mrow = 2; }
        f32x4 v[4]; float ss = 0.f;
#pragma unroll
        for (int j = 0; j < 4; ++j) { v[j] = ((const f32x4*)src)[lane + 64 * j]; ss += (v[j][0] * v[j][0] + v[j][1] * v[j][1]) + (v[j][2] * v[j][2] + v[j][3] * v[j][3]); }
        const float rstd = rsqrtf(wave_sum(ss) * (1.0f / 1024.0f) + 1e-6f);
#pragma unroll
        for (int j = 0; j < 4; ++j) { const int col = 4 * (lane + 64 * j);
            const f32x4 gg = *(const f32x4*)(g + col), sc = *(const f32x4*)(mod + mrow * 6144 + scoff + col), sh = *(const f32x4*)(mod + mrow * 6144 + shoff + col);
            const f32x4 y = v[j] * rstd * gg * (sc + 1.0f) + sh;
            u32x2 w; w.x = pk2(y[0], y[1]); w.y = pk2(y[2], y[3]); *(u32x2*)(U + (size_t)row * 1024 + col) = w; }
    }
}

__device__ __forceinline__ void phase_shiftprep(const Params& p) {
    const int lane = threadIdx.x & 63, wave = threadIdx.x >> 6;
    const bf16_t* PR = (const bf16_t*)(p.ws + OFF_PR); bf16_t* LA = (bf16_t*)(p.ws + OFF_LA);
    float mp[5], mn[5];
#pragma unroll
    for (int j = 0; j < 5; ++j) { mp[j] = p.in[12][1536 + lane + 64 * j]; mn[j] = p.in[13][1536 + lane + 64 * j]; }
    constexpr int NRW = 4;
    const int stride = gridDim.x * 8;
    for (int row0 = blockIdx.x * 8 + wave; row0 < MA; row0 += NRW * stride) {
        unsigned short pc[NRW][5], pp[NRW][5], pn[NRW][5]; float mpf[NRW], mnf[NRW]; bool ok[NRW];
#pragma unroll
        for (int u = 0; u < NRW; ++u) { const int rw = row0 + u * stride; ok[u] = rw < MA; const int row = ok[u] ? rw : row0;
            bool hp_, hn_;
            if (row < MT) { const int t = row % T; hp_ = t > 0; hn_ = t < T - 1; } else { const int l = (row - MT) % LC; hp_ = l > 0; hn_ = l < LC - 1; }
            const bf16_t* pr = PR + (size_t)row * RWP + 1536; const bf16_t* prp = hp_ ? pr - RWP : pr; const bf16_t* prn = hn_ ? pr + RWP : pr;
            mpf[u] = hp_ ? 1.0f : 0.0f; mnf[u] = hn_ ? 1.0f : 0.0f;
#pragma unroll
            for (int j = 0; j < 5; ++j) { const int col = lane + 64 * j; pc[u][j] = pr[col]; pp[u][j] = prp[col]; pn[u][j] = prn[col]; } }
#pragma unroll
        for (int u = 0; u < NRW; ++u) { if (!ok[u]) continue; const int row = row0 + u * stride;
#pragma unroll
            for (int j = 0; j < 5; ++j) { const int col = lane + 64 * j;
                const float c_ = bf2f(pc[u][j]), p_ = mpf[u] * bf2f(pp[u][j]), n_ = mnf[u] * bf2f(pn[u][j]);
                float v = c_ + mp[j] * (p_ - c_) + mn[j] * (n_ - c_);
                if (j < 2) v = 1.0f - 2.0f * __builtin_amdgcn_rcpf(1.0f + __expf(2.0f * v));
                else if (j >= 3) v = sigmoid_f(v);
                LA[(size_t)row * 384 + col] = f2bf(v); }
            LA[(size_t)row * 384 + 320 + lane] = 0; }
    }
}
struct EpiLora {
    static constexpr bool PERM = false, AFTER_DRAIN = false;
    bf16_t *DEC, *AR, *MIXG; const float *w0, *a0;
    __device__ __forceinline__ void operator()(const f32x4 (&acc)[2][2][4][2], const Unit& u, int wr, int wc, int fr, int fq) const {
        const int ac = u.pn * 256 + wc * 64, grp = ac >> 9, hc0 = (ac & 511) + 8 * fq, d = grp & 1;
        const int row0 = u.pm * 256 + wr * 64 + fr;
        if (grp == 4) {
#pragma unroll
            for (int ai = 0; ai < 2; ++ai)
#pragma unroll
                for (int m = 0; m < 4; ++m) { const int r = row0 + ai * 128 + m * 16; if (r >= MT) continue;
                    bf16_t* rowp = MIXG + (size_t)r * 1024 + 512 + hc0;
#pragma unroll
                    for (int bj = 0; bj < 2; ++bj) { const f32x4 y0 = acc[ai][bj][m][0], y1 = acc[ai][bj][m][1]; u32x4 w; w.x = pk2(y0[0], y0[1]); w.y = pk2(y0[2], y0[3]); w.z = pk2(y1[0], y1[1]); w.w = pk2(y1[2], y1[3]); *(u32x4*)(rowp + 32 * bj) = w; } }
            return;
        }
        const bool isw = grp < 2;
        const float* bias = (isw ? w0 : a0) + d * 512 + hc0;
        bf16_t* dst = (isw ? DEC : AR) + d * 512 + hc0;
        f32x4 bv[2][2];
#pragma unroll
        for (int bj = 0; bj < 2; ++bj)
#pragma unroll
            for (int n = 0; n < 2; ++n) bv[bj][n] = *(const f32x4*)(bias + 32 * bj + 4 * n);
#pragma unroll
        for (int ai = 0; ai < 2; ++ai)
#pragma unroll
            for (int m = 0; m < 4; ++m) {
                bf16_t* rowp = dst + (size_t)(row0 + ai * 128 + m * 16) * 1024;
#pragma unroll
                for (int bj = 0; bj < 2; ++bj) { u32x4 w;
#pragma unroll
                    for (int n = 0; n < 2; ++n) { const f32x4 x = acc[ai][bj][m][n] + bv[bj][n]; f32x4 y;
#pragma unroll
                        for (int e = 0; e < 4; ++e) {
                            if (isw) y[e] = -0.60653066f * sigmoid_f(x[e]);
                            else y[e] = sigmoid_f(x[e]); }
                        if (n == 0) { w.x = pk2(y[0], y[1]); w.y = pk2(y[2], y[3]); } else { w.z = pk2(y[0], y[1]); w.w = pk2(y[2], y[3]); } }
                    *(u32x4*)(rowp + 32 * bj) = w;
                    asm volatile("" ::: "memory"); }
            }
    }
};
#define XB_TMO      128
#define XB_XCNT(j)  (256  + 64 * (j))
#define XB_XSUB(j)  (1280 + 64 * (j))
#define XB_XGEN(j)  (2304 + 64 * (j))
#define XB_TOP      3328
#define XB_TOPGEN   3392
#define XCD_BAR_WORDS 3456
#define XB_SPIN_CAP (1u << 18)

__device__ __forceinline__ unsigned xb_ld(unsigned* p)              { return __hip_atomic_load(p, __ATOMIC_RELAXED, __HIP_MEMORY_SCOPE_AGENT); }
__device__ __forceinline__ unsigned xb_add(unsigned* p, unsigned v) { return __hip_atomic_fetch_add(p, v, __ATOMIC_RELAXED, __HIP_MEMORY_SCOPE_AGENT); }
__device__ __forceinline__ unsigned xb_xcc_id() { return (unsigned)__builtin_amdgcn_s_getreg((3 << 11) | 20) & 0xFu; }
#define XB_SPIN(cond, bar) do { unsigned _sp = 0; while (cond) { __builtin_amdgcn_s_sleep(1); \
    if ((++_sp & 255u) == 0u) { if (xb_ld(&(bar)[XB_TMO])) break; if (_sp > XB_SPIN_CAP) { atomicAdd(&(bar)[XB_TMO], 1u); break; } } } } while (0)

struct XcdBarrier {
    unsigned* bar; unsigned x;
    volatile LAS unsigned* st;
};

__device__ __forceinline__ XcdBarrier xcd_barrier_post(unsigned* bar, volatile LAS unsigned* st) {
    XcdBarrier b; b.bar = bar; b.x = xb_xcc_id(); b.st = st;
    if (threadIdx.x == 0) (void)xb_add(&bar[XB_XCNT(b.x)], 1u);
    return b;
}
__device__ __forceinline__ void xcd_barrier_complete(unsigned* bar, unsigned x, unsigned& nloc, unsigned& nx) {
    const unsigned G = gridDim.x * gridDim.y * gridDim.z;
    unsigned sum, cnt, mine, sp = 0u;
    for (;;) {
        sum = 0u; cnt = 0u; mine = 0u;
#pragma unroll
        for (unsigned j = 0; j < 16; ++j) { const unsigned c = xb_ld(&bar[XB_XCNT(j)]); sum += c; cnt += (c > 0u) ? 1u : 0u; mine = (j == x) ? c : mine; }
        if (sum == G) break;
        __builtin_amdgcn_s_sleep(1);
        if ((++sp & 255u) == 0u) { if (xb_ld(&bar[XB_TMO])) break; if (sp > XB_SPIN_CAP) { atomicAdd(&bar[XB_TMO], 1u); break; } }
    }
    nloc = mine > 0u ? mine : 1u; nx = cnt > 0u ? cnt : 1u;
}

__device__ __forceinline__ void xcd_barrier(const XcdBarrier& b) {
    asm volatile("s_waitcnt vmcnt(0)" ::: "memory");
    __syncthreads();
    if (threadIdx.x == 0) {
        unsigned* bar = b.bar;
        __builtin_amdgcn_s_waitcnt(0);
        unsigned nloc = b.st[0], nx = b.st[1];
        if (nloc == 0u) { xcd_barrier_complete(bar, b.x, nloc, nx); b.st[0] = nloc; b.st[1] = nx; }
        const unsigned old = xb_add(&bar[XB_XSUB(b.x)], 1u);
        const unsigned gen = old / nloc;
        if (old + 1u == (gen + 1u) * nloc) {
            __builtin_amdgcn_fence(__ATOMIC_RELEASE, "agent");
            asm volatile("s_waitcnt vmcnt(0)" ::: "memory");
            const unsigned og = xb_add(&bar[XB_TOP], 1u);
            const unsigned tg = og / nx;
            if (og + 1u == (tg + 1u) * nx) xb_add(&bar[XB_TOPGEN], 1u);
            else XB_SPIN(xb_ld(&bar[XB_TOPGEN]) == tg, bar);
            __builtin_amdgcn_fence(__ATOMIC_ACQUIRE, "agent");
            xb_add(&bar[XB_XGEN(b.x)], 1u);
            asm volatile("s_waitcnt vmcnt(0)" ::: "memory");
        } else {
            XB_SPIN(xb_ld(&bar[XB_XGEN(b.x)]) == gen, bar);
            __builtin_amdgcn_fence(__ATOMIC_ACQUIRE, "agent");
            asm volatile("s_waitcnt vmcnt(0)" ::: "memory");
        }
    }
    __syncthreads();
}
constexpr int NA_KLD = 72, NA_VLD = 264;
__device__ __forceinline__ void na_task(const Params& p, int b, int h, int i, int j, int lane, const LAS bf16_t* Kc, const LAS bf16_t* VTc, const LAS float* rpb) {
    const int fr = lane & 15, fq = lane >> 4;
    const bf16_t* Q = (const bf16_t*)(p.ws + OFF_Q); const bf16_t* K = (const bf16_t*)(p.ws + OFF_K);
    const bf16_t* VT = (const bf16_t*)(p.ws + OFF_VT);
    bf16_t* MIX = (bf16_t*)(p.ws + OFF_MIX);
    const size_t qrow = (size_t)b * T + i * 64 + 16 * j + fr;
    const bf16_t* qp = Q + qrow * 512 + h * 64 + 8 * fq;
    const bf16x8 q0 = *(const bf16x8*)qp, q1 = *(const bf16x8*)(qp + 32);
    const int rs = min(max(i - 4, 0), 248);
    const int cb = (j == 0) ? 0 : (j == 1) ? 8 : (j == 2) ? 24 : 32;
    const int c = 16 * j + fr, cs = min(max(c - 8, 0), 48);
    float m_run = -INFINITY, l_run = 0.f;
    f32x4 o[4];
#pragma unroll
    for (int dt = 0; dt < 4; ++dt) o[dt] = (f32x4){0.f, 0.f, 0.f, 0.f};
    const bf16_t* vt_base = VT + ((size_t)(b * 8 + h) * 64 + fr) * T;
#pragma unroll
    for (int half = 0; half < 2; ++half) {
    const bool win = half == 0;
#pragma unroll 1
    for (int grp = 2 * half; grp < 2 * half + 2; ++grp) {
        f32x4 s[8];
#pragma unroll
        for (int kt = 0; kt < 8; ++kt) {
            int rr = 0, nt = 0; bf16x8 k0, k1;
            if (win) { rr = grp * 4 + (kt >> 1); nt = kt & 1; const size_t krow = (size_t)b * T + (rs + rr) * 64 + cb + 16 * nt + fr;
                const bf16_t* kp = K + krow * 512 + h * 64 + 8 * fq; k0 = *(const bf16x8*)kp; k1 = *(const bf16x8*)(kp + 32); }
            else { const LAS bf16_t* kp = Kc + ((grp - 2) * 128 + kt * 16 + fr) * NA_KLD + 8 * fq; k0 = *(const LAS bf16x8*)kp; k1 = *(const LAS bf16x8*)(kp + 32); }
            f32x4 a = {0.f, 0.f, 0.f, 0.f};
            a = __builtin_amdgcn_mfma_f32_16x16x32_bf16(k0, q0, a, 0, 0, 0);
            a = __builtin_amdgcn_mfma_f32_16x16x32_bf16(k1, q1, a, 0, 0, 0);
            if (win) {
                const int di = rs + rr - i + 7;
#pragma unroll
                for (int e = 0; e < 4; ++e) { const int kc = cb + 16 * nt + 4 * fq + e; const bool valid = (kc >= cs) && (kc < cs + 16);
                    const int dj = min(max(kc - c + 15, 0), 30);
                    const float bias = rpb[di * 31 + dj];
                    a[e] = valid ? a[e] + bias : -INFINITY; }
            }
            s[kt] = a;
        }
        float gmax = -INFINITY;
#pragma unroll
        for (int kt = 0; kt < 8; ++kt)
#pragma unroll
            for (int e = 0; e < 4; ++e) gmax = fmaxf(gmax, s[kt][e]);
        gmax = fmaxf(gmax, __shfl_xor(gmax, 16)); gmax = fmaxf(gmax, __shfl_xor(gmax, 32));
        const float m_new = fmaxf(m_run, gmax);
        const float alpha = __expf(m_run - m_new);
        float psum = 0.f;
#pragma unroll
        for (int kt = 0; kt < 8; ++kt)
#pragma unroll
            for (int e = 0; e < 4; ++e) { const float pv = __expf(s[kt][e] - m_new); psum += pv; s[kt][e] = pv; }
        psum += __shfl_xor(psum, 16); psum += __shfl_xor(psum, 32);
        l_run = l_run * alpha + psum; m_run = m_new;
#pragma unroll
        for (int dt = 0; dt < 4; ++dt) o[dt] *= alpha;
#pragma unroll
        for (int k2 = 0; k2 < 4; ++k2) {
            u32x4 pw; pw.x = pk2(s[2 * k2][0], s[2 * k2][1]); pw.y = pk2(s[2 * k2][2], s[2 * k2][3]); pw.z = pk2(s[2 * k2 + 1][0], s[2 * k2 + 1][1]); pw.w = pk2(s[2 * k2 + 1][2], s[2 * k2 + 1][3]);
            const bf16x8 pb = __builtin_bit_cast(bf16x8, pw);
            if (win) {
                const bf16_t* vp = vt_base + (size_t)(rs + grp * 4 + k2) * 64 + cb + 4 * fq; const size_t dstride = (size_t)16 * T;
#pragma unroll
                for (int dt = 0; dt < 4; ++dt) {
                    const u32x2 lo = *(const u32x2*)(vp + dt * dstride), hi = *(const u32x2*)(vp + dt * dstride + 16);
                    u32x4 vw; vw.x = lo.x; vw.y = lo.y; vw.z = hi.x; vw.w = hi.y;
                    o[dt] = __builtin_amdgcn_mfma_f32_16x16x32_bf16(__builtin_bit_cast(bf16x8, vw), pb, o[dt], 0, 0, 0);
                }
            } else {
                const LAS bf16_t* vp = VTc + fr * NA_VLD + (grp - 2) * 128 + k2 * 32 + 4 * fq;
#pragma unroll
                for (int dt = 0; dt < 4; ++dt) {
                    const u32x2 lo = *(const LAS u32x2*)(vp + dt * 16 * NA_VLD), hi = *(const LAS u32x2*)(vp + dt * 16 * NA_VLD + 16);
                    u32x4 vw; vw.x = lo.x; vw.y = lo.y; vw.z = hi.x; vw.w = hi.y;
                    o[dt] = __builtin_amdgcn_mfma_f32_16x16x32_bf16(__builtin_bit_cast(bf16x8, vw), pb, o[dt], 0, 0, 0);
                }
            }
        }
    }
    }
    const float inv = 1.0f / l_run;
    bf16_t* op = MIX + qrow * 1024 + h * 64 + 4 * fq;
#pragma unroll
    for (int dt = 0; dt < 4; ++dt) { const f32x4 y = o[dt] * inv; u32x2 w; w.x = pk2(y[0], y[1]); w.y = pk2(y[2], y[3]); *(u32x2*)(op + 16 * dt) = w; }
}
template <int NTL>
__device__ __forceinline__ void na_softmax_n(f32x4 (&s)[NTL], float& m_run, float& l_run, f32x4 (&o)[4]) {
    float gmax = -INFINITY;
#pragma unroll
    for (int kt = 0; kt < NTL; ++kt)
#pragma unroll
        for (int e = 0; e < 4; ++e) gmax = fmaxf(gmax, s[kt][e]);
    gmax = fmaxf(gmax, __shfl_xor(gmax, 16)); gmax = fmaxf(gmax, __shfl_xor(gmax, 32));
    const float m_new = fmaxf(m_run, gmax);
    const float alpha = __expf(m_run - m_new);
    float psum = 0.f;
#pragma unroll
    for (int kt = 0; kt < NTL; ++kt)
#pragma unroll
        for (int e = 0; e < 4; ++e) { const float pv = __expf(s[kt][e] - m_new); psum += pv; s[kt][e] = pv; }
    psum += __shfl_xor(psum, 16); psum += __shfl_xor(psum, 32);
    l_run = l_run * alpha + psum; m_run = m_new;
#pragma unroll
    for (int dt = 0; dt < 4; ++dt) o[dt] *= alpha;
}
__device__ __forceinline__ bf16x8 na_pack2(const f32x4& x, const f32x4& y) {
    u32x4 pw; pw.x = pk2(x[0], x[1]); pw.y = pk2(x[2], x[3]); pw.z = pk2(y[0], y[1]); pw.w = pk2(y[2], y[3]); return __builtin_bit_cast(bf16x8, pw);
}
__device__ __forceinline__ void na_task2(const Params& p, int b, int h, int ip, int j, int lane, const LAS bf16_t* Kc, const LAS bf16_t* VTc, const LAS float* rpb) {
    const int fr = lane & 15, fq = lane >> 4;
    const bf16_t* Q = (const bf16_t*)(p.ws + OFF_Q); const bf16_t* K = (const bf16_t*)(p.ws + OFF_K);
    const bf16_t* VT = (const bf16_t*)(p.ws + OFF_VT);
    bf16_t* MIX = (bf16_t*)(p.ws + OFF_MIX);
    const int i0 = 2 * ip;
    const int rs0 = min(max(i0 - 4, 0), 248), rs1 = min(max(i0 - 3, 0), 248);
    const int cb = (j == 0) ? 0 : (j == 1) ? 8 : (j == 2) ? 24 : 32;
    const int c = 16 * j + fr, cs = min(max(c - 8, 0), 48);
    const size_t qrow0 = (size_t)b * T + i0 * 64 + 16 * j + fr;
    bf16x8 q[2][2];
#pragma unroll
    for (int a = 0; a < 2; ++a) { const bf16_t* qp = Q + (qrow0 + a * 64) * 512 + h * 64 + 8 * fq; q[a][0] = *(const bf16x8*)qp; q[a][1] = *(const bf16x8*)(qp + 32); }
    float m_run[2] = {-INFINITY, -INFINITY}, l_run[2] = {0.f, 0.f};
    f32x4 o[2][4];
#pragma unroll
    for (int a = 0; a < 2; ++a)
#pragma unroll
        for (int dt = 0; dt < 4; ++dt) o[a][dt] = (f32x4){0.f, 0.f, 0.f, 0.f};
    const bf16_t* vt_base = VT + ((size_t)(b * 8 + h) * 64 + fr) * T;
#pragma unroll 1
    for (int g = 0; g < 2; ++g) {
        f32x4 s[2][8];
#pragma unroll
        for (int kt = 0; kt < 8; ++kt) { const LAS bf16_t* kp = Kc + (g * 128 + kt * 16 + fr) * NA_KLD + 8 * fq;
            const bf16x8 k0 = *(const LAS bf16x8*)kp, k1 = *(const LAS bf16x8*)(kp + 32);
#pragma unroll
            for (int a = 0; a < 2; ++a) { f32x4 acc = {0.f, 0.f, 0.f, 0.f};
                acc = __builtin_amdgcn_mfma_f32_16x16x32_bf16(k0, q[a][0], acc, 0, 0, 0);
                s[a][kt] = __builtin_amdgcn_mfma_f32_16x16x32_bf16(k1, q[a][1], acc, 0, 0, 0); } }
#pragma unroll
        for (int a = 0; a < 2; ++a) na_softmax_n<8>(s[a], m_run[a], l_run[a], o[a]);
#pragma unroll
        for (int k2 = 0; k2 < 4; ++k2) { const bf16x8 pb0 = na_pack2(s[0][2 * k2], s[0][2 * k2 + 1]), pb1 = na_pack2(s[1][2 * k2], s[1][2 * k2 + 1]);
            const LAS bf16_t* vp = VTc + fr * NA_VLD + g * 128 + k2 * 32 + 4 * fq;
#pragma unroll
            for (int dt = 0; dt < 4; ++dt) { const u32x2 lo = *(const LAS u32x2*)(vp + dt * 16 * NA_VLD), hi = *(const LAS u32x2*)(vp + dt * 16 * NA_VLD + 16);
                u32x4 vw; vw.x = lo.x; vw.y = lo.y; vw.z = hi.x; vw.w = hi.y; const bf16x8 vf = __builtin_bit_cast(bf16x8, vw);
                o[0][dt] = __builtin_amdgcn_mfma_f32_16x16x32_bf16(vf, pb0, o[0][dt], 0, 0, 0);
                o[1][dt] = __builtin_amdgcn_mfma_f32_16x16x32_bf16(vf, pb1, o[1][dt], 0, 0, 0); } }
    }
#pragma unroll 1
    for (int wg = 0; wg < 3; ++wg) {
        f32x4 s[2][6];
#pragma unroll
        for (int kt = 0; kt < 6; ++kt) { const int rr = 3 * wg + (kt >> 1), nt = kt & 1, kru = rs0 + rr, kr = min(kru, 255);
            const bf16_t* kp = K + ((size_t)b * T + kr * 64 + cb + 16 * nt + fr) * 512 + h * 64 + 8 * fq;
            const bf16x8 k0 = *(const bf16x8*)kp, k1 = *(const bf16x8*)(kp + 32);
#pragma unroll
            for (int a = 0; a < 2; ++a) { const int rsa = a ? rs1 : rs0;
                f32x4 acc = {0.f, 0.f, 0.f, 0.f};
                acc = __builtin_amdgcn_mfma_f32_16x16x32_bf16(k0, q[a][0], acc, 0, 0, 0);
                acc = __builtin_amdgcn_mfma_f32_16x16x32_bf16(k1, q[a][1], acc, 0, 0, 0);
                const bool rv = (kru >= rsa) && (kru < rsa + 8);
                const int di = min(max(kru - (i0 + a) + 7, 0), 14);
#pragma unroll
                for (int e = 0; e < 4; ++e) { const int kc = cb + 16 * nt + 4 * fq + e; const bool valid = rv && (kc >= cs) && (kc < cs + 16);
                    const int dj = min(max(kc - c + 15, 0), 30);
                    const float bias = rpb[di * 31 + dj];
                    acc[e] = (acc[e] + bias) + (valid ? 0.0f : -INFINITY); }
                s[a][kt] = acc; } }
#pragma unroll
        for (int a = 0; a < 2; ++a) na_softmax_n<6>(s[a], m_run[a], l_run[a], o[a]);
#pragma unroll
        for (int k2 = 0; k2 < 3; ++k2) { const bf16x8 pb0 = na_pack2(s[0][2 * k2], s[0][2 * k2 + 1]), pb1 = na_pack2(s[1][2 * k2], s[1][2 * k2 + 1]);
            const int kr = min(rs0 + 3 * wg + k2, 255);
            const bf16_t* vp = vt_base + (size_t)kr * 64 + cb + 4 * fq;
#pragma unroll
            for (int dt = 0; dt < 4; ++dt) { const u32x2 lo = *(const u32x2*)(vp + (size_t)dt * 16 * T), hi = *(const u32x2*)(vp + (size_t)dt * 16 * T + 16);
                u32x4 vw; vw.x = lo.x; vw.y = lo.y; vw.z = hi.x; vw.w = hi.y; const bf16x8 vf = __builtin_bit_cast(bf16x8, vw);
                o[0][dt] = __builtin_amdgcn_mfma_f32_16x16x32_bf16(vf, pb0, o[0][dt], 0, 0, 0);
                o[1][dt] = __builtin_amdgcn_mfma_f32_16x16x32_bf16(vf, pb1, o[1][dt], 0, 0, 0); } }
    }
#pragma unroll
    for (int a = 0; a < 2; ++a) { const float inv = 1.0f / l_run[a];
        bf16_t* op = MIX + (qrow0 + a * 64) * 1024 + h * 64 + 4 * fq;
#pragma unroll
        for (int dt = 0; dt < 4; ++dt) { const f32x4 y = o[a][dt] * inv; u32x2 w; w.x = pk2(y[0], y[1]); w.y = pk2(y[2], y[3]); *(u32x2*)(op + 16 * dt) = w; } }
}
template <int NTL>
__device__ __forceinline__ void na_expsum(f32x4 (&s)[NTL], float& l_part) {
#pragma unroll
    for (int kt = 0; kt < NTL; ++kt)
#pragma unroll
        for (int e = 0; e < 4; ++e) { const float pv = __builtin_amdgcn_exp2f(s[kt][e] * 1.44269504f - 14.4269504f); l_part += pv; s[kt][e] = pv; }
}
template <int NR>
__device__ __forceinline__ void na_taskN(const Params& p, int b, int h, int ig, int j, int lane, const LAS bf16_t* Kc, const LAS bf16_t* VTc, const LAS float* rpb) {
    constexpr int NWG = NR + 7;
    const int fr = lane & 15, fq = lane >> 4;
    const bf16_t* Q = (const bf16_t*)(p.ws + OFF_Q); const bf16_t* K = (const bf16_t*)(p.ws + OFF_K);
    const bf16_t* VT = (const bf16_t*)(p.ws + OFF_VT);
    bf16_t* MIX = (bf16_t*)(p.ws + OFF_MIX);
    const int i0 = NR * ig;
    const int rs0 = min(max(i0 - 4, 0), 248);
    const int cb = (j == 0) ? 0 : (j == 1) ? 8 : (j == 2) ? 24 : 32;
    const int c = 16 * j + fr, cs = min(max(c - 8, 0), 48);
    const size_t qrow0 = (size_t)b * T + i0 * 64 + 16 * j + fr;
    bf16x8 q[NR][2];
#pragma unroll
    for (int a = 0; a < NR; ++a) { const bf16_t* qp = Q + (qrow0 + a * 64) * 512 + h * 64 + 8 * fq; q[a][0] = *(const bf16x8*)qp; q[a][1] = *(const bf16x8*)(qp + 32); }
    float l_run[NR];
    f32x4 o[NR][4];
#pragma unroll
    for (int a = 0; a < NR; ++a) { l_run[a] = 0.f;
#pragma unroll
        for (int dt = 0; dt < 4; ++dt) o[a][dt] = (f32x4){0.f, 0.f, 0.f, 0.f}; }
    const bf16_t* vt_base = VT + ((size_t)(b * 8 + h) * 64 + fr) * T;
#pragma unroll 1
    for (int g = 0; g < 8; ++g) {
        f32x4 s[NR][2];
#pragma unroll
        for (int kt = 0; kt < 2; ++kt) { const LAS bf16_t* kp = Kc + (g * 32 + kt * 16 + fr) * NA_KLD + 8 * fq;
            const bf16x8 k0 = *(const LAS bf16x8*)kp, k1 = *(const LAS bf16x8*)(kp + 32);
#pragma unroll
            for (int a = 0; a < NR; ++a) { f32x4 acc = {0.f, 0.f, 0.f, 0.f};
                acc = __builtin_amdgcn_mfma_f32_16x16x32_bf16(k0, q[a][0], acc, 0, 0, 0);
                s[a][kt] = __builtin_amdgcn_mfma_f32_16x16x32_bf16(k1, q[a][1], acc, 0, 0, 0); } }
#pragma unroll
        for (int a = 0; a < NR; ++a) na_expsum<2>(s[a], l_run[a]);
#pragma unroll
        for (int k2 = 0; k2 < 1; ++k2) { bf16x8 pb[NR];
#pragma unroll
            for (int a = 0; a < NR; ++a) pb[a] = na_pack2(s[a][2 * k2], s[a][2 * k2 + 1]);
            const LAS bf16_t* vp = VTc + fr * NA_VLD + g * 32 + k2 * 32 + 4 * fq;
#pragma unroll
            for (int dt = 0; dt < 4; ++dt) { const u32x2 lo = *(const LAS u32x2*)(vp + dt * 16 * NA_VLD), hi = *(const LAS u32x2*)(vp + dt * 16 * NA_VLD + 16);
                u32x4 vw; vw.x = lo.x; vw.y = lo.y; vw.z = hi.x; vw.w = hi.y; const bf16x8 vf = __builtin_bit_cast(bf16x8, vw);
#pragma unroll
                for (int a = 0; a < NR; ++a) o[a][dt] = __builtin_amdgcn_mfma_f32_16x16x32_bf16(vf, pb[a], o[a][dt], 0, 0, 0); } }
    }
#pragma unroll 1
    for (int wg = 0; wg < NWG; ++wg) {
        f32x4 s[NR][2];
        const int kru = rs0 + wg, kr = min(kru, 255);
        bf16x8 kf[2][2];
#pragma unroll
        for (int nt = 0; nt < 2; ++nt) { const bf16_t* kp = K + ((size_t)b * T + kr * 64 + cb + 16 * nt + fr) * 512 + h * 64 + 8 * fq;
            kf[nt][0] = *(const bf16x8*)kp; kf[nt][1] = *(const bf16x8*)(kp + 32); }
        bool rv[NR];
#pragma unroll
        for (int a = 0; a < NR; ++a) { const int rsa = min(max(i0 + a - 4, 0), 248); rv[a] = (kru >= rsa) && (kru < rsa + 8);
            if (rv[a]) {
                const int di = min(max(kru - (i0 + a) + 7, 0), 14);
#pragma unroll
                for (int nt = 0; nt < 2; ++nt) { f32x4 acc = {0.f, 0.f, 0.f, 0.f};
                    acc = __builtin_amdgcn_mfma_f32_16x16x32_bf16(kf[nt][0], q[a][0], acc, 0, 0, 0);
                    acc = __builtin_amdgcn_mfma_f32_16x16x32_bf16(kf[nt][1], q[a][1], acc, 0, 0, 0);
#pragma unroll
                    for (int e = 0; e < 4; ++e) { const int kc = cb + 16 * nt + 4 * fq + e; const bool valid = (kc >= cs) && (kc < cs + 16);
                        const int dj = min(max(kc - c + 15, 0), 30);
                        const float bias = rpb[di * 31 + dj];
                        acc[e] = (acc[e] + bias) + (valid ? 0.0f : -INFINITY); }
                    s[a][nt] = acc; }
                na_expsum<2>(s[a], l_run[a]);
            } else { s[a][0] = (f32x4){0.f, 0.f, 0.f, 0.f}; s[a][1] = (f32x4){0.f, 0.f, 0.f, 0.f}; } }
        bf16x8 pb[NR];
#pragma unroll
        for (int a = 0; a < NR; ++a) pb[a] = na_pack2(s[a][0], s[a][1]);
        const bf16_t* vp = vt_base + (size_t)kr * 64 + cb + 4 * fq;
#pragma unroll
        for (int dt = 0; dt < 4; ++dt) { const u32x2 lo = *(const u32x2*)(vp + (size_t)dt * 16 * T), hi = *(const u32x2*)(vp + (size_t)dt * 16 * T + 16);
            u32x4 vw; vw.x = lo.x; vw.y = lo.y; vw.z = hi.x; vw.w = hi.y; const bf16x8 vf = __builtin_bit_cast(bf16x8, vw);
#pragma unroll
            for (int a = 0; a < NR; ++a) if (rv[a]) o[a][dt] = __builtin_amdgcn_mfma_f32_16x16x32_bf16(vf, pb[a], o[a][dt], 0, 0, 0); }
    }
#pragma unroll
    for (int a = 0; a < NR; ++a) { float lt = l_run[a]; lt += __shfl_xor(lt, 16); lt += __shfl_xor(lt, 32); const float inv = 1.0f / lt;
        bf16_t* op = MIX + (qrow0 + a * 64) * 1024 + h * 64 + 4 * fq;
#pragma unroll
        for (int dt = 0; dt < 4; ++dt) { const f32x4 y = o[a][dt] * inv; u32x2 w; w.x = pk2(y[0], y[1]); w.y = pk2(y[2], y[3]); *(u32x2*)(op + 16 * dt) = w; } }
}
__device__ __forceinline__ void phase_na(const Params& p, LAS unsigned char* lds, int blk, int nblk) {
    const int tid = threadIdx.x, lane = tid & 63, wave = tid >> 6;
    const int bh = blk & 15, sub = blk >> 4, nsub = (nblk - bh + 15) >> 4, b = bh >> 3, h = bh & 7;
    LAS bf16_t* Kc = (LAS bf16_t*)lds; LAS bf16_t* VTc = Kc + 256 * NA_KLD;
    const bf16_t* K = (const bf16_t*)(p.ws + OFF_K); const bf16_t* VTC = (const bf16_t*)(p.ws + OFF_VTC);
    for (int idx = tid; idx < 256 * 8; idx += 512) { const int l = idx >> 3, c8 = idx & 7;
        *(LAS u32x4*)(Kc + l * NA_KLD + 8 * c8) = *(const u32x4*)(K + ((size_t)MT + b * LC + l) * 512 + h * 64 + 8 * c8); }
    for (int idx = tid; idx < 64 * 32; idx += 512) { const int dd = idx >> 5, c8 = idx & 31;
        *(LAS u32x4*)(VTc + dd * NA_VLD + 8 * c8) = *(const u32x4*)(VTC + ((size_t)(b * 8 + h) * 64 + dd) * LC + 8 * c8); }
    LAS float* rpbl = (LAS float*)(VTc + 64 * NA_VLD);
    for (int idx = tid; idx < 15 * 31; idx += 512) rpbl[idx] = p.in[11][h * 15 * 31 + idx];
    __syncthreads();
    for (int wt = sub * 8 + wave; wt < 256; wt += nsub * 8) na_taskN<4>(p, b, h, wt >> 2, wt & 3, lane, Kc, VTc, rpbl);
}

typedef float f32x16 __attribute__((ext_vector_type(16)));
typedef float f32x2 __attribute__((ext_vector_type(2)));
constexpr int SC = 2;
constexpr int CL = 260;
__device__ __forceinline__ void chunk_pos(int b, int d, int q, int i, int& row, bool& hasp, bool& hasn, int& t) {
    const int s = q * CL + i;
    if (s < LC) { const int l = d ? (LC - 1 - s) : s; row = MT + b * LC + l; hasp = l > 0; hasn = l < LC - 1; t = -1; }
    else { const int off = s - LC; t = d ? (T - 1 - off) : off; row = b * T + t; hasp = t > 0; hasn = t < T - 1; }
}
__device__ __forceinline__ void prep_consts(const Params& p, int h, int lane, LAS float* cst) {
    const int hc = h * 64 + lane;
    cst[lane] = p.in[12][hc]; cst[64 + lane] = p.in[13][hc]; cst[128 + lane] = p.in[12][512 + hc]; cst[192 + lane] = p.in[13][512 + hc];
    cst[256 + lane] = p.in[12][1024 + hc]; cst[320 + lane] = p.in[13][1024 + hc];
    cst[384 + lane] = p.in[19][hc]; cst[448 + lane] = p.in[20][hc]; cst[512 + lane] = p.in[21][hc];
}
typedef unsigned short us2 __attribute__((ext_vector_type(2)));
struct RawTok { us2 rk, vd, pa, pb, nn, vn_ar; };
__device__ __forceinline__ RawTok prep_load(const bf16_t* PR, const bf16_t* DEC, const bf16_t* AR, int row, bool hp, bool hn, int hc, int dcol) {
    const bf16_t* pr = PR + (size_t)row * RWP;
    const bf16_t* prp = hp ? pr - RWP : pr; const bf16_t* prn = hn ? pr + RWP : pr;
    RawTok x;
    x.rk = (us2){pr[hc], pr[512 + hc]}; x.vd = (us2){pr[1024 + hc], (DEC + (size_t)row * 1024)[dcol]};
    x.pa = (us2){prp[hc], prp[512 + hc]}; x.pb = (us2){prp[1024 + hc], prn[hc]};
    x.nn = (us2){prn[512 + hc], prn[1024 + hc]}; x.vn_ar = (us2){(AR + (size_t)row * 1024)[dcol], (unsigned short)0};
    return x;
}
__device__ __forceinline__ void prep_compute(const RawTok& x, bool hp, bool hn, const LAS float* cst, LAS float* o, int lane) {
    const float mp_ = hp ? 1.0f : 0.0f, mn_ = hn ? 1.0f : 0.0f;
    const float rc = bf2f(x.rk[0]), kc = bf2f(x.rk[1]), vc = bf2f(x.vd[0]);
    const float rp = mp_ * bf2f(x.pa[0]), kp = mp_ * bf2f(x.pa[1]), vp = mp_ * bf2f(x.pb[0]);
    const float rn = mn_ * bf2f(x.pb[1]), kn = mn_ * bf2f(x.nn[0]), vn = mn_ * bf2f(x.nn[1]);
    const float r = rc + cst[lane] * (rp - rc) + cst[64 + lane] * (rn - rc);
    const float k = kc + cst[128 + lane] * (kp - kc) + cst[192 + lane] * (kn - kc);
    const float v = vc + cst[256 + lane] * (vp - vc) + cst[320 + lane] * (vn - vc);
    const float w = __expf(bf2f(x.vd[1]));
    const float a = bf2f(x.vn_ar[0]);
    const float kkr = k * cst[384 + lane];
    const float ss = wave_sum(kkr * kkr);
    const float kk = kkr * __builtin_amdgcn_rsqf(fmaxf(ss, 1e-24f));
    const float kd = k * (1.0f + (a - 1.0f) * cst[448 + lane]);
    o[lane] = w; o[64 + lane] = -kk; o[128 + lane] = kk * a; o[192 + lane] = kd; o[256 + lane] = r; o[320 + lane] = v;
}
#define LO2(x) ((f32x2){(x)[0], (x)[1]})
#define HI2(x) ((f32x2){(x)[2], (x)[3]})
template <int MODE>
__device__ __forceinline__ float rec_step(f32x2 (&s)[32], f32x2 (&pm)[32], const LAS float* o, int lane, float& zout) {
    constexpr int GA = 2;
    constexpr int GU = 1;
    const float vv = o[320 + lane];
    f32x2 sacc0 = {0.f, 0.f}, sacc1 = {0.f, 0.f}, pacc0 = {0.f, 0.f}, pacc1 = {0.f, 0.f};
    f32x4 abuf[2][GA];
#pragma unroll
    for (int i = 0; i < GA; ++i) abuf[0][i] = *(const LAS f32x4*)(o + 64 + 4 * i);
    f32x4 wb[2][GU], bb[2][GU], kb[2][GU], rb[2][GU];
#pragma unroll
    for (int gg = 0; gg < 16 / GA; ++gg) {
        if (gg < 16 / GA - 1) {
#pragma unroll
            for (int i = 0; i < GA; ++i) abuf[(gg + 1) & 1][i] = *(const LAS f32x4*)(o + 64 + 4 * GA * (gg + 1) + 4 * i);
        } else {
#pragma unroll
            for (int i = 0; i < GU; ++i) { wb[0][i] = *(const LAS f32x4*)(o + 4 * i); bb[0][i] = *(const LAS f32x4*)(o + 128 + 4 * i); kb[0][i] = *(const LAS f32x4*)(o + 192 + 4 * i);
                if (MODE != 0) rb[0][i] = *(const LAS f32x4*)(o + 256 + 4 * i); }
        }
        ;
#pragma unroll
        for (int i = 0; i < GA; ++i) { const int g = GA * gg + i; const f32x4 a4 = abuf[gg & 1][i];
            sacc0 += s[2 * g] * LO2(a4); sacc1 += s[2 * g + 1] * HI2(a4);
            if (MODE != 1) { pacc0 += pm[2 * g] * LO2(a4); pacc1 += pm[2 * g + 1] * HI2(a4); } }
        ;
    }
    const f32x2 sacc = sacc0 + sacc1, pacc = pacc0 + pacc1;
    const float sa = sacc.x + sacc.y, pa = pacc.x + pacc.y;
    const f32x2 sa2 = {sa, sa}, pa2 = {pa, pa}, vv2 = {vv, vv};
    f32x2 yacc0 = {0.f, 0.f}, yacc1 = {0.f, 0.f}, zacc0 = {0.f, 0.f}, zacc1 = {0.f, 0.f};
#pragma unroll
    for (int gg = 0; gg < 16 / GU; ++gg) {
        if (gg < 16 / GU - 1) {
#pragma unroll
            for (int i = 0; i < GU; ++i) { const int g = GU * (gg + 1) + i; wb[(gg + 1) & 1][i] = *(const LAS f32x4*)(o + 4 * g); bb[(gg + 1) & 1][i] = *(const LAS f32x4*)(o + 128 + 4 * g);
                kb[(gg + 1) & 1][i] = *(const LAS f32x4*)(o + 192 + 4 * g); if (MODE != 0) rb[(gg + 1) & 1][i] = *(const LAS f32x4*)(o + 256 + 4 * g); }
        }
        ;
#pragma unroll
        for (int i = 0; i < GU; ++i) { const int g = GU * gg + i; const f32x4 w4 = wb[gg & 1][i], b4 = bb[gg & 1][i], k4 = kb[gg & 1][i];
            s[2 * g] = s[2 * g] * LO2(w4) + sa2 * LO2(b4) + vv2 * LO2(k4);
            s[2 * g + 1] = s[2 * g + 1] * HI2(w4) + sa2 * HI2(b4) + vv2 * HI2(k4);
            if (MODE != 1) { pm[2 * g] = pm[2 * g] * LO2(w4) + pa2 * LO2(b4); pm[2 * g + 1] = pm[2 * g + 1] * HI2(w4) + pa2 * HI2(b4); }
            if (MODE != 0) { const f32x4 r4 = rb[gg & 1][i]; yacc0 += s[2 * g] * LO2(r4); yacc1 += s[2 * g + 1] * HI2(r4);
                if (MODE == 2) { zacc0 += pm[2 * g] * LO2(r4); zacc1 += pm[2 * g + 1] * HI2(r4); } } }
        ;
    }
    const f32x2 yacc = yacc0 + yacc1, zacc = zacc0 + zacc1;
    zout = zacc.x + zacc.y;
    return yacc.x + yacc.y;
}
template <bool DO_PREP = true, bool DO_REC = true, bool DUMMY = false>
__device__ __forceinline__ void phase_pass1(const Params& p, LAS unsigned char* lds) {
    const int lane = threadIdx.x & 63, wave = __builtin_amdgcn_readfirstlane(threadIdx.x >> 6);
    const bf16_t* PR = (const bf16_t*)(p.ws + OFF_PR); const bf16_t* DEC = (const bf16_t*)(p.ws + OFF_DEC); const bf16_t* AR = (const bf16_t*)(p.ws + OFF_AR);
    LAS float* stg = (LAS float*)lds + wave * (SC * 384);
    LAS float* cst = (LAS float*)lds + 8 * (SC * 384) + wave * 576;
    for (int tk = blockIdx.x; tk < 256; tk += gridDim.x) {
        const int b = tk >> 7, d = (tk >> 6) & 1, q = tk & 63, h = wave, ch = (b * 8 + h) * 2 + d;
        prep_consts(p, h, lane, cst);
        const int hc = h * 64 + lane, dcol = d * 512 + hc;
        unsigned* YZ = d ? (unsigned*)(p.ws + OFF_Q) : (unsigned*)p.out;
        f32x2 s[32], pm[32];
#pragma unroll
        for (int i = 0; i < 32; i += 2) { const f32x4 x = *(const f32x4*)((const float*)(p.ws + OFF_IDENT) + lane * 64 + 2 * i);
            s[i] = (f32x2){0.f, 0.f}; s[i + 1] = (f32x2){0.f, 0.f}; pm[i] = (f32x2){x[0], x[1]}; pm[i + 1] = (f32x2){x[2], x[3]}; }
        RawTok raw[SC];
#pragma unroll
        for (int j = 0; j < SC; ++j) { int row, t; bool hp_, hn_; chunk_pos(b, d, q, j, row, hp_, hn_, t); raw[j] = prep_load(PR, DEC, AR, row, hp_, hn_, hc, dcol); }
#pragma unroll 1
        for (int it = 0; it < CL / SC; ++it) {
            int row0 = 0, t0 = 0;
            { int hr_, ht_; bool x1, x2; chunk_pos(b, d, q, it * SC, hr_, x1, x2, ht_); row0 = hr_; t0 = ht_; }
            if (DO_PREP) {
#pragma unroll
                for (int j = 0; j < SC; ++j) { int row, t; bool hp_, hn_; chunk_pos(b, d, q, it * SC + j, row, hp_, hn_, t); prep_compute(raw[j], hp_, hn_, cst, stg + j * 384, lane); asm volatile("" ::: "memory"); }
                const int itn = min(it + 1, CL / SC - 1);
#pragma unroll
                for (int j = 0; j < SC; ++j) { int row, t; bool hp_, hn_; chunk_pos(b, d, q, itn * SC + j, row, hp_, hn_, t); raw[j] = prep_load(PR, DEC, AR, row, hp_, hn_, hc, dcol); }
            }
            if (DO_REC) {
                const bool latent = t0 >= 0 && !DUMMY;
                int rowc = row0; const int rstep = d ? -1 : 1;
#pragma unroll 1
                for (int st = 0; st < SC; ++st) { float z; const float y = rec_step<2>(s, pm, stg + st * 384, lane, z);
                    if (latent) (YZ + (size_t)rowc * 512)[hc] = pk2(y, z); rowc += rstep; }
            }
        }
        float* hp = p.out + (DUMMY ? 0 : (size_t)MT * 512) + ((size_t)(ch * 64 + q) * 2) * 4096 + lane * 64;
        if (!DUMMY) {
#pragma unroll
        for (int i = 0; i < 32; i += 2) { *(f32x4*)(hp + 2 * i) = (f32x4){s[i].x, s[i].y, s[i + 1].x, s[i + 1].y}; *(f32x4*)(hp + 4096 + 2 * i) = (f32x4){pm[i].x, pm[i].y, pm[i + 1].x, pm[i + 1].y}; }
        }
    }
}
__device__ __forceinline__ void phase_pass2(const Params& p, LAS unsigned char* lds, int ch, int mt) {
    constexpr int LDP = 68;
    LAS float* Sl = (LAS float*)lds; LAS float* Pl = Sl + 16 * LDP;
    const int tid = threadIdx.x, lane = tid & 63, w = tid >> 6, fr = lane & 15, fq = lane >> 4;
    const float* HP = p.out + (size_t)MT * 512 + (size_t)ch * 64 * 8192;
    float* SST = (float*)(p.ws + OFF_SST) + (size_t)ch * 65 * 4096;
    __syncthreads();
    for (int idx = tid; idx < 16 * LDP; idx += 512) Sl[idx] = 0.f;
    for (int idx = tid; idx < 1024; idx += 512) SST[mt * 1024 + idx] = 0.f;
    const int pidx = tid * 8, pj = pidx >> 6, pk = pidx & 63;
    f32x4 px0 = *(const f32x4*)(HP + 4096 + pidx), px1 = *(const f32x4*)(HP + 4096 + pidx + 4);
    f32x4 hx = {0.f, 0.f, 0.f, 0.f};
    if (w < 4) {
#pragma unroll
        for (int e = 0; e < 4; ++e) hx[e] = HP[(16 * mt + 4 * fq + e) * 64 + 16 * w + fr];
    }
#pragma unroll 1
    for (int q = 0; q < 63; ++q) {
        *(LAS f32x4*)(Pl + pj * LDP + pk) = px0; *(LAS f32x4*)(Pl + pj * LDP + pk + 4) = px1;
        f32x4 acc = hx;
        const float* Hn = HP + (size_t)min(q + 1, 62) * 8192;
        px0 = *(const f32x4*)(Hn + 4096 + pidx); px1 = *(const f32x4*)(Hn + 4096 + pidx + 4);
        if (w < 4) {
#pragma unroll
            for (int e = 0; e < 4; ++e) hx[e] = Hn[(16 * mt + 4 * fq + e) * 64 + 16 * w + fr];
        }
        asm volatile("s_waitcnt lgkmcnt(0)\n\ts_barrier" ::: "memory");
        if (w < 4) {
#pragma unroll
            for (int ks = 0; ks < 16; ++ks) {
                const float a = Sl[fr * LDP + 4 * ks + fq];
                const float b0 = Pl[(4 * ks + fq) * LDP + 16 * w + fr];
                acc = __builtin_amdgcn_mfma_f32_16x16x4f32(a, b0, acc, 0, 0, 0);
            }
        }
        asm volatile("s_waitcnt lgkmcnt(0)\n\ts_barrier" ::: "memory");
        if (w < 4) {
#pragma unroll
            for (int e = 0; e < 4; ++e) { const int vl = 4 * fq + e, k = 16 * w + fr; Sl[vl * LDP + k] = acc[e]; SST[(size_t)(q + 1) * 4096 + (16 * mt + vl) * 64 + k] = acc[e]; }
        }
    }
}
struct FinRaw { unsigned yz0, yz1; us2 gv, rk, pa, pb, nn, aa; };
__device__ __forceinline__ FinRaw fin_load(const bf16_t* PR, const bf16_t* AR, const bf16_t* MIX, const unsigned* YZ0, const unsigned* YZ1, int b, int t, int c) {
    const int row = b * T + t;
    const bf16_t* pr = PR + (size_t)row * RWP; const bf16_t* prp = t > 0 ? pr - RWP : pr; const bf16_t* prn = t < T - 1 ? pr + RWP : pr;
    const bf16_t* ar = AR + (size_t)row * 1024;
    FinRaw x;
    x.yz0 = (YZ0 + (size_t)row * 512)[c]; x.yz1 = (YZ1 + (size_t)row * 512)[c]; x.gv = (us2){(MIX + (size_t)row * 1024 + 512)[c], pr[1024 + c]};
    x.rk = (us2){pr[c], pr[512 + c]}; x.pa = (us2){prp[c], prp[512 + c]}; x.pb = (us2){prp[1024 + c], prn[c]};
    x.nn = (us2){prn[512 + c], prn[1024 + c]}; x.aa = (us2){ar[c], ar[512 + c]};
    return x;
}
__device__ __forceinline__ void phase_fixfinish(const Params& p, LAS unsigned char* lds) {
    const int tid = threadIdx.x, lane = tid & 63, wave = __builtin_amdgcn_readfirstlane(tid >> 6);
    const bf16_t* PR = (const bf16_t*)(p.ws + OFF_PR); const bf16_t* AR = (const bf16_t*)(p.ws + OFF_AR);
    bf16_t* MIX = (bf16_t*)(p.ws + OFF_MIX);
    const float* mup = p.in[12]; const float* mun = p.in[13];
    const int h = wave, c = h * 64 + lane;
    const float lng = p.in[22][c], lnb = p.in[23][c];
    const float mpv = mup[1024 + c], mnv = mun[1024 + c], mpr = mup[c], mnr = mun[c], mpk = mup[512 + c], mnk = mun[512 + c], kac = p.in[20][c], rkc = p.in[21][c];
    const unsigned* YZ0 = (const unsigned*)p.out; const unsigned* YZ1 = (const unsigned*)(p.ws + OFF_Q);
    const float* SSTb = (const float*)(p.ws + OFF_SST);
    LAS float* zb = (LAS float*)lds + wave * 128;
    constexpr int NT = 2;
    for (int tk = blockIdx.x; tk < 256; tk += gridDim.x) {
        const int b = tk >> 7, m = tk & 127;
        const float* S0base = SSTb + (size_t)((b * 8 + h) * 2 + 0) * 65 * 4096 + lane * 64;
        const float* S1base = SSTb + (size_t)((b * 8 + h) * 2 + 1) * 65 * 4096 + lane * 64;
        f32x2 s0[32], s1[32]; int q0c = -1, q1c = -1;
        FinRaw fr[NT];
#pragma unroll
        for (int j = 0; j < NT; ++j) fr[j] = fin_load(PR, AR, MIX, YZ0, YZ1, b, m * 128 + j, c);
#pragma unroll 1
        for (int tl0 = 0; tl0 < 128; tl0 += NT) {
            FinRaw cur[NT];
#pragma unroll
            for (int j = 0; j < NT; ++j) cur[j] = fr[j];
            const int tn0 = m * 128 + min(tl0 + NT, 128 - NT);
#pragma unroll
            for (int j = 0; j < NT; ++j) fr[j] = fin_load(PR, AR, MIX, YZ0, YZ1, b, tn0 + j, c);
#pragma unroll
            for (int j = 0; j < NT; ++j) {
                const int t = m * 128 + tl0 + j, row = b * T + t;
                const int q0 = (LC + t) / CL, q1 = (LC + T - 1 - t) / CL;
                if (q0 != q0c) { q0c = q0; const float* sp = S0base + (size_t)q0 * 4096;
#pragma unroll
                    for (int i = 0; i < 32; i += 2) { const f32x4 x = *(const f32x4*)(sp + 2 * i); s0[i] = (f32x2){x[0], x[1]}; s0[i + 1] = (f32x2){x[2], x[3]}; } }
                if (q1 != q1c) { q1c = q1; const float* sp = S1base + (size_t)q1 * 4096;
#pragma unroll
                    for (int i = 0; i < 32; i += 2) { const f32x4 x = *(const f32x4*)(sp + 2 * i); s1[i] = (f32x2){x[0], x[1]}; s1[i + 1] = (f32x2){x[2], x[3]}; } }
                const FinRaw& x = cur[j];
                zb[lane] = __uint_as_float(x.yz0 & 0xffff0000u); zb[64 + lane] = __uint_as_float(x.yz1 & 0xffff0000u);
                float w = __uint_as_float(x.yz0 << 16) + __uint_as_float(x.yz1 << 16);
                const float gte = bf2f(x.gv[0]);
                const float mp_ = t > 0 ? 1.0f : 0.0f, mn_ = t < T - 1 ? 1.0f : 0.0f;
                const float vc = bf2f(x.gv[1]), rc = bf2f(x.rk[0]), kc = bf2f(x.rk[1]);
                const float rp = mp_ * bf2f(x.pa[0]), kp = mp_ * bf2f(x.pa[1]), vp = mp_ * bf2f(x.pb[0]);
                const float rn = mn_ * bf2f(x.pb[1]), kn = mn_ * bf2f(x.nn[0]), vn = mn_ * bf2f(x.nn[1]);
                const float a0 = bf2f(x.aa[0]), a1 = bf2f(x.aa[1]);
                f32x2 acc0 = {0.f, 0.f}, acc1 = {0.f, 0.f};
#pragma unroll
                for (int g = 0; g < 16; ++g) { const f32x4 za = *(const LAS f32x4*)(zb + 4 * g), zc = *(const LAS f32x4*)(zb + 64 + 4 * g);
                    acc0 += s0[2 * g] * LO2(za); acc0 += s0[2 * g + 1] * HI2(za); acc1 += s1[2 * g] * LO2(zc); acc1 += s1[2 * g + 1] * HI2(zc); }
                const f32x2 acc = acc0 + acc1; w += acc.x + acc.y;
                const float mu = wave_sum(w) * (1.0f / 64.0f);
                const float dv = w - mu;
                const float var = wave_sum(dv * dv) * (1.0f / 64.0f);
                float y = dv * rsqrtf(var + 64e-5f) * lng + lnb;
                const float vs = vc + mpv * (vp - vc) + mnv * (vn - vc);
                const float rs = rc + mpr * (rp - rc) + mnr * (rn - rc);
                const float ks = kc + mpk * (kp - kc) + mnk * (kn - kc);
                const float bon = wave_sum(rs * ks * rkc * (2.0f + (a0 + a1 - 2.0f) * kac));
                y = (y + bon * vs) * gte;
                MIX[(size_t)row * 1024 + 512 + c] = f2bf(y);
            }
        }
    }
}

__global__ void __launch_bounds__(512) mega(Params p) {
    extern __shared__ __attribute__((aligned(16))) unsigned char shm[];
    LAS unsigned char* lds = (LAS unsigned char*)shm;
    cg::grid_group grid = cg::this_grid();
    __shared__ unsigned xb_words[4];
    if (threadIdx.x < 4) xb_words[threadIdx.x] = 0u;
    __syncthreads();
    if (blockIdx.x == 0) { unsigned* bw = (unsigned*)(p.ws + OFF_BAR); for (int i = threadIdx.x; i < XCD_BAR_WORDS; i += 512) bw[i] = 0u; }
    XcdBarrier xb; xb.bar = (unsigned*)(p.ws + OFF_BAR); xb.x = 0u; xb.st = (volatile LAS unsigned*)xb_words;
    const float* mod = (const float*)(p.ws + OFF_MOD);
#ifndef PHMASK
#define PHMASK 0x1fff
#endif
#ifndef REPMASK
#define REPMASK 0
#endif
#define HAS(x) ((PHMASK >> (x)) & 1)
#define RUN(k) (HAS(k) && p.ph_lo <= (k) && (k) < p.ph_hi)
#define SYNC(k) do { if (p.ph_lo <= (k) && (k) + 1 < p.ph_hi) { if ((k) == 0) grid.sync(); else xcd_barrier(xb); } } while (0)
#define PHASE(k, ...) do { if (RUN(k)) { __VA_ARGS__; if ((REPMASK >> (k)) & 1) { xcd_barrier(xb); __VA_ARGS__; } } SYNC(k); } while (0)
#define GEMM_PH_W(EPI, Aoff, Boff, M_, N_, K_, LD_, THR_, KOFF_, ...) { int kk_ = (K_); asm volatile("" : "+s"(kk_)); pg8::Gemm g{(const bf16_t*)(p.ws + (Aoff)), (const bf16_t*)(p.ws + (Boff)), (M_), (N_), kk_, (LD_), (THR_), (KOFF_)}; \
        pg8::StaticOrder S; S.init((M_), (N_), (int)gridDim.x, (int)blockIdx.x); EPI E{__VA_ARGS__}; pg8::gemm_phase<EPI, pg8::StaticOrder, false>(lds, g, S, E, nullptr); }
#define GEMM_PH(EPI, Aoff, Boff, M_, N_, K_, ...) { int kk_ = (K_); asm volatile("" : "+s"(kk_)); pg8::Gemm g{(const bf16_t*)(p.ws + (Aoff)), (const bf16_t*)(p.ws + (Boff)), (M_), (N_), kk_}; \
        pg8::StaticOrder S; S.init((M_), (N_), (int)gridDim.x, (int)blockIdx.x); EPI E{__VA_ARGS__}; pg8::gemm_phase<EPI, pg8::StaticOrder, false>(lds, g, S, E, nullptr); }
    PHASE(0, phase0(p, lds));
    xb = xcd_barrier_post((unsigned*)(p.ws + OFF_BAR), (volatile LAS unsigned*)xb_words);
    PHASE(1, phase_norm(p, 0));
    PHASE(2, GEMM_PH(EpiIn, OFF_U, OFF_WIN, MA, INPP, 1024, (bf16_t*)(p.ws + OFF_Q), (bf16_t*)(p.ws + OFF_K), (bf16_t*)(p.ws + OFF_VT), (bf16_t*)(p.ws + OFF_VTC), (bf16_t*)(p.ws + OFF_PR), p.in[9], p.in[10]));
    PHASE(3, phase_shiftprep(p); phase_na(p, lds, (int)blockIdx.x, (int)gridDim.x));
    PHASE(4, GEMM_PH_W(EpiLora, OFF_LA, OFF_LORAB, MA, 2560, 256, 384, 8, 128, (bf16_t*)(p.ws + OFF_DEC), (bf16_t*)(p.ws + OFF_AR), (bf16_t*)(p.ws + OFF_MIX), p.in[14], p.in[16]));
    PHASE(6, phase_pass1(p, lds));
    PHASE(7, if ((int)gridDim.x > NCHAIN * 4 && (int)blockIdx.x >= NCHAIN * 4) weight_transposes(p, lds, W_EARLY, W_ALL, ((int)blockIdx.x - NCHAIN * 4) * 8 + (int)(threadIdx.x >> 6), ((int)gridDim.x - NCHAIN * 4) * 8);
             else { for (int it_ = blockIdx.x; it_ < NCHAIN * 4; it_ += ((int)gridDim.x > NCHAIN * 4 ? NCHAIN * 4 : (int)gridDim.x)) phase_pass2(p, lds, it_ >> 2, it_ & 3);
                    if ((int)gridDim.x <= NCHAIN * 4) weight_transposes(p, lds, W_EARLY, W_ALL, (int)blockIdx.x * 8 + (int)(threadIdx.x >> 6), (int)gridDim.x * 8); });
    PHASE(8, phase_fixfinish(p, lds));
    PHASE(9, GEMM_PH(EpiRes, OFF_MIX, OFF_WOUT, MT, 1024, 1024, p.in[0], p.out, mod + 2 * 1024));
    PHASE(10, phase_norm(p, 1));
    PHASE(11, GEMM_PH(EpiGlu, OFF_U, OFF_WF1, MT, 2 * DFF, 1024, (bf16_t*)(p.ws + OFF_ACT)));
    PHASE(12, GEMM_PH(EpiRes, OFF_ACT, OFF_WF2, MT, 1024, DFF, p.out, p.out, mod + 5 * 1024));
}

extern "C" void kernel_launch(void* const* d_in, const int* in_sizes, int n_in, void* d_out, int out_size, void* d_ws, size_t ws_size, hipStream_t stream) {
    static int grid = 0;
    if (!grid) {
        int dev = 0, cus = 0, per_cu = 0;
        (void)hipGetDevice(&dev);
        (void)hipDeviceGetAttribute(&cus, hipDeviceAttributeMultiprocessorCount, dev);
        (void)hipFuncSetAttribute((const void*)mega, hipFuncAttributeMaxDynamicSharedMemorySize, LDS_BYTES);
        if (hipOccupancyMaxActiveBlocksPerMultiprocessor(&per_cu, (const void*)mega, 512, LDS_BYTES) != hipSuccess || per_cu < 1) { (void)hipGetLastError(); per_cu = 1; }
        grid = cus * per_cu;
        if (ws_size < OFF_END) fprintf(stderr, "kernel_launch: workspace too small: %zu < %zu\n", ws_size, (size_t)OFF_END);
    }
    Params p{};
    for (int i = 0; i < 27; ++i) p.in[i] = (const float*)d_in[i];
    p.out = (float*)d_out; p.ws = (unsigned char*)d_ws; p.ph_lo = 0; p.ph_hi = 13;
    void* args[] = {&p};
    hipError_t e = hipLaunchCooperativeKernel((const void*)mega, dim3(grid), dim3(512), args, LDS_BYTES, stream);
    if (e != hipSuccess) fprintf(stderr, "cooperative launch failed: %s (grid %d)\n", hipGetErrorString(e), grid);
}
```
